# Optimizing an MI355X kernel written in HIP

```python
import math
import jax, jax.numpy as jnp
from jax import lax
import numpy as np

D_MODEL = 2048
BATCH = 4
SEQ = 2048
DEPTH = 2
DEC_BATCH = 128
DEC_SEQ = 8
PAST_LEN = 8192
PAGE_SIZE = 128

N_BRANCH = 4
SSM_INNER = D_MODEL // 2
SSM_HEADDIM = 64
SSM_HEADS = SSM_INNER // SSM_HEADDIM
SSM_GROUPS = 4
SSM_STATE = 128
SSM_CONV = 4
SSM_CHUNK = 128
SSM_CONV_DIM = SSM_INNER + 2 * SSM_GROUPS * SSM_STATE
CF_WIDTH = D_MODEL // 2
CF_CONV_WIDTH = 31
SC_WIDTH = D_MODEL // 2
SC_CONV_WIDTH = 3
ATT_HEAD_DIM = 64
ATT_HEADS = 16
ATT_KV_HEADS = 4
ATT_REP = ATT_HEADS // ATT_KV_HEADS
ATT_WIDTH = ATT_HEADS * ATT_HEAD_DIM
ATT_KV_WIDTH = ATT_KV_HEADS * ATT_HEAD_DIM
WINDOW = 128
ATT_BLOCK = 128
WIN_BUF = min(WINDOW, PAST_LEN)
EPS = 1e-6

IN_SPLITS = (SSM_INNER, SSM_CONV_DIM, SSM_HEADS,
             2 * CF_WIDTH, CF_WIDTH,
             3 * SC_WIDTH, SC_WIDTH,
             ATT_WIDTH, ATT_KV_WIDTH, ATT_KV_WIDTH, ATT_WIDTH,
             N_BRANCH * D_MODEL)
IN_COLS = sum(IN_SPLITS)

kernel_name = "hybrid_ssd_conformer_shortconv_swa_step"


def _in_offsets():
    return [int(o) for o in np.cumsum(IN_SPLITS)[:-1]]


def rms_norm(x, w, eps=EPS):
    xf = x.astype(jnp.float32)
    xf = xf * lax.rsqrt(jnp.mean(xf * xf, axis=-1, keepdims=True) + eps)
    return (xf * w.astype(jnp.float32)).astype(x.dtype)


def layer_norm(x, w, b, eps=1e-5):
    xf = x.astype(jnp.float32)
    mu = jnp.mean(xf, axis=-1, keepdims=True)
    xc = xf - mu
    var = jnp.mean(xc * xc, axis=-1, keepdims=True)
    return (xc * lax.rsqrt(var + eps) * w.astype(jnp.float32) + b.astype(jnp.float32)).astype(x.dtype)


def causal_dwconv(x, prefix, w, b=None):
    k = w.shape[0]
    xp = jnp.concatenate([prefix.astype(x.dtype), x], axis=1)
    y = lax.conv_general_dilated(xp, w[:, None, :].astype(x.dtype), window_strides=(1,),
                                 padding='VALID', dimension_numbers=('NWC', 'WIO', 'NWC'),
                                 feature_group_count=x.shape[-1])
    if b is not None:
        y = y + b.astype(x.dtype)
    return y, xp[:, xp.shape[1] - (k - 1):]


def segsum_exp(cs):
    n = cs.shape[-1]
    diff = cs[..., :, None] - cs[..., None, :]
    mask = jnp.tril(jnp.ones((n, n), dtype=bool))
    return jnp.exp(jnp.where(mask, diff, -jnp.inf))


def ssd_scan(x, dt, a, bmat, cmat, h0):
    b_, t_, h_, p_ = x.shape
    g_, n_ = bmat.shape[2], bmat.shape[3]
    r_ = h_ // g_
    lc = SSM_CHUNK if t_ % SSM_CHUNK == 0 else t_
    nc = t_ // lc
    xf = (x.astype(jnp.float32) * dt[..., None]).reshape(b_, nc, lc, g_, r_, p_)
    bf = bmat.astype(jnp.float32).reshape(b_, nc, lc, g_, n_)
    cf = cmat.astype(jnp.float32).reshape(b_, nc, lc, g_, n_)
    da = (dt * a).reshape(b_, nc, lc, g_, r_)
    cs = jnp.cumsum(da, axis=2)
    lmat = segsum_exp(jnp.moveaxis(cs, 2, -1))
    cb = jnp.einsum('bclgn,bcsgn->bcgls', cf, bf)
    y_diag = jnp.einsum('bcgrls,bcsgrp->bclgrp', cb[:, :, :, None] * lmat, xf)
    decay = jnp.exp(cs[:, :, -1:] - cs)
    chunk_states = jnp.einsum('bclgn,bclgr,bclgrp->bcgrpn', bf, decay, xf)
    chunk_decay = jnp.exp(cs[:, :, -1])

    def step(h, inp):
        s_c, d_c = inp
        return h * d_c[..., None, None] + s_c, h

    h0g = h0.astype(jnp.float32).reshape(b_, g_, r_, p_, n_)
    h_final, h_prev = lax.scan(step, h0g, (jnp.moveaxis(chunk_states, 1, 0),
                                           jnp.moveaxis(chunk_decay, 1, 0)))
    h_prev = jnp.moveaxis(h_prev, 0, 1)
    y_off = jnp.einsum('bclgn,bcgrpn,bclgr->bclgrp', cf, h_prev, jnp.exp(cs))
    y = (y_diag + y_off).reshape(b_, t_, h_, p_)
    return y, h_final.reshape(b_, h_, p_, n_)


def swa_sink_attend(q, k, v, q_pos, k_pos, sinks):
    s = jnp.einsum('bnqhrd,bnkhd->bnhrqk', q.astype(jnp.float32), k.astype(jnp.float32))
    s = s * (ATT_HEAD_DIM ** -0.5)
    rel = q_pos[:, :, None] - k_pos[:, None, :]
    valid = (rel >= 0) & (rel < WINDOW) & (k_pos[:, None, :] >= 0)
    s = jnp.where(valid[None, :, None, None], s, -jnp.inf)
    sink = sinks.astype(jnp.float32).reshape(1, 1, ATT_KV_HEADS, ATT_REP, 1, 1)
    m = jnp.maximum(jnp.max(s, axis=-1, keepdims=True), sink)
    p = jnp.exp(s - m)
    denom = jnp.sum(p, axis=-1, keepdims=True) + jnp.exp(sink - m)
    return jnp.einsum('bnhrqk,bnkhd->bnqhrd', p / denom, v.astype(jnp.float32))


def decoder_layer(x, h_ssm, buf_ssm, buf_cf, buf_sc, kv_buf, lp, prompt):
    (norm_w, w_in, ssm_conv_w, ssm_conv_b, dt_bias, a_log, d_skip, ssm_norm_w, w_out_ssm,
     cf_conv_w, cf_conv_b, cf_ln_w, cf_ln_b, w_out_cf, sc_conv_w, w_out_sc,
     sinks, w_out_att, w_o) = lp
    b_, t_, _ = x.shape
    xn = rms_norm(x, norm_w)
    proj = jnp.einsum('btd,de->bte', xn, w_in.astype(x.dtype))
    (z, xbc, dt_raw, cf_in, cf_gate, sc_in, sc_gate,
     q, k, v, att_gate, merge) = jnp.split(proj, _in_offsets(), axis=-1)

    xbc, new_buf_ssm = causal_dwconv(xbc, buf_ssm, ssm_conv_w, ssm_conv_b)
    xbc = jax.nn.silu(xbc)
    xs, bs, cs = jnp.split(xbc, [SSM_INNER, SSM_INNER + SSM_GROUPS * SSM_STATE], axis=-1)
    dt = jax.nn.softplus(dt_raw.astype(jnp.float32) + dt_bias.astype(jnp.float32))
    a = -jnp.exp(a_log.astype(jnp.float32))
    xh = xs.reshape(b_, t_, SSM_HEADS, SSM_HEADDIM)
    y_a, new_h = ssd_scan(xh, dt, a, bs.reshape(b_, t_, SSM_GROUPS, SSM_STATE),
                          cs.reshape(b_, t_, SSM_GROUPS, SSM_STATE), h_ssm)
    y_a = y_a + d_skip.astype(jnp.float32)[:, None] * xh.astype(jnp.float32)
    y_a = y_a.reshape(b_, t_, SSM_INNER).astype(x.dtype) * jax.nn.silu(z)
    out_a = rms_norm(y_a, ssm_norm_w, 1e-5) @ w_out_ssm.astype(x.dtype)

    u = cf_in[..., :CF_WIDTH] * jax.nn.sigmoid(cf_in[..., CF_WIDTH:])
    u, new_buf_cf = causal_dwconv(u, buf_cf, cf_conv_w, cf_conv_b)
    u = jax.nn.silu(layer_norm(u, cf_ln_w, cf_ln_b))
    out_b = (u * jax.nn.silu(cf_gate)) @ w_out_cf.astype(x.dtype)

    gb, gc, sv = jnp.split(sc_in, 3, axis=-1)
    u, new_buf_sc = causal_dwconv(gc * sv, buf_sc, sc_conv_w)
    out_c = (gb * u * jax.nn.silu(sc_gate)) @ w_out_sc.astype(x.dtype)

    q = q.reshape(b_, t_, ATT_KV_HEADS, ATT_REP, ATT_HEAD_DIM)
    k = k.reshape(b_, t_, ATT_KV_HEADS, ATT_HEAD_DIM)
    v = v.reshape(b_, t_, ATT_KV_HEADS, ATT_HEAD_DIM)
    if prompt:
        nb = t_ // ATT_BLOCK
        qb = q.reshape(b_, nb, ATT_BLOCK, ATT_KV_HEADS, ATT_REP, ATT_HEAD_DIM)
        kb = k.reshape(b_, nb, ATT_BLOCK, ATT_KV_HEADS, ATT_HEAD_DIM)
        vb = v.reshape(b_, nb, ATT_BLOCK, ATT_KV_HEADS, ATT_HEAD_DIM)
        k_band = jnp.concatenate([jnp.concatenate([jnp.zeros_like(kb[:, :1]), kb[:, :-1]], axis=1), kb], axis=2)
        v_band = jnp.concatenate([jnp.concatenate([jnp.zeros_like(vb[:, :1]), vb[:, :-1]], axis=1), vb], axis=2)
        pos = jnp.arange(t_, dtype=jnp.int32).reshape(nb, ATT_BLOCK)
        k_pos = jnp.concatenate([pos - ATT_BLOCK, pos], axis=1)
        o = swa_sink_attend(qb, k_band, v_band, pos, k_pos, sinks)
        new_k = k[:, t_ - WIN_BUF:]
        new_v = v[:, t_ - WIN_BUF:]
    else:
        k_buf, v_buf = kv_buf
        k_all = jnp.concatenate([k_buf.astype(k.dtype), k], axis=1)
        v_all = jnp.concatenate([v_buf.astype(v.dtype), v], axis=1)
        q_pos = PAST_LEN + jnp.arange(t_, dtype=jnp.int32)
        k_pos = jnp.concatenate([PAST_LEN - WIN_BUF + jnp.arange(WIN_BUF, dtype=jnp.int32), q_pos])
        o = swa_sink_attend(q[:, None], k_all[:, None], v_all[:, None], q_pos[None], k_pos[None], sinks)
        new_k = k_all[:, t_:]
        new_v = v_all[:, t_:]
    o = o.reshape(b_, t_, ATT_WIDTH).astype(x.dtype)
    out_d = (o * jax.nn.silu(att_gate)) @ w_out_att.astype(x.dtype)

    g = jax.nn.sigmoid(merge.reshape(b_, t_, N_BRANCH, D_MODEL))
    h = g[:, :, 0] * out_a + g[:, :, 1] * out_b + g[:, :, 2] * out_c + g[:, :, 3] * out_d
    x = x + h @ w_o.astype(x.dtype)
    return x, (new_h.astype(h_ssm.dtype), new_buf_ssm, new_buf_cf, new_buf_sc, new_k, new_v)


def setup_inputs(seed: int = 0) -> dict:
    key = jax.random.key(seed)
    ks = jax.random.split(key, 32)
    f32 = jnp.float32

    def nrm(k, shape, scale):
        return jax.random.normal(k, shape, f32) * scale

    dt0 = jnp.exp(jax.random.uniform(ks[12], (DEPTH, SSM_HEADS), f32, math.log(1e-3), math.log(1e-1)))
    return {
        "x_prompt": nrm(ks[0], (BATCH, SEQ, D_MODEL), 1.0),
        "x_sample": nrm(ks[1], (DEC_BATCH, DEC_SEQ, D_MODEL), 1.0),
        "state_ssm": nrm(ks[2], (DEPTH, DEC_BATCH, SSM_HEADS, SSM_HEADDIM, SSM_STATE), 0.5),
        "state_conv_ssm": nrm(ks[3], (DEPTH, DEC_BATCH, SSM_CONV - 1, SSM_CONV_DIM), 1.0),
        "state_conv_cf": nrm(ks[4], (DEPTH, DEC_BATCH, CF_CONV_WIDTH - 1, CF_WIDTH), 1.0),
        "state_conv_sc": nrm(ks[5], (DEPTH, DEC_BATCH, SC_CONV_WIDTH - 1, SC_WIDTH), 1.0),
        "cache_k": nrm(ks[6], (DEPTH, DEC_BATCH, WIN_BUF, ATT_KV_HEADS, ATT_HEAD_DIM), 1.0),
        "cache_v": nrm(ks[7], (DEPTH, DEC_BATCH, WIN_BUF, ATT_KV_HEADS, ATT_HEAD_DIM), 1.0),
        "norm_w": 1.0 + nrm(ks[8], (DEPTH, D_MODEL), 0.02),
        "w_in": nrm(ks[9], (DEPTH, D_MODEL, IN_COLS), D_MODEL ** -0.5),
        "ssm_conv_w": nrm(ks[10], (DEPTH, SSM_CONV, SSM_CONV_DIM), SSM_CONV ** -0.5),
        "ssm_conv_b": nrm(ks[11], (DEPTH, SSM_CONV_DIM), 0.02),
        "ssm_dt_bias": dt0 + jnp.log(-jnp.expm1(-dt0)),
        "ssm_a_log": jnp.log(jax.random.uniform(ks[13], (DEPTH, SSM_HEADS), f32, 1.0, 16.0)),
        "ssm_d": 1.0 + nrm(ks[14], (DEPTH, SSM_HEADS), 0.1),
        "ssm_norm_w": 1.0 + nrm(ks[15], (DEPTH, SSM_INNER), 0.02),
        "w_out_ssm": nrm(ks[16], (DEPTH, SSM_INNER, D_MODEL), SSM_INNER ** -0.5),
        "cf_conv_w": nrm(ks[17], (DEPTH, CF_CONV_WIDTH, CF_WIDTH), CF_CONV_WIDTH ** -0.5),
        "cf_conv_b": nrm(ks[18], (DEPTH, CF_WIDTH), 0.02),
        "cf_ln_w": 1.0 + nrm(ks[19], (DEPTH, CF_WIDTH), 0.02),
        "cf_ln_b": nrm(ks[20], (DEPTH, CF_WIDTH), 0.02),
        "w_out_cf": nrm(ks[21], (DEPTH, CF_WIDTH, D_MODEL), CF_WIDTH ** -0.5),
        "sc_conv_w": nrm(ks[22], (DEPTH, SC_CONV_WIDTH, SC_WIDTH), SC_CONV_WIDTH ** -0.5),
        "w_out_sc": nrm(ks[23], (DEPTH, SC_WIDTH, D_MODEL), SC_WIDTH ** -0.5),
        "att_sinks": nrm(ks[24], (DEPTH, ATT_HEADS), 0.5),
        "w_out_att": nrm(ks[25], (DEPTH, ATT_WIDTH, D_MODEL), ATT_WIDTH ** -0.5),
        "w_o": nrm(ks[26], (DEPTH, D_MODEL, D_MODEL), D_MODEL ** -0.5),
        "final_norm_w": 1.0 + nrm(ks[27], (D_MODEL,), 0.02),
    }


def reference(x_prompt, x_sample, state_ssm, state_conv_ssm, state_conv_cf, state_conv_sc,
              cache_k, cache_v, norm_w, w_in, ssm_conv_w, ssm_conv_b, ssm_dt_bias, ssm_a_log,
              ssm_d, ssm_norm_w, w_out_ssm, cf_conv_w, cf_conv_b, cf_ln_w, cf_ln_b, w_out_cf,
              sc_conv_w, w_out_sc, att_sinks, w_out_att, w_o, final_norm_w):
    layer_params = [(norm_w[l], w_in[l], ssm_conv_w[l], ssm_conv_b[l], ssm_dt_bias[l], ssm_a_log[l],
                     ssm_d[l], ssm_norm_w[l], w_out_ssm[l], cf_conv_w[l], cf_conv_b[l], cf_ln_w[l],
                     cf_ln_b[l], w_out_cf[l], sc_conv_w[l], w_out_sc[l], att_sinks[l], w_out_att[l], w_o[l])
                    for l in range(DEPTH)]

    bp = x_prompt.shape[0]
    dtp = x_prompt.dtype
    xp = x_prompt
    p_states = []
    for l in range(DEPTH):
        xp, st = decoder_layer(
            xp,
            jnp.zeros((bp, SSM_HEADS, SSM_HEADDIM, SSM_STATE), dtp),
            jnp.zeros((bp, SSM_CONV - 1, SSM_CONV_DIM), dtp),
            jnp.zeros((bp, CF_CONV_WIDTH - 1, CF_WIDTH), dtp),
            jnp.zeros((bp, SC_CONV_WIDTH - 1, SC_WIDTH), dtp),
            None, layer_params[l], True)
        p_states.append(st)
    y_prompt = rms_norm(xp, final_norm_w)

    xs = x_sample
    s_states = []
    for l in range(DEPTH):
        xs, st = decoder_layer(xs, state_ssm[l], state_conv_ssm[l], state_conv_cf[l], state_conv_sc[l],
                               (cache_k[l], cache_v[l]), layer_params[l], False)
        s_states.append(st)
    y_sample = rms_norm(xs, final_norm_w)

    p_ssm, p_conv_ssm, p_conv_cf, p_conv_sc, p_k, p_v = [jnp.stack(s, axis=0) for s in zip(*p_states)]
    s_ssm, s_conv_ssm, s_conv_cf, s_conv_sc, s_k, s_v = [jnp.stack(s, axis=0) for s in zip(*s_states)]
    return (y_prompt, y_sample, p_ssm, p_conv_ssm, p_conv_cf, p_conv_sc, p_k, p_v,
            s_ssm, s_conv_ssm, s_conv_cf, s_conv_sc, s_k, s_v)
```

```cpp
#include <hip/hip_runtime.h>
#include <hip/hip_cooperative_groups.h>
#include <cstdio>
#include <cstdint>
namespace cg = cooperative_groups;

#ifndef GEMM_MASK
#define GEMM_MASK 7
#endif
#ifndef ITEM_MASK
#define ITEM_MASK 127
#endif
#ifndef PROBE_CHECK
#define PROBE_CHECK 0
#endif

#define LAS __attribute__((address_space(3)))
typedef unsigned short bf16;
typedef short bf16x8 __attribute__((ext_vector_type(8)));
typedef float f32x4 __attribute__((ext_vector_type(4)));
typedef float f32x2 __attribute__((ext_vector_type(2)));
typedef unsigned u32x4 __attribute__((ext_vector_type(4)));
typedef unsigned u32x2 __attribute__((ext_vector_type(2)));
typedef unsigned long long u64;

constexpr int DM = 2048, TP = 8192, TS = 1024, TT = TP + TS, NL = 2;
constexpr int PB = 4, PSEQ = 2048, SB = 128, SSEQ = 8;
constexpr int IN_COLS = 21008, NT1 = 83, N1 = NT1 * 256;
constexpr int HEADS = 16, HD = 64, GROUPS = 4, NST = 128, CHUNK = 128, NCH = PSEQ / CHUNK;
constexpr int XBC_W = 2048, CFW = 1024, SCW = 1024;
constexpr int C_Z = 0, C_XBC = 1024, C_DT = 3072, C_CFA = 3088, C_CFB = 4112, C_CFG = 5136, C_GB = 6160, C_GC = 7184, C_SV = 8208, C_SCG = 9232,
              C_Q = 10256, C_K = 11280, C_V = 11536, C_AG = 11792, C_MG = 12816;

constexpr size_t MiB = 1u << 20;
constexpr size_t WS_CTL = 0, CTL_BYTES = 1 * MiB;
constexpr size_t WS_SSQ = 1 * MiB;
constexpr size_t WS_SSQA = 2 * MiB;
constexpr size_t WS_W1T = 16 * MiB;
constexpr size_t W1T_L = (size_t)N1 * DM * 2;
constexpr size_t WS_W2T = 192 * MiB;
constexpr size_t W2T_L = (size_t)DM * 4096 * 2;
constexpr size_t WS_W3T = 224 * MiB;
constexpr size_t W3T_L = (size_t)DM * DM * 2;
constexpr size_t WS_XB = 240 * MiB;
constexpr size_t WS_Z = 276 * MiB;
constexpr size_t WS_XBC = 294 * MiB;
constexpr size_t WS_U = 330 * MiB;
constexpr size_t WS_CFG = 348 * MiB;
constexpr size_t WS_CV = 366 * MiB;
constexpr size_t WS_CM = 384 * MiB;
constexpr size_t WS_Q = 402 * MiB;
constexpr size_t WS_KV = 420 * MiB;
constexpr size_t WS_AG = 429 * MiB;
constexpr size_t WS_MG = 447 * MiB;
constexpr size_t WS_DT = 591 * MiB;
constexpr size_t WS_ACT = 592 * MiB;
constexpr size_t WS_H = 664 * MiB;
constexpr size_t WS_CST = 700 * MiB;
constexpr size_t WS_HPREV = 732 * MiB;
constexpr size_t WS_CDEC = 748 * MiB;
constexpr size_t WS_SCR = 749 * MiB;
constexpr size_t WS_DBG = 813 * MiB;
constexpr size_t WS_END = 814 * MiB;

constexpr int LDS_BYTES = 147456;

__device__ __forceinline__ float bf2f(unsigned v) { return __uint_as_float(v << 16); }
__device__ __forceinline__ unsigned f2bf(float f) { unsigned u = __float_as_uint(f); return (u + 0x7fffu + ((u >> 16) & 1u)) >> 16; }
__device__ __forceinline__ unsigned pk2(float lo, float hi) { return f2bf(lo) | (f2bf(hi) << 16); }
__device__ __forceinline__ float fsigmoid(float x) { return __builtin_amdgcn_rcpf(1.0f + __expf(-x)); }
__device__ __forceinline__ float fsilu(float x) { return x * fsigmoid(x); }
__device__ __forceinline__ float fsoftplus(float x) { return x > 15.f ? x : log1pf(__expf(x)); }
__device__ __forceinline__ float ssq_to_rstd(u64 s, float inv_n, float eps) { return rsqrtf((float)((double)s * (1.0 / 1048576.0)) * inv_n + eps); }
__device__ __forceinline__ u64 ssq_fix(float s) { return (u64)((double)s * 1048576.0 + 0.5); }
#define LDS_WAIT() asm volatile("s_waitcnt lgkmcnt(0)" ::: "memory")
__device__ __forceinline__ int fresh_lane() { int ln = (int)__builtin_amdgcn_mbcnt_hi(~0u, __builtin_amdgcn_mbcnt_lo(~0u, 0u)); asm volatile("" : "+v"(ln)); return ln; }

struct TileInfo { int mode, src0, src1, valid0, valid1; size_t dst; int ld, col0; };
enum { M_ID = 0, M_SILU = 1, M_SIG = 2, M_GLU = 3, M_MUL = 4, M_ASILUB = 5, M_DT = 6 };
__host__ __device__ __forceinline__ TileInfo tile_info(int pn) {
    TileInfo t; t.valid0 = 128; t.valid1 = 128;
    if (pn < 4)       { t.mode = M_SILU;   t.src0 = C_Z + 256 * pn;           t.src1 = t.src0 + 128; t.dst = WS_Z;   t.ld = 1024; t.col0 = 256 * pn; }
    else if (pn < 12) { t.mode = M_ID;     t.src0 = C_XBC + 256 * (pn - 4);   t.src1 = t.src0 + 128; t.dst = WS_XBC; t.ld = 2048; t.col0 = 256 * (pn - 4); }
    else if (pn < 20) { t.mode = M_GLU;    t.src0 = C_CFA + 128 * (pn - 12);  t.src1 = C_CFB + 128 * (pn - 12); t.dst = WS_U; t.ld = 1024; t.col0 = 128 * (pn - 12); }
    else if (pn < 24) { t.mode = M_SILU;   t.src0 = C_CFG + 256 * (pn - 20);  t.src1 = t.src0 + 128; t.dst = WS_CFG; t.ld = 1024; t.col0 = 256 * (pn - 20); }
    else if (pn < 32) { t.mode = M_MUL;    t.src0 = C_GC + 128 * (pn - 24);   t.src1 = C_SV + 128 * (pn - 24); t.dst = WS_CV; t.ld = 1024; t.col0 = 128 * (pn - 24); }
    else if (pn < 40) { t.mode = M_ASILUB; t.src0 = C_GB + 128 * (pn - 32);   t.src1 = C_SCG + 128 * (pn - 32); t.dst = WS_CM; t.ld = 1024; t.col0 = 128 * (pn - 32); }
    else if (pn < 44) { t.mode = M_ID;     t.src0 = C_Q + 256 * (pn - 40);    t.src1 = t.src0 + 128; t.dst = WS_Q;   t.ld = 1024; t.col0 = 256 * (pn - 40); }
    else if (pn < 46) { t.mode = M_ID;     t.src0 = C_K + 256 * (pn - 44);    t.src1 = t.src0 + 128; t.dst = WS_KV;  t.ld = 512;  t.col0 = 256 * (pn - 44); }
    else if (pn < 50) { t.mode = M_SILU;   t.src0 = C_AG + 256 * (pn - 46);   t.src1 = t.src0 + 128; t.dst = WS_AG;  t.ld = 1024; t.col0 = 256 * (pn - 46); }
    else if (pn < 82) { t.mode = M_SIG;    t.src0 = C_MG + 256 * (pn - 50);   t.src1 = t.src0 + 128; t.dst = WS_MG;  t.ld = 8192; t.col0 = 256 * (pn - 50); }
    else              { t.mode = M_DT;     t.src0 = C_DT; t.src1 = 0; t.valid0 = 16; t.valid1 = 0; t.dst = WS_DT; t.ld = 16; t.col0 = 0; }
    return t;
}

namespace pg8 {
constexpr int BM = 256, BK = 64, HALF = 128, HTB = HALF * BK * 2, STAGE_BYTES = 8 * HTB, NXCD = 8, WGM = 8;
__host__ __device__ __forceinline__ int lds_byte(int r, int c) { const int st = (r >> 4) * 2 + (c >> 5), rr = r & 15, cc = c & 31, ob = rr * 64 + cc * 2; return st * 1024 + (ob ^ (((ob >> 9) & 1) << 5)); }
__host__ __device__ __forceinline__ void stage_rc(int b, int& R, int& C) { const int st = b / 1024, sb = b % 1024, swz = sb ^ (((sb >> 9) & 1) << 5); R = (st >> 1) * 16 + swz / 64; C = (st & 1) * 32 + (swz % 64) / 2; }
__host__ __device__ __forceinline__ int perm32(int rho) { const int n = rho >> 4, i = rho & 15; return 8 * (i >> 2) + 4 * n + (i & 3); }

struct Unit { int pm, pn, sub; };
struct Gemm { const bf16* A; const bf16* Bt; int lda, ldb, nt, ksubA, ksubB; };

struct Order {
    int nM, nN, nwg, G, c, nsub;
    __device__ void init(int nM_, int nN_, int G_, int c_, int nsub_) { nM = nM_; nN = nN_; nwg = nM * nN; G = G_; c = c_; nsub = nsub_; }
    __device__ bool next(int i, Unit& u) const {
        const int gi = i / nsub; u.sub = i - gi * nsub;
        const long L = (long)gi * G + c; if (L >= nwg) return false;
        int wgid = (int)L; { const int q = nwg / NXCD, r = nwg % NXCD, xcd = wgid % NXCD, off = wgid / NXCD; wgid = (xcd < r ? xcd * (q + 1) : r * (q + 1) + (xcd - r) * q) + off; }
        const int nig = WGM * nN, gid = wgid / nig, fm = gid * WGM, gsz = (nM - fm) < WGM ? (nM - fm) : WGM;
        u.pm = fm + ((wgid % nig) % gsz); u.pn = (wgid % nig) / gsz; return true;
    }
};

template <class Epi>
__device__ __forceinline__ void gemm_phase(LAS unsigned char* lds, const Gemm g, const Order& S, const Epi& E) {
    const int tid = threadIdx.x, wid = __builtin_amdgcn_readfirstlane(tid >> 6), lane = tid & 63, wr = wid >> 2, wc = wid & 3, fr = lane & 15, fq = lane >> 4;
    const int nt = g.nt;
    unsigned voffA[2], voffB[2];
#pragma unroll
    for (int i = 0; i < 2; ++i) { int R, C; stage_rc(tid * 16 + i * 8192, R, C); const int Rb = Epi::PERM ? ((R & ~31) + perm32(R & 31)) : R;
        voffA[i] = (unsigned)(R * g.lda + C) * 2u; voffB[i] = (unsigned)(Rb * g.ldb + C) * 2u; }
    const size_t kstep = (size_t)(BK * 2);
    const size_t hstepA = (size_t)HALF * g.lda * 2, hstepB = (size_t)HALF * g.ldb * 2;
    const size_t tstepA = 2 * hstepA, tstepB = 2 * hstepB;
    const unsigned ldsw = (unsigned)wid * 1024u;
    const int aoff = lds_byte(wr * 64 + fr, fq * 8), boff = lds_byte(wc * 32 + fr, fq * 8);
#define PG8_SA(b, h) (((b) * 2 + (h)) * HTB)
#define PG8_SB(b, h) ((4 + (b) * 2 + (h)) * HTB)
#define PG8_STAGE(bufoff, gbase, voff) do { _Pragma("unroll") for (int _i = 0; _i < 2; ++_i) \
        __builtin_amdgcn_global_load_lds((const unsigned*)((const char*)(gbase) + (voff)[_i]), (LAS unsigned*)(lds + (bufoff) + ldsw + _i * 8192), 16, 0, 0); } while (0)
#define PG8_LDA(dst, b, h) do { _Pragma("unroll") for (int m = 0; m < 4; ++m) _Pragma("unroll") for (int k = 0; k < 2; ++k) dst[m][k] = *(const LAS bf16x8*)(lds + PG8_SA(b, h) + aoff + m * 2048 + k * 1024); } while (0)
#define PG8_LDB(dst, b, h) do { _Pragma("unroll") for (int n = 0; n < 2; ++n) _Pragma("unroll") for (int k = 0; k < 2; ++k) dst[n][k] = *(const LAS bf16x8*)(lds + PG8_SB(b, h) + boff + n * 2048 + k * 1024); } while (0)
#define PG8_MMA(ai, bj, At, Bt) do { __builtin_amdgcn_s_setprio(1); _Pragma("unroll") for (int m = 0; m < 4; ++m) _Pragma("unroll") for (int n = 0; n < 2; ++n) _Pragma("unroll") for (int k = 0; k < 2; ++k) \
        acc[ai][bj][m][n] = __builtin_amdgcn_mfma_f32_16x16x32_bf16(Bt[n][k], At[m][k], acc[ai][bj][m][n], 0, 0, 0); __builtin_amdgcn_s_setprio(0); } while (0)
#define PG8_WAIT_V(n) asm volatile("s_waitcnt vmcnt(" #n ")" ::: "memory")
#define PG8_WAIT_L(n) asm volatile("s_waitcnt lgkmcnt(" #n ")" ::: "memory")
#define PG8_BAR __builtin_amdgcn_s_barrier()
#define PG8_SCHED __builtin_amdgcn_sched_barrier(0)
    Unit cur, nxt; int ui = 0;
    if (!S.next(0, cur)) return;
    f32x4 acc[2][2][4][2];
#pragma unroll
    for (int a = 0; a < 2; ++a)
#pragma unroll
        for (int b = 0; b < 2; ++b)
#pragma unroll
            for (int m = 0; m < 4; ++m)
#pragma unroll
                for (int n = 0; n < 2; ++n) acc[a][b][m][n] = (f32x4){0.f, 0.f, 0.f, 0.f};
    bf16x8 At[4][2], B0[2][2], B1[2][2];
    const char* cA = (const char*)g.A + (size_t)cur.pm * tstepA + (size_t)cur.sub * g.ksubA * 2; const char* cB = (const char*)g.Bt + (size_t)cur.pn * tstepB + (size_t)cur.sub * g.ksubB * 2;
    PG8_STAGE(PG8_SB(0, 0), cB, voffB); PG8_STAGE(PG8_SB(0, 1), cB + hstepB, voffB); PG8_STAGE(PG8_SA(0, 0), cA, voffA); PG8_STAGE(PG8_SA(0, 1), cA + hstepA, voffA);
    if (wr == 1) PG8_BAR;
    PG8_WAIT_V(2); PG8_BAR;
    PG8_STAGE(PG8_SB(1, 0), cB + kstep, voffB); PG8_STAGE(PG8_SA(1, 0), cA + kstep, voffA); PG8_STAGE(PG8_SB(1, 1), cB + hstepB + kstep, voffB);
    PG8_WAIT_V(6); PG8_BAR;
    for (;;) {
        const bool has_next = S.next(ui + 1, nxt);
        const char* nA = has_next ? (const char*)g.A + (size_t)nxt.pm * tstepA + (size_t)nxt.sub * g.ksubA * 2 : cA;
        const char* nB = has_next ? (const char*)g.Bt + (size_t)nxt.pn * tstepB + (size_t)nxt.sub * g.ksubB * 2 : cB;
        for (int t = 0; t < nt; t += 2) {
            const bool last = (t == nt - 2);
            const char* a1 = cA + (size_t)(t + 1) * kstep;
            const char* a2 = last ? nA : cA + (size_t)(t + 2) * kstep; const char* b2 = last ? nB : cB + (size_t)(t + 2) * kstep;
            const char* a3 = a2 + kstep; const char* b3 = b2 + kstep;
            PG8_LDB(B0, 0, 0); PG8_LDB(B1, 0, 1); PG8_SCHED; PG8_LDA(At, 0, 0); PG8_STAGE(PG8_SA(1, 1), a1 + hstepA, voffA);
            PG8_WAIT_V(8); PG8_WAIT_L(0); PG8_BAR; PG8_MMA(0, 0, At, B0); PG8_MMA(0, 1, At, B1); PG8_BAR; PG8_SCHED;
            PG8_LDA(At, 0, 1); PG8_STAGE(PG8_SB(0, 0), b2, voffB); PG8_STAGE(PG8_SB(0, 1), b2 + hstepB, voffB); PG8_STAGE(PG8_SA(0, 0), a2, voffA);
            PG8_WAIT_V(8); PG8_WAIT_L(0); PG8_BAR; PG8_MMA(1, 0, At, B0); PG8_MMA(1, 1, At, B1); PG8_BAR; PG8_SCHED;
            PG8_LDB(B0, 1, 0); PG8_LDB(B1, 1, 1); PG8_SCHED; PG8_LDA(At, 1, 0); PG8_STAGE(PG8_SA(0, 1), a2 + hstepA, voffA);
            PG8_WAIT_V(8); PG8_WAIT_L(0); PG8_BAR; PG8_MMA(0, 0, At, B0); PG8_MMA(0, 1, At, B1); PG8_BAR; PG8_SCHED;
            PG8_LDA(At, 1, 1); PG8_STAGE(PG8_SB(1, 0), b3, voffB); PG8_STAGE(PG8_SB(1, 1), b3 + hstepB, voffB); PG8_STAGE(PG8_SA(1, 0), a3, voffA);
            PG8_WAIT_V(8); PG8_WAIT_L(0); PG8_BAR; PG8_MMA(1, 0, At, B0); PG8_MMA(1, 1, At, B1); PG8_BAR; PG8_SCHED;
        }
        if (wr == 0) PG8_BAR;
        E(acc, cur, wr, wc, fr, fq);
        if (!has_next) break;
#pragma unroll
        for (int a = 0; a < 2; ++a)
#pragma unroll
            for (int b = 0; b < 2; ++b)
#pragma unroll
                for (int m = 0; m < 4; ++m)
#pragma unroll
                    for (int n = 0; n < 2; ++n) acc[a][b][m][n] = (f32x4){0.f, 0.f, 0.f, 0.f};
        cur = nxt; cA = nA; cB = nB; ++ui;
        if (wr == 1) PG8_BAR;
    }
    PG8_WAIT_V(0);
    PG8_BAR;
#undef PG8_SA
#undef PG8_SB
#undef PG8_STAGE
#undef PG8_LDA
#undef PG8_LDB
#undef PG8_MMA
#undef PG8_WAIT_V
#undef PG8_WAIT_L
#undef PG8_BAR
#undef PG8_SCHED
}
}

struct Epi1 {
    static constexpr bool PERM = true;
    unsigned char* ws; const u64* ssq; const float* dt_bias;
    __device__ __forceinline__ void operator()(const f32x4 (&acc)[2][2][4][2], const pg8::Unit& u, int wr, int wc, int fr, int fq) const {
        const TileInfo ti = tile_info(u.pn);
        { const int ln = fresh_lane(); fr = ln & 15; fq = ln >> 4; }
        const int row0 = u.pm * 256 + wr * 64 + fr;
        float rs[2][4];
#pragma unroll
        for (int ai = 0; ai < 2; ++ai)
#pragma unroll
            for (int m = 0; m < 4; ++m) rs[ai][m] = ssq_to_rstd(ssq[row0 + ai * 128 + m * 16], 1.0f / 2048.0f, 1e-6f);
        const int cl = wc * 32 + 8 * fq;
        if (ti.mode <= M_SIG) {
            bf16* base = (bf16*)(ws + ti.dst) + ti.col0 + cl;
#pragma unroll
            for (int ai = 0; ai < 2; ++ai)
#pragma unroll
                for (int m = 0; m < 4; ++m) { bf16* rowp = base + (size_t)(row0 + ai * 128 + m * 16) * ti.ld; const float r = rs[ai][m];
#pragma unroll
                    for (int bj = 0; bj < 2; ++bj) { float v[8];
#pragma unroll
                        for (int j = 0; j < 4; ++j) { v[j] = acc[ai][bj][m][0][j] * r; v[4 + j] = acc[ai][bj][m][1][j] * r; }
                        if (ti.mode == M_SILU) {
#pragma unroll
                            for (int j = 0; j < 8; ++j) v[j] = fsilu(v[j]); }
                        else if (ti.mode == M_SIG) {
#pragma unroll
                            for (int j = 0; j < 8; ++j) v[j] = fsigmoid(v[j]); }
                        u32x4 w; w.x = pk2(v[0], v[1]); w.y = pk2(v[2], v[3]); w.z = pk2(v[4], v[5]); w.w = pk2(v[6], v[7]);
                        *(u32x4*)(rowp + bj * 128) = w; } }
        } else if (ti.mode != M_DT) {
            bf16* base = (bf16*)(ws + ti.dst) + ti.col0 + cl;
#pragma unroll
            for (int ai = 0; ai < 2; ++ai)
#pragma unroll
                for (int m = 0; m < 4; ++m) { bf16* rowp = base + (size_t)(row0 + ai * 128 + m * 16) * ti.ld; const float r = rs[ai][m]; float v[8];
#pragma unroll
                    for (int j = 0; j < 8; ++j) { const float a = acc[ai][0][m][j >> 2][j & 3] * r, b = acc[ai][1][m][j >> 2][j & 3] * r;
                        v[j] = ti.mode == M_GLU ? a * fsigmoid(b) : (ti.mode == M_MUL ? a * b : a * fsilu(b)); }
                    u32x4 w; w.x = pk2(v[0], v[1]); w.y = pk2(v[2], v[3]); w.z = pk2(v[4], v[5]); w.w = pk2(v[6], v[7]);
                    *(u32x4*)rowp = w; }
        } else {
            if (wc == 0 && fq < 2) {
                float* base = (float*)(ws + ti.dst) + 8 * fq;
                const f32x4 b0 = *(const f32x4*)(dt_bias + 8 * fq), b1 = *(const f32x4*)(dt_bias + 8 * fq + 4);
#pragma unroll
                for (int ai = 0; ai < 2; ++ai)
#pragma unroll
                    for (int m = 0; m < 4; ++m) { float* rowp = base + (size_t)(row0 + ai * 128 + m * 16) * 16; const float r = rs[ai][m]; f32x4 o0, o1;
#pragma unroll
                        for (int j = 0; j < 4; ++j) { o0[j] = fsoftplus(acc[ai][0][m][0][j] * r + b0[j]); o1[j] = fsoftplus(acc[ai][0][m][1][j] * r + b1[j]); }
                        *(f32x4*)rowp = o0; *(f32x4*)(rowp + 4) = o1; }
            }
        }
    }
};

struct Args { const float* in[28]; float* out; unsigned char* ws; int ph_lo, ph_hi; };
enum { I_XP = 0, I_XS, I_SSM, I_CSSM, I_CCF, I_CSC, I_CK, I_CVV, I_NORMW, I_WIN, I_SCONVW, I_SCONVB, I_DTB, I_ALOG, I_DSKIP, I_SNORMW, I_WOSSM,
       I_CFCW, I_CFCB, I_CFLNW, I_CFLNB, I_WOCF, I_SCCW, I_WOSC, I_SINK, I_WOATT, I_WO, I_FNW };

__device__ __forceinline__ void transpose_item(const float* W, size_t ldw, int src, int valid, const float* ks, int k0, bf16* dst, size_t ldk, int dk0, LAS float* scr, int lane) {
#pragma unroll 8
    for (int i = 0; i < 32; ++i) { const int kk = 2 * i + (lane >> 5), j = lane & 31; float v = 0.f;
        if (j < valid) { v = W[(size_t)(k0 + kk) * ldw + src + j]; if (ks) v *= ks[k0 + kk]; }
        scr[kk * 33 + j] = v; }
    LDS_WAIT(); asm volatile("" ::: "memory");
    const int c = lane & 7;
#pragma unroll
    for (int j = 0; j < 4; ++j) { const int n = (lane >> 3) + 8 * j; const LAS float* s = scr + (8 * c) * 33 + n;
        u32x4 o; o.x = pk2(s[0 * 33], s[1 * 33]); o.y = pk2(s[2 * 33], s[3 * 33]); o.z = pk2(s[4 * 33], s[5 * 33]); o.w = pk2(s[6 * 33], s[7 * 33]);
        *(u32x4*)(dst + (size_t)n * ldk + dk0 + k0 + 8 * c) = o; }
    LDS_WAIT(); asm volatile("" ::: "memory");
}
__device__ __forceinline__ float wave_sum(float v) {
#pragma unroll
    for (int o = 1; o < 64; o <<= 1) v += __shfl_xor(v, o);
    return v;
}

__device__ __forceinline__ void phase_prologue(const Args& a, LAS unsigned char* lds, int gw, int ngw, int wave, int lane) {
    LAS float* scr = (LAS float*)(lds + wave * 16384);
    constexpr int I1 = (DM / 64) * (N1 / 32), I2 = 4 * (1024 / 64) * (DM / 32), I3 = (DM / 64) * (DM / 32), IL = I1 + I2 + I3;
    for (int it = gw; it < NL * IL; it += ngw) {
        const int l = it / IL; int r = it - l * IL;
        if (r < I1) {
            const int nb = r % (N1 / 32), kb = r / (N1 / 32), pn = nb >> 3, sb = nb & 7, half = sb >> 2;
            const TileInfo ti = tile_info(pn);
            const int src = (half ? ti.src1 : ti.src0) + (sb & 3) * 32; int valid = (half ? ti.valid1 : ti.valid0) - (sb & 3) * 32; valid = valid < 0 ? 0 : (valid > 32 ? 32 : valid);
            transpose_item(a.in[I_WIN] + (size_t)l * DM * IN_COLS, IN_COLS, src, valid, a.in[I_NORMW] + l * DM, kb * 64,
                           (bf16*)(a.ws + WS_W1T + l * W1T_L) + (size_t)(nb * 32) * DM, DM, 0, scr, lane);
            continue; }
        r -= I1;
        if (r < I2) {
            const int br = r / (I2 / 4), rr = r % (I2 / 4), nb = rr % (DM / 32), kb = rr / (DM / 32);
            const float* W = a.in[br == 0 ? I_WOSSM : (br == 1 ? I_WOCF : (br == 2 ? I_WOSC : I_WOATT))] + (size_t)l * 1024 * DM;
            transpose_item(W, DM, nb * 32, 32, br == 0 ? a.in[I_SNORMW] + l * 1024 : nullptr, kb * 64,
                           (bf16*)(a.ws + WS_W2T + l * W2T_L) + (size_t)(nb * 32) * 4096, 4096, br * 1024, scr, lane);
            continue; }
        r -= I2;
        { const int nb = r % (DM / 32), kb = r / (DM / 32);
          transpose_item(a.in[I_WO] + (size_t)l * DM * DM, DM, nb * 32, 32, nullptr, kb * 64, (bf16*)(a.ws + WS_W3T + l * W3T_L) + (size_t)(nb * 32) * DM, DM, 0, scr, lane); }
    }
    for (int m = gw; m < TT; m += ngw) {
        const float* xr = (m < TP) ? a.in[I_XP] + (size_t)m * DM : a.in[I_XS] + (size_t)(m - TP) * DM;
        const f32x4* x4 = (const f32x4*)xr + lane; u64* o8 = (u64*)((bf16*)(a.ws + WS_XB) + (size_t)m * DM) + lane; float s = 0.f;
#pragma unroll
        for (int j = 0; j < 8; ++j) { const f32x4 v = x4[64 * j]; s += (v.x * v.x + v.y * v.y) + (v.z * v.z + v.w * v.w); o8[64 * j] = (u64)pk2(v.x, v.y) | ((u64)pk2(v.z, v.w) << 32); }
        s = wave_sum(s);
        if (lane == 0) ((u64*)(a.ws + WS_SSQ))[m] = ssq_fix(s);
    }
    for (int i = gw * 64 + lane; i < 2 * TT; i += ngw * 64) { ((u64*)(a.ws + WS_SSQ))[TT + i] = 0ull; ((u64*)(a.ws + WS_SSQA))[i] = 0ull; }
}


constexpr size_t O_YP = 0, O_YS = 16777216, O_PSSM = 18874368, O_PCSSM = 19922944, O_PCCF = 19972096, O_PCSC = 20217856, O_PK = 20234240, O_PV = 20496384,
                 O_SSSM = 20758528, O_SCSSM = 54312960, O_SCCF = 55885824, O_SCSC = 63750144, O_SK = 64274432, O_SV = 72663040, O_TOTAL = 81051648;

template <bool SAMPLE>
__device__ __forceinline__ void conv_item(const Args& a, int l, int item, LAS unsigned char* lds, int tid, int wave, int lane) {
    asm volatile("" : "+v"(tid), "+v"(lane), "+s"(wave), "+s"(item));
    constexpr int NT = SAMPLE ? 8 : 16;
    int b, row0, t0;
    if (SAMPLE) { b = item; t0 = 0; row0 = TP + 8 * b; } else { b = item >> 7; t0 = (item & 127) * 16; row0 = b * PSEQ + t0; }
    const bf16* U = (const bf16*)(a.ws + WS_U); const bf16* CV = (const bf16*)(a.ws + WS_CV); const bf16* CM = (const bf16*)(a.ws + WS_CM);
    const bf16* CFG = (const bf16*)(a.ws + WS_CFG); const bf16* XBC = (const bf16*)(a.ws + WS_XBC); bf16* ACT = (bf16*)(a.ws + WS_ACT);
    const int c0 = 2 * tid;
    __syncthreads();
    {
        f32x2 wk[31];
        const float* cw = a.in[I_CFCW] + (size_t)l * 31 * 1024 + c0;
#pragma unroll
        for (int k = 0; k < 31; ++k) wk[k] = *(const f32x2*)(cw + k * 1024);
        const f32x2 bias = *(const f32x2*)(a.in[I_CFCB] + l * 1024 + c0);
        float acc0[NT], acc1[NT];
#pragma unroll
        for (int t = 0; t < NT; ++t) { acc0[t] = bias.x; acc1[t] = bias.y; }
#pragma unroll
        for (int r = -30; r < NT; ++r) {
            float v0, v1;
            if (SAMPLE && r < 0) { const f32x2 sv = *(const f32x2*)(a.in[I_CCF] + (((size_t)l * SB + b) * 30 + (30 + r)) * 1024 + c0); v0 = sv.x; v1 = sv.y; }
            else if (!SAMPLE && t0 + r < 0) { v0 = 0.f; v1 = 0.f; }
            else { const unsigned w = *(const unsigned*)(U + (size_t)(row0 + r) * 1024 + c0); v0 = bf2f(w & 0xffffu); v1 = bf2f(w >> 16); }
#pragma unroll
            for (int t = 0; t < NT; ++t) { const int k = r - t + 30; if (k >= 0 && k <= 30) { acc0[t] += wk[k].x * v0; acc1[t] += wk[k].y * v1; } }
        }
        LAS float* tile = (LAS float*)lds;
#pragma unroll
        for (int t = 0; t < NT; ++t) *(LAS f32x2*)(tile + t * 1024 + c0) = (f32x2){acc0[t], acc1[t]};
    }
    __syncthreads();
    {
        LAS float* tile = (LAS float*)lds;
#pragma unroll
        for (int tt = 0; tt < NT / 8; ++tt) {
            const int t = wave + 8 * tt; const int row = row0 + t;
            f32x4 x[4]; float s = 0.f;
#pragma unroll
            for (int j = 0; j < 4; ++j) { x[j] = *(LAS f32x4*)(tile + t * 1024 + 256 * j + 4 * lane); s += (x[j].x + x[j].y) + (x[j].z + x[j].w); }
            const float mean = wave_sum(s) * (1.f / 1024.f); float q = 0.f;
#pragma unroll
            for (int j = 0; j < 4; ++j) { x[j] = x[j] - mean; q += (x[j].x * x[j].x + x[j].y * x[j].y) + (x[j].z * x[j].z + x[j].w * x[j].w); }
            const float rstd = rsqrtf(wave_sum(q) * (1.f / 1024.f) + 1e-5f);
#pragma unroll
            for (int j = 0; j < 4; ++j) { const int c = 256 * j + 4 * lane;
                const f32x4 lw = *(const f32x4*)(a.in[I_CFLNW] + l * 1024 + c), lb = *(const f32x4*)(a.in[I_CFLNB] + l * 1024 + c);
                const u32x2 gw = *(const u32x2*)(CFG + (size_t)row * 1024 + c);
                float y[4];
#pragma unroll
                for (int e = 0; e < 4; ++e) y[e] = fsilu(x[j][e] * rstd * lw[e] + lb[e]);
                y[0] *= bf2f(gw.x & 0xffffu); y[1] *= bf2f(gw.x >> 16); y[2] *= bf2f(gw.y & 0xffffu); y[3] *= bf2f(gw.y >> 16);
                u32x2 o; o.x = pk2(y[0], y[1]); o.y = pk2(y[2], y[3]);
                *(u32x2*)(ACT + (size_t)row * 4096 + 1024 + c) = o; }
        }
    }
    {
        f32x2 w3[3];
#pragma unroll
        for (int k = 0; k < 3; ++k) w3[k] = *(const f32x2*)(a.in[I_SCCW] + (size_t)l * 3 * 1024 + k * 1024 + c0);
        f32x2 in[NT + 2];
#pragma unroll
        for (int r = -2; r < NT; ++r) {
            if (SAMPLE && r < 0) in[r + 2] = *(const f32x2*)(a.in[I_CSC] + (((size_t)l * SB + b) * 2 + (2 + r)) * 1024 + c0);
            else if (!SAMPLE && t0 + r < 0) in[r + 2] = (f32x2){0.f, 0.f};
            else { const unsigned w = *(const unsigned*)(CV + (size_t)(row0 + r) * 1024 + c0); in[r + 2] = (f32x2){bf2f(w & 0xffffu), bf2f(w >> 16)}; }
        }
#pragma unroll
        for (int t = 0; t < NT; ++t) {
            const unsigned mw = *(const unsigned*)(CM + (size_t)(row0 + t) * 1024 + c0);
            const float y0 = (w3[0].x * in[t].x + w3[1].x * in[t + 1].x + w3[2].x * in[t + 2].x) * bf2f(mw & 0xffffu);
            const float y1 = (w3[0].y * in[t].y + w3[1].y * in[t + 1].y + w3[2].y * in[t + 2].y) * bf2f(mw >> 16);
            *(unsigned*)(ACT + (size_t)(row0 + t) * 4096 + 2048 + c0) = pk2(y0, y1);
        }
    }
    if (SAMPLE) {
        float* o_cf = a.out + O_SCCF + ((size_t)l * SB + b) * 30 * 1024 + c0;
        for (int rr = 0; rr < 30; ++rr) { f32x2 v;
            if (rr < 22) v = *(const f32x2*)(a.in[I_CCF] + (((size_t)l * SB + b) * 30 + rr + 8) * 1024 + c0);
            else { const unsigned w = *(const unsigned*)(U + (size_t)(row0 + rr - 22) * 1024 + c0); v = (f32x2){bf2f(w & 0xffffu), bf2f(w >> 16)}; }
            *(f32x2*)(o_cf + (size_t)rr * 1024) = v; }
        float* o_sc = a.out + O_SCSC + ((size_t)l * SB + b) * 2 * 1024 + c0;
        for (int rr = 0; rr < 2; ++rr) { const unsigned w = *(const unsigned*)(CV + (size_t)(row0 + 6 + rr) * 1024 + c0); *(f32x2*)(o_sc + rr * 1024) = (f32x2){bf2f(w & 0xffffu), bf2f(w >> 16)}; }
        float* o_ss = a.out + O_SCSSM + ((size_t)l * SB + b) * 3 * 2048 + 4 * tid;
        for (int rr = 0; rr < 3; ++rr) { const u32x2 w = *(const u32x2*)(XBC + (size_t)(row0 + 5 + rr) * 2048 + 4 * tid);
            *(f32x4*)(o_ss + rr * 2048) = (f32x4){bf2f(w.x & 0xffffu), bf2f(w.x >> 16), bf2f(w.y & 0xffffu), bf2f(w.y >> 16)}; }
    } else if ((item & 127) == 127) {
        const int rb = b * PSEQ;
        float* o_cf = a.out + O_PCCF + ((size_t)l * PB + b) * 30 * 1024 + c0;
        for (int rr = 0; rr < 30; ++rr) { const unsigned w = *(const unsigned*)(U + (size_t)(rb + 2018 + rr) * 1024 + c0); *(f32x2*)(o_cf + (size_t)rr * 1024) = (f32x2){bf2f(w & 0xffffu), bf2f(w >> 16)}; }
        float* o_sc = a.out + O_PCSC + ((size_t)l * PB + b) * 2 * 1024 + c0;
        for (int rr = 0; rr < 2; ++rr) { const unsigned w = *(const unsigned*)(CV + (size_t)(rb + 2046 + rr) * 1024 + c0); *(f32x2*)(o_sc + rr * 1024) = (f32x2){bf2f(w & 0xffffu), bf2f(w >> 16)}; }
        float* o_ss = a.out + O_PCSSM + ((size_t)l * PB + b) * 3 * 2048 + 4 * tid;
        for (int rr = 0; rr < 3; ++rr) { const u32x2 w = *(const u32x2*)(XBC + (size_t)(rb + 2045 + rr) * 2048 + 4 * tid);
            *(f32x4*)(o_ss + rr * 2048) = (f32x4){bf2f(w.x & 0xffffu), bf2f(w.x >> 16), bf2f(w.y & 0xffffu), bf2f(w.y >> 16)}; }
        const bf16* KV = (const bf16*)(a.ws + WS_KV);
        float* o_kv = a.out + (tid < 256 ? O_PK : O_PV) + ((size_t)l * PB + b) * 128 * 256 + (tid & 255);
        for (int jj = 0; jj < 128; ++jj) o_kv[(size_t)jj * 256] = bf2f(KV[(size_t)(rb + 1920 + jj) * 512 + tid]);
    }
}

__device__ __forceinline__ float incl_scan64(float v, int lane) {
#pragma unroll
    for (int o = 1; o < 64; o <<= 1) { const float t = __shfl_up(v, o); if (lane >= o) v += t; }
    return v;
}
template <int MODE>
__device__ __forceinline__ void ssd_cs(const Args& a, int l, int g, int r0, LAS float* csb, LAS float* dtb, LAS float* auxb, float* cdec, int wave, int lane) {
    if (wave < 4) {
        const int h = 4 * g + wave; const float A = -__expf(a.in[I_ALOG][l * HEADS + h]);
        const float* DT = (const float*)(a.ws + WS_DT);
        const float d0 = DT[(size_t)(r0 + lane) * 16 + h], d1 = DT[(size_t)(r0 + 64 + lane) * 16 + h];
        const float s0 = incl_scan64(d0 * A, lane); const float tot0 = __shfl(s0, 63);
        const float s1 = incl_scan64(d1 * A, lane) + tot0; const float last = __shfl(s1, 63);
        csb[wave * 128 + lane] = s0; csb[wave * 128 + 64 + lane] = s1; dtb[wave * 128 + lane] = d0; dtb[wave * 128 + 64 + lane] = d1;
        if (MODE == 0) { auxb[wave * 128 + lane] = d0 * __expf(last - s0); auxb[wave * 128 + 64 + lane] = d1 * __expf(last - s1); if (lane == 0) cdec[h] = __expf(last); }
        else { auxb[wave * 128 + lane] = __expf(s0); auxb[wave * 128 + 64 + lane] = __expf(s1); }
    }
}
__device__ __forceinline__ void xbc_conv8x4(const Args& a, int l, int r0, bool first_chunk, int l0, int col, float (&o)[8][4]) {
    const bf16* XBC = (const bf16*)(a.ws + WS_XBC);
    f32x4 w[4];
#pragma unroll
    for (int k = 0; k < 4; ++k) w[k] = *(const f32x4*)(a.in[I_SCONVW] + (size_t)l * 4 * XBC_W + k * XBC_W + col);
    const f32x4 bias = *(const f32x4*)(a.in[I_SCONVB] + l * XBC_W + col);
    float in[11][4];
#pragma unroll
    for (int rr = 0; rr < 11; ++rr) { const int tok = l0 - 3 + rr;
        if (first_chunk && tok < 0) { in[rr][0] = in[rr][1] = in[rr][2] = in[rr][3] = 0.f; }
        else { const u32x2 v = *(const u32x2*)(XBC + (size_t)(r0 + tok) * XBC_W + col); in[rr][0] = bf2f(v.x & 0xffffu); in[rr][1] = bf2f(v.x >> 16); in[rr][2] = bf2f(v.y & 0xffffu); in[rr][3] = bf2f(v.y >> 16); } }
#pragma unroll
    for (int i = 0; i < 8; ++i)
#pragma unroll
        for (int j = 0; j < 4; ++j) { float s = bias[j];
#pragma unroll
            for (int k = 0; k < 4; ++k) s += w[k][j] * in[i + k][j];
            o[i][j] = fsilu(s); }
}
constexpr int LP = 136;

__device__ __forceinline__ void ssd1_item(const Args& a, int l, int item, LAS unsigned char* lds, int tid, int wave, int lane) {
    asm volatile("" : "+v"(tid), "+v"(lane), "+s"(wave), "+s"(item));
    const int b = item >> 6, c = (item >> 2) & 15, g = item & 3; const int r0 = b * PSEQ + c * CHUNK;
    LAS float* csb = (LAS float*)lds; LAS float* w1b = csb + 512; LAS float* dtb = csb + 1024;
    LAS bf16* xwT = (LAS bf16*)(lds + 8192); LAS bf16* BT = xwT + 4 * 64 * LP;
    __syncthreads();
    ssd_cs<0>(a, l, g, r0, csb, dtb, w1b, (float*)(a.ws + WS_CDEC) + (b * NCH + c) * HEADS, wave, lane);
    __syncthreads();
#pragma unroll 1
    for (int ti = 0; ti < 3; ++ti) {
        float o[8][4];
        if (ti < 2) { const int id = tid + 512 * ti, tg = id >> 6, q = id & 63, hh = q >> 4, l0 = 8 * tg;
            xbc_conv8x4(a, l, r0, c == 0, l0, g * 256 + 4 * q, o);
#pragma unroll
            for (int j = 0; j < 4; ++j) { float v[8];
#pragma unroll
                for (int i = 0; i < 8; ++i) v[i] = o[i][j] * w1b[hh * 128 + l0 + i];
                u32x4 w; w.x = pk2(v[0], v[1]); w.y = pk2(v[2], v[3]); w.z = pk2(v[4], v[5]); w.w = pk2(v[6], v[7]);
                *(LAS u32x4*)(xwT + (hh * 64 + 4 * (q & 15) + j) * LP + l0) = w; }
        } else { const int tg = tid >> 5, q = tid & 31, l0 = 8 * tg;
            xbc_conv8x4(a, l, r0, c == 0, l0, 1024 + g * 128 + 4 * q, o);
#pragma unroll
            for (int j = 0; j < 4; ++j) { u32x4 w; w.x = pk2(o[0][j], o[1][j]); w.y = pk2(o[2][j], o[3][j]); w.z = pk2(o[4][j], o[5][j]); w.w = pk2(o[6][j], o[7][j]);
                *(LAS u32x4*)(BT + (4 * q + j) * LP + l0) = w; }
        }
    }
    __syncthreads();
    {
        const int hh = wave >> 1, ph = wave & 1, fr = lane & 15, fq = lane >> 4;
        f32x4 acc[2][8];
#pragma unroll
        for (int i = 0; i < 2; ++i)
#pragma unroll
            for (int n = 0; n < 8; ++n) acc[i][n] = (f32x4){0.f, 0.f, 0.f, 0.f};
#pragma unroll
        for (int kk = 0; kk < 4; ++kk) {
            bf16x8 af[2];
#pragma unroll
            for (int i = 0; i < 2; ++i) af[i] = *(const LAS bf16x8*)(xwT + (hh * 64 + ph * 32 + i * 16 + fr) * LP + kk * 32 + 8 * fq);
#pragma unroll
            for (int n = 0; n < 8; ++n) { const bf16x8 bfr = *(const LAS bf16x8*)(BT + (n * 16 + fr) * LP + kk * 32 + 8 * fq);
#pragma unroll
                for (int i = 0; i < 2; ++i) acc[i][n] = __builtin_amdgcn_mfma_f32_16x16x32_bf16(af[i], bfr, acc[i][n], 0, 0, 0); }
        }
        float* cst = (float*)(a.ws + WS_CST) + ((size_t)((b * NCH + c) * HEADS + 4 * g + hh)) * (HD * NST);
#pragma unroll
        for (int i = 0; i < 2; ++i)
#pragma unroll
            for (int n = 0; n < 8; ++n)
#pragma unroll
                for (int r = 0; r < 4; ++r) cst[(size_t)(ph * 32 + i * 16 + 4 * fq + r) * NST + n * 16 + fr] = acc[i][n][r];
    }
}

__device__ __forceinline__ void ssd_scan_phase(const Args& a, int l, int gthread, int nthreads) {
    const float* CST = (const float*)(a.ws + WS_CST); const float* CDEC = (const float*)(a.ws + WS_CDEC); bf16* HP = (bf16*)(a.ws + WS_HPREV);
    for (int idx = gthread; idx < PB * HEADS * 2048; idx += nthreads) {
        const int b = idx / (HEADS * 2048), h = (idx / 2048) % HEADS, e4 = idx % 2048;
        f32x4 H = (f32x4){0.f, 0.f, 0.f, 0.f};
#pragma unroll 4
        for (int c = 0; c < NCH; ++c) { const size_t o = ((size_t)((b * NCH + c) * HEADS + h)) * (HD * NST) + 4 * e4;
            u32x2 w; w.x = pk2(H.x, H.y); w.y = pk2(H.z, H.w); *(u32x2*)(HP + o) = w;
            const float d = CDEC[(b * NCH + c) * HEADS + h]; const f32x4 s = *(const f32x4*)(CST + o); H = H * d + s; }
        *(f32x4*)(a.out + O_PSSM + ((size_t)((l * PB + b) * HEADS + h)) * (HD * NST) + 4 * e4) = H;
    }
}

__device__ __forceinline__ void ssd2_item(const Args& a, int l, int item, LAS unsigned char* lds, int tid, int wave, int lane) {
    asm volatile("" : "+v"(tid), "+v"(lane), "+s"(wave), "+s"(item));
    const int b = item >> 6, c = (item >> 2) & 15, g = item & 3; const int r0 = b * PSEQ + c * CHUNK;
    LAS float* csb = (LAS float*)lds; LAS float* ecs = csb + 512; LAS float* dtb = csb + 1024;
    LAS bf16* Cimg = (LAS bf16*)(lds + 8192); LAS bf16* Bimg = Cimg + 128 * LP; LAS bf16* xT = Bimg + 128 * LP;
    const int fr = lane & 15, fq = lane >> 4;
    __syncthreads();
    ssd_cs<1>(a, l, g, r0, csb, dtb, ecs, nullptr, wave, lane);
#pragma unroll 1
    for (int ti = 0; ti < 4; ++ti) {
        float o[8][4];
        if (ti < 2) { const int id = tid + 512 * ti, tg = id >> 6, q = id & 63, hh = q >> 4, l0 = 8 * tg;
            xbc_conv8x4(a, l, r0, c == 0, l0, g * 256 + 4 * q, o);
#pragma unroll
            for (int j = 0; j < 4; ++j) { u32x4 w; w.x = pk2(o[0][j], o[1][j]); w.y = pk2(o[2][j], o[3][j]); w.z = pk2(o[4][j], o[5][j]); w.w = pk2(o[6][j], o[7][j]);
                *(LAS u32x4*)(xT + (hh * 64 + 4 * (q & 15) + j) * LP + l0) = w; }
        } else { const int tg = tid >> 5, q = tid & 31, l0 = 8 * tg; LAS bf16* img = ti == 2 ? Bimg : Cimg;
            xbc_conv8x4(a, l, r0, c == 0, l0, 1024 + (ti == 2 ? 0 : 512) + g * 128 + 4 * q, o);
#pragma unroll
            for (int i = 0; i < 8; ++i) { u32x2 w; w.x = pk2(o[i][0], o[i][1]); w.y = pk2(o[i][2], o[i][3]); *(LAS u32x2*)(img + (l0 + i) * LP + 4 * q) = w; }
        }
    }
    __syncthreads();
    bf16x8 cf[4];
#pragma unroll
    for (int kk = 0; kk < 4; ++kk) cf[kk] = *(const LAS bf16x8*)(Cimg + (16 * wave + fr) * LP + kk * 32 + 8 * fq);
    f32x4 cb[8];
#pragma unroll
    for (int st = 0; st < 8; ++st) { cb[st] = (f32x4){0.f, 0.f, 0.f, 0.f};
        if (st <= wave) {
#pragma unroll
            for (int kk = 0; kk < 4; ++kk) { const bf16x8 bfr = *(const LAS bf16x8*)(Bimg + (st * 16 + fr) * LP + kk * 32 + 8 * fq);
                cb[st] = __builtin_amdgcn_mfma_f32_16x16x32_bf16(cf[kk], bfr, cb[st], 0, 0, 0); } } }
    __syncthreads();
    LAS bf16* Mst = Bimg + wave * 16 * LP;
    const bf16* Zb = (const bf16*)(a.ws + WS_Z); bf16* ACT = (bf16*)(a.ws + WS_ACT);
    float ssq[4] = {0.f, 0.f, 0.f, 0.f};
#pragma unroll 1
    for (int hh = 0; hh < 4; ++hh) {
        const int h = 4 * g + hh;
        float csl[4];
#pragma unroll
        for (int r = 0; r < 4; ++r) csl[r] = csb[hh * 128 + 16 * wave + 4 * fq + r];
#pragma unroll
        for (int st = 0; st < 8; ++st) if (st <= (wave | 1)) {
            const int s = st * 16 + fr; const float css = csb[hh * 128 + s], dts = dtb[hh * 128 + s];
#pragma unroll
            for (int r = 0; r < 4; ++r) { const int lr = 16 * wave + 4 * fq + r; const float v = (s <= lr) ? cb[st][r] * __expf(csl[r] - css) * dts : 0.f;
                Mst[(4 * fq + r) * LP + s] = (bf16)f2bf(v); } }
        asm volatile("s_waitcnt lgkmcnt(0)" ::: "memory");
        f32x4 y[4];
        const bf16* hp = (const bf16*)(a.ws + WS_HPREV) + ((size_t)((b * NCH + c) * HEADS + h)) * (HD * NST);
#pragma unroll
        for (int pt = 0; pt < 4; ++pt) { y[pt] = (f32x4){0.f, 0.f, 0.f, 0.f};
#pragma unroll
            for (int kk = 0; kk < 4; ++kk) { const bf16x8 hf = *(const bf16x8*)(hp + (size_t)(pt * 16 + fr) * NST + kk * 32 + 8 * fq);
                y[pt] = __builtin_amdgcn_mfma_f32_16x16x32_bf16(cf[kk], hf, y[pt], 0, 0, 0); } }
#pragma unroll
        for (int r = 0; r < 4; ++r) { const float e = ecs[hh * 128 + 16 * wave + 4 * fq + r];
#pragma unroll
            for (int pt = 0; pt < 4; ++pt) y[pt][r] *= e; }
#pragma unroll
        for (int kk = 0; kk < 4; ++kk) if (kk <= (wave >> 1)) {
            const bf16x8 mf = *(const LAS bf16x8*)(Mst + fr * LP + kk * 32 + 8 * fq);
#pragma unroll
            for (int pt = 0; pt < 4; ++pt) { const bf16x8 xf = *(const LAS bf16x8*)(xT + (hh * 64 + pt * 16 + fr) * LP + kk * 32 + 8 * fq);
                y[pt] = __builtin_amdgcn_mfma_f32_16x16x32_bf16(mf, xf, y[pt], 0, 0, 0); } }
        asm volatile("s_waitcnt lgkmcnt(0)" ::: "memory");
        const float Dh = a.in[I_DSKIP][l * HEADS + h];
#pragma unroll
        for (int pt = 0; pt < 4; ++pt) { const int p = pt * 16 + fr;
            const u32x2 xw = *(const LAS u32x2*)(xT + (hh * 64 + p) * LP + 16 * wave + 4 * fq);
            const float xv[4] = {bf2f(xw.x & 0xffffu), bf2f(xw.x >> 16), bf2f(xw.y & 0xffffu), bf2f(xw.y >> 16)};
#pragma unroll
            for (int r = 0; r < 4; ++r) { const size_t row = (size_t)(r0 + 16 * wave + 4 * fq + r);
                const float v = (y[pt][r] + Dh * xv[r]) * bf2f(Zb[row * 1024 + h * 64 + p]);
                ACT[row * 4096 + h * 64 + p] = (bf16)f2bf(v); ssq[r] += v * v; } }
    }
#pragma unroll
    for (int r = 0; r < 4; ++r) { float s = ssq[r]; s += __shfl_xor(s, 1); s += __shfl_xor(s, 2); s += __shfl_xor(s, 4); s += __shfl_xor(s, 8);
        if (fr == 0) atomicAdd((u64*)(a.ws + WS_SSQA) + (size_t)l * TT + r0 + 16 * wave + 4 * fq + r, ssq_fix(s)); }
}

__device__ __forceinline__ void ssds_item(const Args& a, int l, int item, LAS unsigned char* lds, int tid, int wave, int lane) {
    asm volatile("" : "+v"(tid), "+v"(lane), "+s"(wave), "+s"(item));
    const int b = item >> 4, h = item & 15, g = h >> 2; const int row0 = TP + 8 * b;
    LAS float* xs = (LAS float*)lds; LAS float* Bs = xs + 512; LAS float* Cs = Bs + 1024; LAS float* dtv = Cs + 1024; LAS float* dA = dtv + 8;
    const bf16* XBC = (const bf16*)(a.ws + WS_XBC);
    __syncthreads();
    if (tid < 320) {
        const int ch = tid < 64 ? h * 64 + tid : (tid < 192 ? 1024 + g * 128 + (tid - 64) : 1536 + g * 128 + (tid - 192));
        float w[4], in[11];
#pragma unroll
        for (int k = 0; k < 4; ++k) w[k] = a.in[I_SCONVW][(size_t)l * 4 * XBC_W + k * XBC_W + ch];
        const float bias = a.in[I_SCONVB][l * XBC_W + ch];
#pragma unroll
        for (int rr = 0; rr < 3; ++rr) in[rr] = a.in[I_CSSM][(((size_t)l * SB + b) * 3 + rr) * XBC_W + ch];
#pragma unroll
        for (int rr = 0; rr < 8; ++rr) in[3 + rr] = bf2f(XBC[(size_t)(row0 + rr) * XBC_W + ch]);
#pragma unroll
        for (int t = 0; t < 8; ++t) { const float v = fsilu(bias + w[0] * in[t] + w[1] * in[t + 1] + w[2] * in[t + 2] + w[3] * in[t + 3]);
            if (tid < 64) xs[t * 64 + tid] = v; else if (tid < 192) Bs[t * 128 + tid - 64] = v; else Cs[t * 128 + tid - 192] = v; }
    } else if (tid < 328) {
        const int t = tid - 320; const float d = ((const float*)(a.ws + WS_DT))[(size_t)(row0 + t) * 16 + h];
        dtv[t] = d; dA[t] = __expf(-__expf(a.in[I_ALOG][l * HEADS + h]) * d);
    }
    __syncthreads();
    const int p = tid >> 3, nq = tid & 7;
    const size_t so = ((size_t)((l * SB + b) * HEADS + h)) * (HD * NST) + (size_t)p * NST + 16 * nq;
    float hr[16];
#pragma unroll
    for (int j = 0; j < 4; ++j) { const f32x4 v = *(const f32x4*)(a.in[I_SSM] + so + 4 * j); hr[4 * j] = v.x; hr[4 * j + 1] = v.y; hr[4 * j + 2] = v.z; hr[4 * j + 3] = v.w; }
    float yk = 0.f;
#pragma unroll
    for (int t = 0; t < 8; ++t) {
        const float xv = dtv[t] * xs[t * 64 + p], da = dA[t]; float part = 0.f;
#pragma unroll
        for (int j = 0; j < 16; ++j) { hr[j] = hr[j] * da + xv * Bs[t * 128 + 16 * nq + j]; part += Cs[t * 128 + 16 * nq + j] * hr[j]; }
        part += __shfl_xor(part, 1); part += __shfl_xor(part, 2); part += __shfl_xor(part, 4);
        yk = (nq == t) ? part : yk;
    }
#pragma unroll
    for (int j = 0; j < 4; ++j) *(f32x4*)(a.out + O_SSSM + so + 4 * j) = (f32x4){hr[4 * j], hr[4 * j + 1], hr[4 * j + 2], hr[4 * j + 3]};
    {
        const size_t row = (size_t)(row0 + nq);
        const float v = (yk + a.in[I_DSKIP][l * HEADS + h] * xs[nq * 64 + p]) * bf2f(((const bf16*)(a.ws + WS_Z))[row * 1024 + h * 64 + p]);
        ((bf16*)(a.ws + WS_ACT))[row * 4096 + h * 64 + p] = (bf16)f2bf(v);
        float s = v * v; s += __shfl_xor(s, 8); s += __shfl_xor(s, 16); s += __shfl_xor(s, 32);
        if ((lane >> 3) == 0) atomicAdd((u64*)(a.ws + WS_SSQA) + (size_t)l * TT + row, ssq_fix(s));
    }
}

constexpr int KP = 72, VP = 264;
__device__ __forceinline__ void attn_item(const Args& a, int l, int item, LAS unsigned char* lds, int tid, int wave, int lane) {
    asm volatile("" : "+v"(tid), "+v"(lane), "+s"(wave), "+s"(item));
    const int b = item >> 6, qb = (item >> 2) & 15, g = item & 3; const int r0 = b * PSEQ + qb * 128;
    LAS bf16* Kimg = (LAS bf16*)lds; LAS bf16* VT = Kimg + 256 * KP;
    const bf16* KV = (const bf16*)(a.ws + WS_KV); const bf16* Qb = (const bf16*)(a.ws + WS_Q); const bf16* AG = (const bf16*)(a.ws + WS_AG); bf16* ACT = (bf16*)(a.ws + WS_ACT);
    const int fr = lane & 15, fq = lane >> 4;
    __syncthreads();
#pragma unroll
    for (int i = 0; i < 4; ++i) { const int id = tid + 512 * i, j = id >> 3, ch = id & 7; const int t = qb * 128 - 128 + j;
        u32x4 kw = (u32x4){0u, 0u, 0u, 0u}, vw = (u32x4){0u, 0u, 0u, 0u};
        if (t >= 0) { const bf16* rp = KV + (size_t)(b * PSEQ + t) * 512 + g * 64 + 8 * ch; kw = *(const u32x4*)rp; vw = *(const u32x4*)(rp + 256); }
        *(LAS u32x4*)(Kimg + j * KP + 8 * ch) = kw;
        const int slot = (j & ~31) + 8 * ((j & 15) >> 2) + 4 * ((j >> 4) & 1) + (j & 3);
        const unsigned vv[4] = {vw.x, vw.y, vw.z, vw.w};
#pragma unroll
        for (int e = 0; e < 8; ++e) VT[(8 * ch + e) * VP + slot] = (bf16)((vv[e >> 1] >> (16 * (e & 1))) & 0xffffu); }
    __syncthreads();
    const int hq = wave >> 1, half = wave & 1, h = 4 * g + hq;
    bf16x8 qf[4][2];
#pragma unroll
    for (int qt = 0; qt < 4; ++qt)
#pragma unroll
        for (int kk = 0; kk < 2; ++kk) qf[qt][kk] = *(const bf16x8*)(Qb + (size_t)(r0 + 64 * half + 16 * qt + fr) * 1024 + h * 64 + kk * 32 + 8 * fq);
    const float L2E = 1.4426950408889634f, SC = 0.125f * L2E;
    float m[4], lsum[4]; f32x4 o[4][4];
    const float sinkv = a.in[I_SINK][l * HEADS + h] * L2E;
#pragma unroll
    for (int qt = 0; qt < 4; ++qt) { m[qt] = sinkv; lsum[qt] = (fq == 0) ? 1.f : 0.f;
#pragma unroll
        for (int dt = 0; dt < 4; ++dt) o[dt][qt] = (f32x4){0.f, 0.f, 0.f, 0.f}; }
#pragma unroll 1
    for (int kb = 2 * half; kb < 2 * half + 6; ++kb) {
        const int j0 = 32 * kb;
        f32x4 s[2][4];
#pragma unroll
        for (int tk = 0; tk < 2; ++tk) {
            bf16x8 kf[2];
#pragma unroll
            for (int kk = 0; kk < 2; ++kk) kf[kk] = *(const LAS bf16x8*)(Kimg + (j0 + 16 * tk + fr) * KP + kk * 32 + 8 * fq);
#pragma unroll
            for (int qt = 0; qt < 4; ++qt) { s[tk][qt] = (f32x4){0.f, 0.f, 0.f, 0.f};
#pragma unroll
                for (int kk = 0; kk < 2; ++kk) s[tk][qt] = __builtin_amdgcn_mfma_f32_16x16x32_bf16(kf[kk], qf[qt][kk], s[tk][qt], 0, 0, 0); } }
        bf16x8 pf[4];
#pragma unroll
        for (int qt = 0; qt < 4; ++qt) {
            const int qi = 64 * half + 16 * qt + fr; float bm = -INFINITY;
#pragma unroll
            for (int tk = 0; tk < 2; ++tk)
#pragma unroll
                for (int r = 0; r < 4; ++r) { const int j = j0 + 16 * tk + 4 * fq + r; const bool ok = (j > qi) && (j <= qi + 128) && (qb * 128 - 128 + j >= 0);
                    const float v = ok ? s[tk][qt][r] * SC : -INFINITY; s[tk][qt][r] = v; bm = fmaxf(bm, v); }
            bm = fmaxf(bm, __shfl_xor(bm, 16)); bm = fmaxf(bm, __shfl_xor(bm, 32));
            const float mn = fmaxf(m[qt], bm), al = __builtin_amdgcn_exp2f(m[qt] - mn); m[qt] = mn;
            float ps = 0.f; float pv[8];
#pragma unroll
            for (int tk = 0; tk < 2; ++tk)
#pragma unroll
                for (int r = 0; r < 4; ++r) { const float p = __builtin_amdgcn_exp2f(s[tk][qt][r] - mn); pv[4 * tk + r] = p; ps += p; }
            lsum[qt] = lsum[qt] * al + ps;
#pragma unroll
            for (int dt = 0; dt < 4; ++dt) o[dt][qt] = o[dt][qt] * al;
            u32x4 w; w.x = pk2(pv[0], pv[1]); w.y = pk2(pv[2], pv[3]); w.z = pk2(pv[4], pv[5]); w.w = pk2(pv[6], pv[7]);
            pf[qt] = __builtin_bit_cast(bf16x8, w);
        }
#pragma unroll
        for (int dt = 0; dt < 4; ++dt) { const bf16x8 vf = *(const LAS bf16x8*)(VT + (dt * 16 + fr) * VP + j0 + 8 * fq);
#pragma unroll
            for (int qt = 0; qt < 4; ++qt) o[dt][qt] = __builtin_amdgcn_mfma_f32_16x16x32_bf16(vf, pf[qt], o[dt][qt], 0, 0, 0); }
    }
#pragma unroll
    for (int qt = 0; qt < 4; ++qt) { float lt = lsum[qt]; lt += __shfl_xor(lt, 16); lt += __shfl_xor(lt, 32); const float inv = 1.f / lt;
        const size_t row = (size_t)(r0 + 64 * half + 16 * qt + fr);
#pragma unroll
        for (int dt = 0; dt < 4; ++dt) { const int d = dt * 16 + 4 * fq; const u32x2 gw = *(const u32x2*)(AG + row * 1024 + h * 64 + d);
            u32x2 w; w.x = pk2(o[dt][qt][0] * inv * bf2f(gw.x & 0xffffu), o[dt][qt][1] * inv * bf2f(gw.x >> 16)); w.y = pk2(o[dt][qt][2] * inv * bf2f(gw.y & 0xffffu), o[dt][qt][3] * inv * bf2f(gw.y >> 16));
            *(u32x2*)(ACT + row * 4096 + 3072 + h * 64 + d) = w; } }
}

__device__ __forceinline__ void attns_item(const Args& a, int l, int item, LAS unsigned char* lds, int tid, int wave, int lane) {
    asm volatile("" : "+v"(tid), "+v"(lane), "+s"(wave), "+s"(item));
    const int b = item >> 2, g = item & 3; const int row0 = TP + 8 * b;
    LAS float* Qs = (LAS float*)lds; LAS float* Ks = Qs + 32 * 64; LAS float* Vs = Ks + 136 * 65; LAS float* Sc = Vs + 136 * 64;
    const bf16* KV = (const bf16*)(a.ws + WS_KV); const bf16* Qb = (const bf16*)(a.ws + WS_Q);
    __syncthreads();
    for (int e = tid; e < 32 * 64; e += 512) { const int r = e >> 6, d = e & 63, hq = r >> 3, qi = r & 7; Qs[e] = bf2f(Qb[(size_t)(row0 + qi) * 1024 + (4 * g + hq) * 64 + d]); }
    for (int e = tid; e < 136 * 64; e += 512) { const int j = e >> 6, d = e & 63; float kv, vv;
        if (j < 128) { const size_t o = (((size_t)l * SB + b) * 128 + j) * 256 + g * 64 + d; kv = a.in[I_CK][o]; vv = a.in[I_CVV][o]; }
        else { const bf16* rp = KV + (size_t)(row0 + j - 128) * 512 + g * 64 + d; kv = bf2f(rp[0]); vv = bf2f(rp[256]); }
        Ks[j * 65 + d] = kv; Vs[j * 64 + d] = vv; }
    __syncthreads();
    for (int e = tid; e < 32 * 136; e += 512) { const int r = e / 136, j = e - r * 136, qi = r & 7; float s = 0.f;
#pragma unroll 16
        for (int d = 0; d < 64; ++d) s += Qs[r * 64 + d] * Ks[j * 65 + d];
        const bool ok = j < 128 ? (j > qi) : (j - 128 <= qi);
        Sc[r * 140 + j] = ok ? s * 0.125f : -INFINITY; }
    __syncthreads();
#pragma unroll
    for (int rr = 0; rr < 4; ++rr) { const int r = 4 * wave + rr, hq = r >> 3; const float sink = a.in[I_SINK][l * HEADS + 4 * g + hq];
        const float s0 = Sc[r * 140 + lane], s1 = Sc[r * 140 + 64 + lane], s2 = lane < 8 ? Sc[r * 140 + 128 + lane] : -INFINITY;
        float mx = fmaxf(fmaxf(s0, s1), s2);
#pragma unroll
        for (int o = 1; o < 64; o <<= 1) mx = fmaxf(mx, __shfl_xor(mx, o));
        mx = fmaxf(mx, sink);
        const float p0 = __expf(s0 - mx), p1 = __expf(s1 - mx), p2 = lane < 8 ? __expf(s2 - mx) : 0.f;
        const float den = wave_sum(p0 + p1 + p2) + __expf(sink - mx), inv = 1.f / den;
        Sc[r * 140 + lane] = p0 * inv; Sc[r * 140 + 64 + lane] = p1 * inv; if (lane < 8) Sc[r * 140 + 128 + lane] = p2 * inv; }
    __syncthreads();
    {   const int r = tid >> 4, d4 = (tid & 15) * 4, hq = r >> 3, qi = r & 7; f32x4 o = (f32x4){0.f, 0.f, 0.f, 0.f};
        for (int j = 0; j < 136; ++j) { const float p = Sc[r * 140 + j]; const f32x4 v = *(const LAS f32x4*)(Vs + j * 64 + d4); o = o + v * p; }
        const size_t row = (size_t)(row0 + qi); const int col = (4 * g + hq) * 64 + d4;
        const u32x2 gw = *(const u32x2*)((const bf16*)(a.ws + WS_AG) + row * 1024 + col);
        u32x2 w; w.x = pk2(o.x * bf2f(gw.x & 0xffffu), o.y * bf2f(gw.x >> 16)); w.y = pk2(o.z * bf2f(gw.y & 0xffffu), o.w * bf2f(gw.y >> 16));
        *(u32x2*)((bf16*)(a.ws + WS_ACT) + row * 4096 + 3072 + col) = w; }
    for (int e = tid; e < 128 * 64; e += 512) { const int jj = e >> 6, d = e & 63; const size_t o = (((size_t)l * SB + b) * 128 + jj) * 256 + g * 64 + d;
        a.out[O_SK + o] = Ks[(jj + 8) * 65 + d]; a.out[O_SV + o] = Vs[(jj + 8) * 64 + d]; }
}

struct Epi2 {
    static constexpr bool PERM = true;
    const bf16* MG; const u64* ssqa; float* scr; bf16* H;
    __device__ __forceinline__ void operator()(const f32x4 (&acc)[2][2][4][2], const pg8::Unit& u, int wr, int wc, int fr, int fq) const {
        const int ln = fresh_lane(); const int frv = ln & 15, fqv = ln >> 4; int tid = threadIdx.x; asm volatile("" : "+v"(tid));
        const int row0 = u.pm * 256 + wr * 64 + frv, colb = u.pn * 256 + wc * 32 + 8 * fqv;
#pragma unroll
        for (int ai = 0; ai < 2; ++ai)
#pragma unroll
            for (int m = 0; m < 4; ++m) { const size_t row = (size_t)(row0 + ai * 128 + m * 16);
                const float rsa = (u.sub == 0) ? ssq_to_rstd(ssqa[row], 1.0f / 1024.0f, 1e-5f) : 1.0f;
#pragma unroll
                for (int bj = 0; bj < 2; ++bj) { const int col = colb + bj * 128;
                    const u32x4 gw = *(const u32x4*)(MG + row * 8192 + u.sub * 2048 + col);
                    f32x4 v0, v1;
                    v0[0] = acc[ai][bj][m][0][0] * bf2f(gw.x & 0xffffu) * rsa; v0[1] = acc[ai][bj][m][0][1] * bf2f(gw.x >> 16) * rsa;
                    v0[2] = acc[ai][bj][m][0][2] * bf2f(gw.y & 0xffffu) * rsa; v0[3] = acc[ai][bj][m][0][3] * bf2f(gw.y >> 16) * rsa;
                    v1[0] = acc[ai][bj][m][1][0] * bf2f(gw.z & 0xffffu) * rsa; v1[1] = acc[ai][bj][m][1][1] * bf2f(gw.z >> 16) * rsa;
                    v1[2] = acc[ai][bj][m][1][2] * bf2f(gw.w & 0xffffu) * rsa; v1[3] = acc[ai][bj][m][1][3] * bf2f(gw.w >> 16) * rsa;
                    f32x4* s0 = (f32x4*)scr + (size_t)((((ai * 4 + m) * 2 + bj) * 2 + 0) * 512 + tid); f32x4* s1 = s0 + 512;
                    if (u.sub == 0) { *s0 = v0; *s1 = v1; }
                    else if (u.sub < 3) { *s0 = *s0 + v0; *s1 = *s1 + v1; }
                    else { v0 = *s0 + v0; v1 = *s1 + v1; u32x4 w; w.x = pk2(v0[0], v0[1]); w.y = pk2(v0[2], v0[3]); w.z = pk2(v1[0], v1[1]); w.w = pk2(v1[2], v1[3]);
                        *(u32x4*)(H + row * 2048 + col) = w; }
                    asm volatile("" ::: "memory"); } }
    }
};
struct Epi3 {
    static constexpr bool PERM = false;
    const float* xp; const float* xs; float* out; bf16* XB; u64* ssq; int layer;
    __device__ __forceinline__ void operator()(const f32x4 (&acc)[2][2][4][2], const pg8::Unit& u, int wr, int wc, int fr, int fq) const {
        { const int ln = fresh_lane(); fr = ln & 15; fq = ln >> 4; }
        const int row0 = u.pm * 256 + wr * 64 + fr, col0 = u.pn * 256 + wc * 32 + 4 * fq;
        const float* base = layer ? out : (u.pm < 32 ? xp : xs); const int roff = (layer == 0 && u.pm >= 32) ? TP : 0;
#pragma unroll
        for (int ai = 0; ai < 2; ++ai)
#pragma unroll
            for (int m = 0; m < 4; ++m) { const int row = row0 + ai * 128 + m * 16; float s = 0.f;
#pragma unroll
                for (int bj = 0; bj < 2; ++bj)
#pragma unroll
                    for (int n = 0; n < 2; ++n) { const int col = col0 + bj * 128 + n * 16;
                        const f32x4 xn = *(const f32x4*)(base + (size_t)(row - roff) * DM + col) + acc[ai][bj][m][n];
                        *(f32x4*)(out + (size_t)row * DM + col) = xn;
                        u32x2 w; w.x = pk2(xn[0], xn[1]); w.y = pk2(xn[2], xn[3]); *(u32x2*)(XB + (size_t)row * DM + col) = w;
                        s += (xn[0] * xn[0] + xn[1] * xn[1]) + (xn[2] * xn[2] + xn[3] * xn[3]); }
                s += __shfl_xor(s, 16); s += __shfl_xor(s, 32);
                if (fq == 0) atomicAdd(ssq + row, ssq_fix(s)); }
    }
};

__global__ void __launch_bounds__(512, 2) mk_fwd(Args a) {
    extern __shared__ __attribute__((aligned(16))) unsigned char lds_raw[];
    LAS unsigned char* lds = (LAS unsigned char*)lds_raw;
    cg::grid_group grid = cg::this_grid();
    const int G = gridDim.x, bx = blockIdx.x;
    const int vcu = (G % 8 == 0) ? (bx % 8) * (G / 8) + bx / 8 : bx;
    const int lo = a.ph_lo, hi = a.ph_hi;
#define IN(k) (lo <= (k) && (k) < hi)
#define SEAM(k) do { if (IN(k) && IN((k) + 1)) grid.sync(); } while (0)
#define FRESH_IDS int tid = threadIdx.x; asm volatile("" : "+v"(tid)); const int lane = tid & 63; const int wave = __builtin_amdgcn_readfirstlane(tid >> 6); const int gw = vcu * 8 + wave, ngw = G * 8; (void)lane; (void)gw; (void)ngw;
    int ph = 0;
    if (IN(ph)) { FRESH_IDS phase_prologue(a, lds, gw, ngw, wave, lane); }
    SEAM(ph); ++ph;
#pragma unroll 1
    for (int l = 0; l < NL; ++l) {
        if (IN(ph)) {
            pg8::Gemm g{(const bf16*)(a.ws + WS_XB), (const bf16*)(a.ws + WS_W1T + l * W1T_L), DM, DM, DM / 64, 0, 0};
            pg8::Order S; S.init(TT / 256, NT1, G, bx, 1);
            Epi1 E{a.ws, (const u64*)(a.ws + WS_SSQ) + (size_t)l * TT, a.in[I_DTB] + l * 16};
            if (GEMM_MASK & 1) pg8::gemm_phase<Epi1>(lds, g, S, E);
        }
        SEAM(ph); ++ph;
        if (IN(ph)) {
            FRESH_IDS
            constexpr int N0 = 256, N1_ = N0 + 256, N2 = N1_ + 512, N3 = N2 + 512, N4 = N3 + 128, N5 = N4 + 2048;
#pragma unroll 1
            for (int it = bx; it < N5; it += G) {
                if (it < N0) { if (ITEM_MASK & 1) ssd1_item(a, l, it, lds, tid, wave, lane); }
                else if (it < N1_) { if (ITEM_MASK & 2) attn_item(a, l, it - N0, lds, tid, wave, lane); }
                else if (it < N2) { if (ITEM_MASK & 4) conv_item<false>(a, l, it - N1_, lds, tid, wave, lane); }
                else if (it < N3) { if (ITEM_MASK & 8) attns_item(a, l, it - N2, lds, tid, wave, lane); }
                else if (it < N4) { if (ITEM_MASK & 16) conv_item<true>(a, l, it - N3, lds, tid, wave, lane); }
                else { if (ITEM_MASK & 32) ssds_item(a, l, it - N4, lds, tid, wave, lane); }
            }
        }
        SEAM(ph); ++ph;
        if (IN(ph)) { FRESH_IDS ssd_scan_phase(a, l, bx * 512 + tid, G * 512); }
        SEAM(ph); ++ph;
        if (IN(ph)) {
            FRESH_IDS
#pragma unroll 1
            for (int it = bx; it < 256; it += G) { if (ITEM_MASK & 64) ssd2_item(a, l, it, lds, tid, wave, lane); }
        }
        SEAM(ph); ++ph;
        if (IN(ph)) {
            pg8::Gemm g{(const bf16*)(a.ws + WS_ACT), (const bf16*)(a.ws + WS_W2T + l * W2T_L), 4096, 4096, 1024 / 64, 1024, 1024};
            pg8::Order S; S.init(TT / 256, DM / 256, G, bx, 4);
            Epi2 E{(const bf16*)(a.ws + WS_MG), (const u64*)(a.ws + WS_SSQA) + (size_t)l * TT, (float*)(a.ws + WS_SCR) + (size_t)bx * 65536, (bf16*)(a.ws + WS_H)};
            if (GEMM_MASK & 2) pg8::gemm_phase<Epi2>(lds, g, S, E);
        }
        SEAM(ph); ++ph;
        if (IN(ph)) {
            pg8::Gemm g{(const bf16*)(a.ws + WS_H), (const bf16*)(a.ws + WS_W3T + l * W3T_L), DM, DM, DM / 64, 0, 0};
            pg8::Order S; S.init(TT / 256, DM / 256, G, bx, 1);
            Epi3 E{a.in[I_XP], a.in[I_XS], a.out, (bf16*)(a.ws + WS_XB), (u64*)(a.ws + WS_SSQ) + (size_t)(l + 1) * TT, l};
            if (GEMM_MASK & 4) pg8::gemm_phase<Epi3>(lds, g, S, E);
        }
        SEAM(ph); ++ph;
    }
    if (IN(ph)) {
        FRESH_IDS
        for (int mrow = gw; mrow < TT; mrow += ngw) {
            f32x4* x4 = (f32x4*)(a.out + (size_t)mrow * DM) + lane; f32x4 v[8]; float s = 0.f;
#pragma unroll
            for (int j = 0; j < 8; ++j) { v[j] = x4[64 * j]; s += (v[j].x * v[j].x + v[j].y * v[j].y) + (v[j].z * v[j].z + v[j].w * v[j].w); }
            const float rstd = rsqrtf(wave_sum(s) * (1.f / 2048.f) + 1e-6f);
#pragma unroll
            for (int j = 0; j < 8; ++j) { const f32x4 w = *((const f32x4*)a.in[I_FNW] + lane + 64 * j); x4[64 * j] = v[j] * rstd * w; }
        }
    }
#undef IN
#undef SEAM
}

#if PROBE_CHECK
constexpr int NSTAGE = 40;
__device__ __forceinline__ unsigned hash32(unsigned x) { x ^= x >> 16; x *= 0x7feb352du; x ^= x >> 15; x *= 0x846ca68bu; x ^= x >> 16; return x; }
__device__ __forceinline__ void rec_err(float* dbg, int stage, float got, float ref, float floor_) {
    float e = fabsf(got - ref) / (fabsf(ref) + floor_); if (!(e == e)) e = 1e30f;
    atomicMax((unsigned*)dbg + stage, __float_as_uint(e));
}
__device__ void rec_err2(float* dbg, int stage, float got, float ref, float scale) {
    float e = fabsf(got - ref) / scale; if (!(e == e)) e = 1e30f; if (e == 0.f) e = 1e-30f;
    atomicMax((unsigned*)dbg + stage, __float_as_uint(e));
}
__device__ float chk_xbc(const Args& a, int l, int row, int ch) {
    const bf16* XBC = (const bf16*)(a.ws + WS_XBC); float s = a.in[I_SCONVB][l * XBC_W + ch];
    const bool samp = row >= TP; const int t = samp ? (row - TP) % 8 : row % PSEQ, b = samp ? (row - TP) / 8 : 0;
    for (int k = 0; k < 4; ++k) { const int tt = t - 3 + k; float v;
        if (tt >= 0) v = bf2f(XBC[(size_t)(row - 3 + k) * XBC_W + ch]); else v = samp ? a.in[I_CSSM][(((size_t)l * SB + b) * 3 + (3 + tt)) * XBC_W + ch] : 0.f;
        s += a.in[I_SCONVW][(size_t)l * 4 * XBC_W + k * XBC_W + ch] * v; }
    return s / (1.f + expf(-s));
}
__device__ float chk_cfconv(const Args& a, int l, int row, int ch) {
    const bf16* U = (const bf16*)(a.ws + WS_U); float s = a.in[I_CFCB][l * 1024 + ch];
    const bool samp = row >= TP; const int t = samp ? (row - TP) % 8 : row % PSEQ, b = samp ? (row - TP) / 8 : 0;
    for (int k = 0; k < 31; ++k) { const int tt = t - 30 + k; float v;
        if (tt >= 0) v = bf2f(U[(size_t)(row - 30 + k) * 1024 + ch]); else v = samp ? a.in[I_CCF][(((size_t)l * SB + b) * 30 + (30 + tt)) * 1024 + ch] : 0.f;
        s += a.in[I_CFCW][(size_t)l * 31 * 1024 + k * 1024 + ch] * v; }
    return s;
}
__global__ void chk_kernel(Args a, int layer, int part) {
    float* dbg = (float*)(a.ws + WS_DBG); const int l = layer;
    const int s = blockIdx.x * blockDim.x + threadIdx.x; const unsigned h = hash32(s * 2654435761u + 12345u + 977u * layer);
    const bf16* XB = (const bf16*)(a.ws + WS_XB); const bf16* ACT = (const bf16*)(a.ws + WS_ACT); const float* DT = (const float*)(a.ws + WS_DT);
    const bf16* KV = (const bf16*)(a.ws + WS_KV); const bf16* Zb = (const bf16*)(a.ws + WS_Z);
    if (part == 1) {
        const int row = h % TT, col = (h >> 13) % DM;
        if (layer == 0 && s < 4096) { const bf16* hr = (const bf16*)(a.ws + WS_H) + (size_t)row * DM; const bf16* wr = (const bf16*)(a.ws + WS_W3T + l * W3T_L) + (size_t)col * DM; float d = 0.f, da = 0.f;
            for (int k = 0; k < DM; ++k) { const float t = bf2f(hr[k]) * bf2f(wr[k]); d += t; da += fabsf(t); }
            const float xo = row < TP ? a.in[I_XP][(size_t)row * DM + col] : a.in[I_XS][(size_t)(row - TP) * DM + col];
            rec_err2(dbg, 27, a.out[(size_t)row * DM + col], xo + d, da + fabsf(xo) + 1e-3f); }
        rec_err2(dbg, 28, bf2f(XB[(size_t)row * DM + col]), a.out[(size_t)row * DM + col], fabsf(a.out[(size_t)row * DM + col]) + 0.01f);
        if (s < 2048) { float q = 0.f; for (int i = 0; i < DM; ++i) { const float v = a.out[(size_t)row * DM + i]; q += v * v; }
            rec_err2(dbg, 28, (float)((double)((const u64*)(a.ws + WS_SSQ))[(size_t)(l + 1) * TT + row] / 1048576.0), q, q * 0.25f + 1e-3f); }
        return;
    }
    if (part == 2) {
        if (s < 4096) { const int row = h % TT; float q = 0.f; for (int i = 0; i < DM; ++i) { const float v = a.out[(size_t)row * DM + i] / a.in[I_FNW][i]; q += v * v; }
            rec_err2(dbg, 29, q * (1.f / 2048.f), 1.f, 1.f); }
        return;
    }
    if (layer == 0) {
        const int row = h % TT, k = (h >> 14) % DM;
        const float x = row < TP ? a.in[I_XP][(size_t)row * DM + k] : a.in[I_XS][(size_t)(row - TP) * DM + k];
        rec_err(dbg, 0, bf2f(XB[(size_t)row * DM + k]), x, 0.01f);
        if (s < 4096) { const float* xr = row < TP ? a.in[I_XP] + (size_t)row * DM : a.in[I_XS] + (size_t)(row - TP) * DM; float q = 0.f; for (int i = 0; i < DM; ++i) q += xr[i] * xr[i];
            rec_err(dbg, 1, (float)((double)((const u64*)(a.ws + WS_SSQ))[row] / 1048576.0), q, 0.01f); }
    }
    {
        const unsigned h2 = hash32(h + 77u); const int n = h2 % N1, k = (h2 >> 16) % DM; const int pn = n >> 8, c = n & 255; const TileInfo ti = tile_info(pn);
        const int half = c >> 7, cc = c & 127; const int valid = half ? ti.valid1 : ti.valid0; float ref = 0.f;
        if (cc < valid) ref = a.in[I_WIN][(size_t)layer * DM * IN_COLS + (size_t)k * IN_COLS + (half ? ti.src1 : ti.src0) + cc] * a.in[I_NORMW][layer * DM + k];
        rec_err(dbg, 2, bf2f(((const bf16*)(a.ws + WS_W1T + layer * W1T_L))[(size_t)n * DM + k]), ref, 0.002f);
        const int n2 = h2 % DM, k2 = (h2 >> 12) % 4096, br = k2 >> 10, kk = k2 & 1023;
        float r2 = a.in[br == 0 ? I_WOSSM : (br == 1 ? I_WOCF : (br == 2 ? I_WOSC : I_WOATT))][(size_t)layer * 1024 * DM + (size_t)kk * DM + n2]; if (br == 0) r2 *= a.in[I_SNORMW][layer * 1024 + kk];
        rec_err(dbg, 3, bf2f(((const bf16*)(a.ws + WS_W2T + layer * W2T_L))[(size_t)n2 * 4096 + k2]), r2, 0.002f);
        const int k3 = (h2 >> 11) % DM;
        rec_err(dbg, 4, bf2f(((const bf16*)(a.ws + WS_W3T + layer * W3T_L))[(size_t)n2 * DM + k3]), a.in[I_WO][(size_t)layer * DM * DM + (size_t)k3 * DM + n2], 0.002f);
    }
    {
        const unsigned h3 = hash32(h + 991u); const int row = h3 % TT, pn = s % NT1; const TileInfo ti = tile_info(pn);
        const int ncol = ti.mode == M_DT ? 16 : (ti.mode >= M_GLU ? 128 : 256); const int c = (h3 >> 14) % ncol;
        const bf16* W = (const bf16*)(a.ws + WS_W1T + layer * W1T_L) + (size_t)pn * 256 * DM; const bf16* xr = XB + (size_t)row * DM;
        float d0 = 0.f, d1 = 0.f;
        for (int k = 0; k < DM; ++k) { const float x = bf2f(xr[k]); d0 += x * bf2f(W[(size_t)c * DM + k]); if (ti.mode >= M_GLU && ti.mode <= M_ASILUB) d1 += x * bf2f(W[(size_t)(c + 128) * DM + k]); }
        const float r = ssq_to_rstd(((const u64*)(a.ws + WS_SSQ))[(size_t)layer * TT + row], 1.f / 2048.f, 1e-6f); d0 *= r; d1 *= r;
        float ref, got;
        switch (ti.mode) { case M_ID: ref = d0; break; case M_SILU: ref = d0 / (1.f + expf(-d0)); break; case M_SIG: ref = 1.f / (1.f + expf(-d0)); break;
            case M_GLU: ref = d0 / (1.f + expf(-d1)); break; case M_MUL: ref = d0 * d1; break; case M_ASILUB: ref = d0 * d1 / (1.f + expf(-d1)); break;
            default: ref = log1pf(expf(d0 + a.in[I_DTB][layer * 16 + c])); break; }
        if (ti.mode == M_DT) got = ((const float*)(a.ws + ti.dst))[(size_t)row * 16 + c]; else got = bf2f(((const bf16*)(a.ws + ti.dst))[(size_t)row * ti.ld + ti.col0 + c]);
        rec_err(dbg, 5 + ti.mode, got, ref, ti.mode == M_DT ? 1e-4f : 0.03f);
    }
    const unsigned h4 = hash32(h + 31337u);
    if (s < 2048) {
        const int row = (s & 1) ? TP + (h4 % TS) : (h4 % TP), c = (h4 >> 13) & 1023;
        float sm = 0.f; for (int ch = 0; ch < 1024; ++ch) sm += chk_cfconv(a, l, row, ch);
        const float mean = sm / 1024.f; float q = 0.f; for (int ch = 0; ch < 1024; ++ch) { const float d = chk_cfconv(a, l, row, ch) - mean; q += d * d; }
        const float v = (chk_cfconv(a, l, row, c) - mean) * rsqrtf(q / 1024.f + 1e-5f) * a.in[I_CFLNW][l * 1024 + c] + a.in[I_CFLNB][l * 1024 + c];
        const float ref = v / (1.f + expf(-v)) * bf2f(((const bf16*)(a.ws + WS_CFG))[(size_t)row * 1024 + c]);
        rec_err2(dbg, 12, bf2f(ACT[(size_t)row * 4096 + 1024 + c]), ref, fabsf(ref) + 0.02f);
        const bf16* CV = (const bf16*)(a.ws + WS_CV); const bool samp = row >= TP; const int t = samp ? (row - TP) % 8 : row % PSEQ, b = samp ? (row - TP) / 8 : 0; float y = 0.f, ya = 0.f;
        for (int k = 0; k < 3; ++k) { const int tt = t - 2 + k; float xv; if (tt >= 0) xv = bf2f(CV[(size_t)(row - 2 + k) * 1024 + c]); else xv = samp ? a.in[I_CSC][(((size_t)l * SB + b) * 2 + (2 + tt)) * 1024 + c] : 0.f;
            const float tm = a.in[I_SCCW][(size_t)l * 3 * 1024 + k * 1024 + c] * xv; y += tm; ya += fabsf(tm); }
        const float cm = bf2f(((const bf16*)(a.ws + WS_CM))[(size_t)row * 1024 + c]);
        rec_err2(dbg, 13, bf2f(ACT[(size_t)row * 4096 + 2048 + c]), y * cm, ya * fabsf(cm) + 0.01f);
    }
    if (s < 4096) {
        const int b = h4 & 3, c = (h4 >> 2) & 15, hh = (h4 >> 6) & 15, p = (h4 >> 10) & 63, n = (h4 >> 16) & 127, g = hh >> 2; const int r0 = b * PSEQ + c * CHUNK;
        const float A = -expf(a.in[I_ALOG][l * HEADS + hh]); float last = 0.f; for (int i = 0; i < 128; ++i) last += DT[(size_t)(r0 + i) * 16 + hh] * A;
        float cum = 0.f, ref = 0.f, refa = 0.f;
        for (int i = 0; i < 128; ++i) { const float d = DT[(size_t)(r0 + i) * 16 + hh]; cum += d * A;
            const float tm = chk_xbc(a, l, r0 + i, 1024 + g * 128 + n) * d * expf(last - cum) * chk_xbc(a, l, r0 + i, hh * 64 + p); ref += tm; refa += fabsf(tm); }
        const float* CST = (const float*)(a.ws + WS_CST); const float* CDEC = (const float*)(a.ws + WS_CDEC);
        const size_t eo = (size_t)p * NST + n;
        rec_err2(dbg, 14, CST[((size_t)((b * NCH + c) * HEADS + hh)) * 8192 + eo], ref, refa + 1e-5f);
        rec_err2(dbg, 15, CDEC[(b * NCH + c) * HEADS + hh], expf(last), expf(last) + 1e-6f);
        float H = 0.f; for (int cc = 0; cc < c; ++cc) H = H * CDEC[(b * NCH + cc) * HEADS + hh] + CST[((size_t)((b * NCH + cc) * HEADS + hh)) * 8192 + eo];
        rec_err2(dbg, 16, bf2f(((const bf16*)(a.ws + WS_HPREV))[((size_t)((b * NCH + c) * HEADS + hh)) * 8192 + eo]), H, fabsf(H) + 1e-3f);
        for (int cc = c; cc < NCH; ++cc) H = H * CDEC[(b * NCH + cc) * HEADS + hh] + CST[((size_t)((b * NCH + cc) * HEADS + hh)) * 8192 + eo];
        rec_err2(dbg, 17, a.out[O_PSSM + ((size_t)((l * PB + b) * HEADS + hh)) * 8192 + eo], H, fabsf(H) + 1e-4f);
    }
    if (s < 1024) {
        const int row = h4 % TP, hh = (h4 >> 13) & 15, p = (h4 >> 17) & 63, g = hh >> 2; const int b = row / PSEQ, t = row % PSEQ, c = t / CHUNK, tl = t % CHUNK, r0 = b * PSEQ + c * CHUNK;
        const float A = -expf(a.in[I_ALOG][l * HEADS + hh]); float cst = 0.f; for (int i = 0; i <= tl; ++i) cst += DT[(size_t)(r0 + i) * 16 + hh] * A;
        float y = 0.f, ya = 0.f, css = 0.f;
        for (int i = 0; i <= tl; ++i) { const float d = DT[(size_t)(r0 + i) * 16 + hh]; css += d * A; float gsum = 0.f;
            for (int n = 0; n < 128; ++n) gsum += chk_xbc(a, l, row, 1536 + g * 128 + n) * chk_xbc(a, l, r0 + i, 1024 + g * 128 + n);
            const float tm = gsum * expf(cst - css) * d * chk_xbc(a, l, r0 + i, hh * 64 + p); y += tm; ya += fabsf(tm); }
        const bf16* hp = (const bf16*)(a.ws + WS_HPREV) + ((size_t)((b * NCH + c) * HEADS + hh)) * 8192 + (size_t)p * NST; const float ec = expf(cst);
        for (int n = 0; n < 128; ++n) { const float tm = ec * chk_xbc(a, l, row, 1536 + g * 128 + n) * bf2f(hp[n]); y += tm; ya += fabsf(tm); }
        const float dx = a.in[I_DSKIP][l * HEADS + hh] * chk_xbc(a, l, row, hh * 64 + p), z = bf2f(Zb[(size_t)row * 1024 + hh * 64 + p]);
        rec_err2(dbg, 18, bf2f(ACT[(size_t)row * 4096 + hh * 64 + p]), (y + dx) * z, (ya + fabsf(dx)) * fabsf(z) + 1e-3f);
        const int row2 = (h4 >> 3) % TT; float q = 0.f; for (int i = 0; i < 1024; ++i) { const float v = bf2f(ACT[(size_t)row2 * 4096 + i]); q += v * v; }
        rec_err2(dbg, 19, (float)((double)((const u64*)(a.ws + WS_SSQA))[(size_t)l * TT + row2] / 1048576.0), q, q + 1e-4f);
    }
    if (s < 2048) {
        const int b = h4 & 127, hh = (h4 >> 7) & 15, p = (h4 >> 11) & 63, nsel = (h4 >> 17) & 127, g = hh >> 2; const int row0 = TP + 8 * b;
        const float A = -expf(a.in[I_ALOG][l * HEADS + hh]); float y[8] = {0.f, 0.f, 0.f, 0.f, 0.f, 0.f, 0.f, 0.f}, ya[8] = {0.f, 0.f, 0.f, 0.f, 0.f, 0.f, 0.f, 0.f}; float hfin = 0.f;
        for (int n = 0; n < 128; ++n) { float hn = a.in[I_SSM][((size_t)((l * SB + b) * HEADS + hh)) * 8192 + (size_t)p * NST + n];
#pragma unroll
            for (int t = 0; t < 8; ++t) { const float d = DT[(size_t)(row0 + t) * 16 + hh]; hn = hn * expf(d * A) + d * chk_xbc(a, l, row0 + t, hh * 64 + p) * chk_xbc(a, l, row0 + t, 1024 + g * 128 + n);
                const float tm = chk_xbc(a, l, row0 + t, 1536 + g * 128 + n) * hn; y[t] += tm; ya[t] += fabsf(tm); }
            if (n == nsel) hfin = hn; }
#pragma unroll
        for (int t = 0; t < 8; ++t) { const float dx = a.in[I_DSKIP][l * HEADS + hh] * chk_xbc(a, l, row0 + t, hh * 64 + p), z = bf2f(Zb[(size_t)(row0 + t) * 1024 + hh * 64 + p]);
            rec_err2(dbg, 20, bf2f(ACT[(size_t)(row0 + t) * 4096 + hh * 64 + p]), (y[t] + dx) * z, (ya[t] + fabsf(dx)) * fabsf(z) + 1e-3f); }
        rec_err2(dbg, 21, a.out[O_SSSM + ((size_t)((l * SB + b) * HEADS + hh)) * 8192 + (size_t)p * NST + nsel], hfin, fabsf(hfin) + 1e-3f);
    }
    if (s < 4096) {
        const int row = h4 % TP, hh = (h4 >> 13) & 15, d = (h4 >> 17) & 63, g = hh >> 2; const int t = row % PSEQ; const int klo = t - 127 < 0 ? 0 : t - 127;
        const bf16* q = (const bf16*)(a.ws + WS_Q) + (size_t)row * 1024 + hh * 64; const float sink = a.in[I_SINK][l * HEADS + hh];
        float mx = sink;
        for (int kt = klo; kt <= t; ++kt) { const bf16* kr = KV + (size_t)(row - t + kt) * 512 + g * 64; float sc = 0.f; for (int e = 0; e < 64; ++e) sc += bf2f(q[e]) * bf2f(kr[e]); mx = fmaxf(mx, sc * 0.125f); }
        float den = expf(sink - mx), o = 0.f, oa = 0.f;
        for (int kt = klo; kt <= t; ++kt) { const bf16* kr = KV + (size_t)(row - t + kt) * 512 + g * 64; float sc = 0.f; for (int e = 0; e < 64; ++e) sc += bf2f(q[e]) * bf2f(kr[e]);
            const float pp = expf(sc * 0.125f - mx); den += pp; const float tm = pp * bf2f(kr[256 + d]); o += tm; oa += fabsf(tm); }
        const float gt = bf2f(((const bf16*)(a.ws + WS_AG))[(size_t)row * 1024 + hh * 64 + d]);
        rec_err2(dbg, 22, bf2f(ACT[(size_t)row * 4096 + 3072 + hh * 64 + d]), o / den * gt, oa / den * fabsf(gt) + 1e-3f);
    }
    if (s < 4096) {
        const int b = h4 & 127, qi = (h4 >> 7) & 7, hh = (h4 >> 10) & 15, d = (h4 >> 14) & 63, g = hh >> 2; const int row = TP + 8 * b + qi;
        const bf16* q = (const bf16*)(a.ws + WS_Q) + (size_t)row * 1024 + hh * 64; const float sink = a.in[I_SINK][l * HEADS + hh];
        float mx = sink;
        for (int pass = 0; pass < 1; ++pass) for (int j = 0; j < 136; ++j) { if (j < 128 ? (j <= qi) : (j - 128 > qi)) continue; float sc = 0.f;
            for (int e = 0; e < 64; ++e) { const float kv = j < 128 ? a.in[I_CK][(((size_t)l * SB + b) * 128 + j) * 256 + g * 64 + e] : bf2f(KV[(size_t)(TP + 8 * b + j - 128) * 512 + g * 64 + e]); sc += bf2f(q[e]) * kv; }
            mx = fmaxf(mx, sc * 0.125f); }
        float den = expf(sink - mx), o = 0.f, oa = 0.f;
        for (int j = 0; j < 136; ++j) { if (j < 128 ? (j <= qi) : (j - 128 > qi)) continue; float sc = 0.f;
            for (int e = 0; e < 64; ++e) { const float kv = j < 128 ? a.in[I_CK][(((size_t)l * SB + b) * 128 + j) * 256 + g * 64 + e] : bf2f(KV[(size_t)(TP + 8 * b + j - 128) * 512 + g * 64 + e]); sc += bf2f(q[e]) * kv; }
            const float pp = expf(sc * 0.125f - mx); den += pp; const float vv = j < 128 ? a.in[I_CVV][(((size_t)l * SB + b) * 128 + j) * 256 + g * 64 + d] : bf2f(KV[(size_t)(TP + 8 * b + j - 128) * 512 + 256 + g * 64 + d]);
            const float tm = pp * vv; o += tm; oa += fabsf(tm); }
        const float gt = bf2f(((const bf16*)(a.ws + WS_AG))[(size_t)row * 1024 + hh * 64 + d]);
        rec_err2(dbg, 23, bf2f(ACT[(size_t)row * 4096 + 3072 + hh * 64 + d]), o / den * gt, oa / den * fabsf(gt) + 1e-3f);
        const int jj = (h4 >> 20) & 127; const size_t oo = (((size_t)l * SB + b) * 128 + jj) * 256 + g * 64 + d;
        const float rk = jj < 120 ? a.in[I_CK][oo + 8 * 256] : bf2f(KV[(size_t)(TP + 8 * b + jj - 120) * 512 + g * 64 + d]);
        const float rv = jj < 120 ? a.in[I_CVV][oo + 8 * 256] : bf2f(KV[(size_t)(TP + 8 * b + jj - 120) * 512 + 256 + g * 64 + d]);
        rec_err2(dbg, 24, a.out[O_SK + oo], rk, fabsf(rk) + 1e-3f); rec_err2(dbg, 24, a.out[O_SV + oo], rv, fabsf(rv) + 1e-3f);
    }
    if (s < 4096) {
        const bf16* U = (const bf16*)(a.ws + WS_U); const bf16* CV = (const bf16*)(a.ws + WS_CV); const bf16* XBC = (const bf16*)(a.ws + WS_XBC);
        const int b = h4 & 127, pb = b & 3, c = (h4 >> 7) & 1023, c2 = (h4 >> 7) & 2047, r30 = (h4 >> 18) % 30, r3 = (h4 >> 18) % 3, r2 = (h4 >> 18) & 1, jj = (h4 >> 18) & 127, c512 = (h4 >> 7) & 255;
        float ref;
        ref = bf2f(U[(size_t)(pb * PSEQ + 2018 + r30) * 1024 + c]); rec_err2(dbg, 25, a.out[O_PCCF + (((size_t)l * PB + pb) * 30 + r30) * 1024 + c], ref, fabsf(ref) + 1e-3f);
        ref = bf2f(CV[(size_t)(pb * PSEQ + 2046 + r2) * 1024 + c]); rec_err2(dbg, 25, a.out[O_PCSC + (((size_t)l * PB + pb) * 2 + r2) * 1024 + c], ref, fabsf(ref) + 1e-3f);
        ref = bf2f(XBC[(size_t)(pb * PSEQ + 2045 + r3) * 2048 + c2]); rec_err2(dbg, 25, a.out[O_PCSSM + (((size_t)l * PB + pb) * 3 + r3) * 2048 + c2], ref, fabsf(ref) + 1e-3f);
        ref = bf2f(KV[(size_t)(pb * PSEQ + 1920 + jj) * 512 + c512]); rec_err2(dbg, 25, a.out[O_PK + (((size_t)l * PB + pb) * 128 + jj) * 256 + c512], ref, fabsf(ref) + 1e-3f);
        ref = bf2f(KV[(size_t)(pb * PSEQ + 1920 + jj) * 512 + 256 + c512]); rec_err2(dbg, 25, a.out[O_PV + (((size_t)l * PB + pb) * 128 + jj) * 256 + c512], ref, fabsf(ref) + 1e-3f);
        const int row0 = TP + 8 * b;
        ref = r30 < 22 ? a.in[I_CCF][(((size_t)l * SB + b) * 30 + r30 + 8) * 1024 + c] : bf2f(U[(size_t)(row0 + r30 - 22) * 1024 + c]); rec_err2(dbg, 25, a.out[O_SCCF + (((size_t)l * SB + b) * 30 + r30) * 1024 + c], ref, fabsf(ref) + 1e-3f);
        ref = bf2f(CV[(size_t)(row0 + 6 + r2) * 1024 + c]); rec_err2(dbg, 25, a.out[O_SCSC + (((size_t)l * SB + b) * 2 + r2) * 1024 + c], ref, fabsf(ref) + 1e-3f);
        ref = bf2f(XBC[(size_t)(row0 + 5 + r3) * 2048 + c2]); rec_err2(dbg, 25, a.out[O_SCSSM + (((size_t)l * SB + b) * 3 + r3) * 2048 + c2], ref, fabsf(ref) + 1e-3f);
    }
    if (s < 4096) {
        const int row = h4 % TT, col = (h4 >> 14) % DM; float ref = 0.f, refa = 0.f;
        for (int br = 0; br < 4; ++br) { const bf16* ar = ACT + (size_t)row * 4096 + br * 1024; const bf16* wr = (const bf16*)(a.ws + WS_W2T + l * W2T_L) + (size_t)col * 4096 + br * 1024; float d = 0.f, da = 0.f;
            for (int k = 0; k < 1024; ++k) { const float tm = bf2f(ar[k]) * bf2f(wr[k]); d += tm; da += fabsf(tm); }
            const float gt = bf2f(((const bf16*)(a.ws + WS_MG))[(size_t)row * 8192 + br * 2048 + col]) * (br == 0 ? ssq_to_rstd(((const u64*)(a.ws + WS_SSQA))[(size_t)l * TT + row], 1.f / 1024.f, 1e-5f) : 1.f);
            ref += gt * d; refa += fabsf(gt) * da; }
        rec_err2(dbg, 26, bf2f(((const bf16*)(a.ws + WS_H))[(size_t)row * DM + col]), ref, refa + 1e-3f);
    }
}
__global__ void chk_init(Args a) { float* dbg = (float*)(a.ws + WS_DBG); if (threadIdx.x < NSTAGE) dbg[threadIdx.x] = 0.f; }
__global__ void chk_encode(Args a, int out_size) {
    const float* dbg = (const float*)(a.ws + WS_DBG);
    const size_t i0 = (size_t)blockIdx.x * blockDim.x + threadIdx.x, n = (size_t)gridDim.x * blockDim.x;
    for (size_t i = i0; i < (size_t)out_size; i += n) a.out[i] = 0.f;
    if (i0 == 0) {
        const float tol[NSTAGE] = {0.01f, 1e-3f, 0.01f, 0.01f, 0.01f, 0.02f, 0.02f, 0.02f, 0.02f, 0.02f, 0.02f, 0.01f,
                                   0.02f, 0.02f, 0.02f, 1e-3f, 0.01f, 1e-3f, 0.02f, 0.01f, 0.02f, 1e-3f, 0.02f, 0.02f, 0.01f, 0.01f, 0.02f, 0.01f, 0.02f, 2e-3f};
        float code = 9.9e8f;
        for (int st = 0; st < 30; ++st) { const float e = dbg[st]; if (!(e <= tol[st]) || e == 0.f) { const int bucket = e == 0.f ? 5 : (e < 1e-2f ? 0 : (e < 1e-1f ? 1 : (e < 1.f ? 2 : (e < 10.f ? 3 : 4)))); code = (float)(10 + st) * 100.f * powf(10.f, (float)bucket); break; } }
        a.out[0] = code;
    }
}
#endif

extern "C" void kernel_launch(void* const* d_in, const int* in_sizes, int n_in, void* d_out, int out_size, void* d_ws, size_t ws_size, hipStream_t stream) {
    static int grid = 0;
    if (grid == 0) {
        int dev = 0, cus = 0, per_cu = 0;
        (void)hipGetDevice(&dev);
        (void)hipDeviceGetAttribute(&cus, hipDeviceAttributeMultiprocessorCount, dev);
        (void)hipFuncSetAttribute((const void*)mk_fwd, hipFuncAttributeMaxDynamicSharedMemorySize, LDS_BYTES);
        (void)hipOccupancyMaxActiveBlocksPerMultiprocessor(&per_cu, (const void*)mk_fwd, 512, LDS_BYTES);
        if (per_cu < 1 || n_in != 28 || ws_size < WS_END) { fprintf(stderr, "kernel_launch: unexpected environment (per_cu %d, n_in %d, ws %zu)\n", per_cu, n_in, ws_size); grid = -1; return; }
        grid = cus;
    }
    if (grid < 0) return;
    (void)hipMemsetAsync((char*)d_ws + WS_CTL, 0, CTL_BYTES, stream);
    Args a{};
    for (int i = 0; i < 28; ++i) a.in[i] = (const float*)d_in[i];
    a.out = (float*)d_out; a.ws = (unsigned char*)d_ws;
    const int NPH = 1 + NL * 6 + 1;
#if PROBE_CHECK
    chk_init<<<1, 64, 0, stream>>>(a);
#endif
#if PROBE_CHECK
    for (int p = 0; p < NPH; ++p) {
        a.ph_lo = p; a.ph_hi = p + 1;
        void* args[] = {&a};
        hipError_t e = hipLaunchCooperativeKernel((const void*)mk_fwd, dim3(grid), dim3(512), args, LDS_BYTES, stream);
        if (e != hipSuccess) fprintf(stderr, "cooperative launch failed: %s (grid %d)\n", hipGetErrorString(e), grid);
        if (p >= 1 && p < NPH - 1 && (p - 1) % 6 == 4) chk_kernel<<<64, 256, 0, stream>>>(a, (p - 1) / 6, 0);
        if (p >= 1 && p < NPH - 1 && (p - 1) % 6 == 5) chk_kernel<<<64, 256, 0, stream>>>(a, (p - 1) / 6, 1);
        if (p == NPH - 1) chk_kernel<<<64, 256, 0, stream>>>(a, 0, 2);
    }
#else
    {
        a.ph_lo = 0; a.ph_hi = NPH;
        void* args[] = {&a};
        hipError_t e = hipLaunchCooperativeKernel((const void*)mk_fwd, dim3(grid), dim3(512), args, LDS_BYTES, stream);
        if (e != hipSuccess) fprintf(stderr, "cooperative launch failed: %s (grid %d)\n", hipGetErrorString(e), grid);
    }
#endif
#if PROBE_CHECK
    chk_encode<<<256, 256, 0, stream>>>(a, out_size);
#endif
}
```

```cpp
#include <hip/hip_runtime.h>
#include <hip/hip_cooperative_groups.h>
#include <cstdio>
#include <cstdint>
namespace cg = cooperative_groups;

#ifndef PROBE_TIMING
#define PROBE_TIMING 0
#endif
#ifndef GEMM_MASK
#define GEMM_MASK 7
#endif
#ifndef ITEM_MASK
#define ITEM_MASK 127
#endif
#ifndef PROBE_CHECK
#define PROBE_CHECK 0
#endif

#define LAS __attribute__((address_space(3)))
typedef unsigned short bf16;
typedef short bf16x8 __attribute__((ext_vector_type(8)));
typedef float f32x4 __attribute__((ext_vector_type(4)));
typedef float f32x2 __attribute__((ext_vector_type(2)));
typedef unsigned u32x4 __attribute__((ext_vector_type(4)));
typedef unsigned u32x2 __attribute__((ext_vector_type(2)));
typedef unsigned long long u64;

constexpr int DM = 2048, TP = 8192, TS = 1024, TT = TP + TS, NL = 2;
constexpr int PB = 4, PSEQ = 2048, SB = 128, SSEQ = 8;
constexpr int IN_COLS = 21008, NT1 = 83, N1 = NT1 * 256;
constexpr int HEADS = 16, HD = 64, GROUPS = 4, NST = 128, CHUNK = 128, NCH = PSEQ / CHUNK;
constexpr int XBC_W = 2048, CFW = 1024, SCW = 1024;
constexpr int C_Z = 0, C_XBC = 1024, C_DT = 3072, C_CFA = 3088, C_CFB = 4112, C_CFG = 5136, C_GB = 6160, C_GC = 7184, C_SV = 8208, C_SCG = 9232,
              C_Q = 10256, C_K = 11280, C_V = 11536, C_AG = 11792, C_MG = 12816;

constexpr size_t MiB = 1u << 20;
constexpr size_t WS_CTL = 0, CTL_BYTES = 1 * MiB;
constexpr size_t WS_SSQ = 1 * MiB;
constexpr size_t WS_SSQA = 2 * MiB;
constexpr size_t WS_W1T = 16 * MiB;
constexpr size_t W1T_L = (size_t)N1 * DM * 2;
constexpr size_t WS_W2T = 192 * MiB;
constexpr size_t W2T_L = (size_t)DM * 4096 * 2;
constexpr size_t WS_W3T = 224 * MiB;
constexpr size_t W3T_L = (size_t)DM * DM * 2;
constexpr size_t WS_XB = 240 * MiB;
constexpr size_t WS_Z = 276 * MiB;
constexpr size_t WS_XBC = 294 * MiB;
constexpr size_t WS_U = 330 * MiB;
constexpr size_t WS_CFG = 348 * MiB;
constexpr size_t WS_CV = 366 * MiB;
constexpr size_t WS_CM = 384 * MiB;
constexpr size_t WS_Q = 402 * MiB;
constexpr size_t WS_KV = 420 * MiB;
constexpr size_t WS_AG = 429 * MiB;
constexpr size_t WS_MG = 447 * MiB;
constexpr size_t WS_DT = 591 * MiB;
constexpr size_t WS_ACT = 592 * MiB;
constexpr size_t WS_H = 664 * MiB;
constexpr size_t WS_CST = 700 * MiB;
constexpr size_t WS_HPREV = 732 * MiB;
constexpr size_t WS_CDEC = 748 * MiB;
constexpr size_t WS_DBG = 813 * MiB;
constexpr size_t WS_END = 814 * MiB;

constexpr int LDS_MISC = 147456, LDS_BYTES = LDS_MISC + 256;

__device__ __forceinline__ float bf2f(unsigned v) { return __uint_as_float(v << 16); }
typedef float f32x2c_t __attribute__((ext_vector_type(2))); typedef __bf16 bf16x2c_t __attribute__((ext_vector_type(2)));
__device__ __forceinline__ unsigned pk2(float lo, float hi) { const f32x2c_t v = {lo, hi}; const bf16x2c_t b = __builtin_convertvector(v, bf16x2c_t); return __builtin_bit_cast(unsigned, b); }
__device__ __forceinline__ unsigned f2bf(float f) { return pk2(f, 0.f) & 0xffffu; }
__device__ __forceinline__ float fsigmoid(float x) { return __builtin_amdgcn_rcpf(1.0f + __expf(-x)); }
__device__ __forceinline__ float fsilu(float x) { return x * fsigmoid(x); }
__device__ __forceinline__ float fsoftplus(float x) { return x > 15.f ? x : log1pf(__expf(x)); }
__device__ __forceinline__ float ssq_to_rstd(u64 s, float inv_n, float eps) { return rsqrtf((float)s * (inv_n * (1.0f / 1048576.0f)) + eps); }
__device__ __forceinline__ u64 ssq_fix(float s) { return (u64)((double)s * 1048576.0 + 0.5); }
#define LDS_WAIT() asm volatile("s_waitcnt lgkmcnt(0)" ::: "memory")
__device__ __forceinline__ int fresh_lane() { int ln = (int)__builtin_amdgcn_mbcnt_hi(~0u, __builtin_amdgcn_mbcnt_lo(~0u, 0u)); asm volatile("" : "+v"(ln)); return ln; }


template <int CTRL> __device__ __forceinline__ float dpp_f(float v) { return __int_as_float(__builtin_amdgcn_update_dpp(0, __float_as_int(v), CTRL, 0xf, 0xf, true)); }
__device__ __forceinline__ float red8_sum(float v) { v += dpp_f<0xB1>(v); v += dpp_f<0x4E>(v); v += dpp_f<0x141>(v); return v; }
__device__ __forceinline__ float red16_sum(float v) { v = red8_sum(v); v += dpp_f<0x140>(v); return v; }
__device__ __forceinline__ float red16_max(float v) { v = fmaxf(v, dpp_f<0xB1>(v)); v = fmaxf(v, dpp_f<0x4E>(v)); v = fmaxf(v, dpp_f<0x141>(v)); v = fmaxf(v, dpp_f<0x140>(v)); return v; }
__device__ __forceinline__ float rl_f(float v, int l) { return __int_as_float(__builtin_amdgcn_readlane(__float_as_int(v), l)); }
__device__ __forceinline__ float xor16_f(float v) { auto r = __builtin_amdgcn_permlane16_swap(__float_as_uint(v), __float_as_uint(v), false, false); return __uint_as_float(r[0] ^ r[1] ^ __float_as_uint(v)); }
__device__ __forceinline__ float xor32_f(float v) { auto r = __builtin_amdgcn_permlane32_swap(__float_as_uint(v), __float_as_uint(v), false, false); return __uint_as_float(r[0] ^ r[1] ^ __float_as_uint(v)); }

struct TileInfo { int mode, src0, src1, valid0, valid1; size_t dst; int ld, col0; };
enum { M_ID = 0, M_SILU = 1, M_SIG = 2, M_GLU = 3, M_MUL = 4, M_ASILUB = 5, M_DT = 6, M_SIGR = 7 };
__host__ __device__ __forceinline__ TileInfo tile_info(int pn) {
    TileInfo t; t.valid0 = 128; t.valid1 = 128;
    if (pn < 4)       { t.mode = M_SILU;   t.src0 = C_Z + 256 * pn;           t.src1 = t.src0 + 128; t.dst = WS_Z;   t.ld = 1024; t.col0 = 256 * pn; }
    else if (pn < 12) { t.mode = M_ID;     t.src0 = C_XBC + 256 * (pn - 4);   t.src1 = t.src0 + 128; t.dst = WS_XBC; t.ld = 2048; t.col0 = 256 * (pn - 4); }
    else if (pn < 20) { t.mode = M_GLU;    t.src0 = C_CFA + 128 * (pn - 12);  t.src1 = C_CFB + 128 * (pn - 12); t.dst = WS_U; t.ld = 1024; t.col0 = 128 * (pn - 12); }
    else if (pn < 24) { t.mode = M_SILU;   t.src0 = C_CFG + 256 * (pn - 20);  t.src1 = t.src0 + 128; t.dst = WS_CFG; t.ld = 1024; t.col0 = 256 * (pn - 20); }
    else if (pn < 32) { t.mode = M_MUL;    t.src0 = C_GC + 128 * (pn - 24);   t.src1 = C_SV + 128 * (pn - 24); t.dst = WS_CV; t.ld = 1024; t.col0 = 128 * (pn - 24); }
    else if (pn < 40) { t.mode = M_ASILUB; t.src0 = C_GB + 128 * (pn - 32);   t.src1 = C_SCG + 128 * (pn - 32); t.dst = WS_CM; t.ld = 1024; t.col0 = 128 * (pn - 32); }
    else if (pn < 44) { t.mode = M_ID;     t.src0 = C_Q + 256 * (pn - 40);    t.src1 = t.src0 + 128; t.dst = WS_Q;   t.ld = 1024; t.col0 = 256 * (pn - 40); }
    else if (pn < 46) { t.mode = M_ID;     t.src0 = C_K + 256 * (pn - 44);    t.src1 = t.src0 + 128; t.dst = WS_KV;  t.ld = 512;  t.col0 = 256 * (pn - 44); }
    else if (pn < 50) { t.mode = M_SILU;   t.src0 = C_AG + 256 * (pn - 46);   t.src1 = t.src0 + 128; t.dst = WS_AG;  t.ld = 1024; t.col0 = 256 * (pn - 46); }
    else if (pn < 82) { t.mode = M_SIGR;   t.src0 = C_MG + 64 * (pn - 50);    t.src1 = t.src0 + 4096; t.dst = WS_MG; t.ld = 8192; t.col0 = 64 * (pn - 50); }
    else              { t.mode = M_DT;     t.src0 = C_DT; t.src1 = 0; t.valid0 = 16; t.valid1 = 0; t.dst = WS_DT; t.ld = 16; t.col0 = 0; }
    return t;
}

namespace pg8 {
constexpr int BM = 256, BK = 64, HALF = 128, HTB = HALF * BK * 2, STAGE_BYTES = 8 * HTB, NXCD = 8, WGM = 4;
__host__ __device__ __forceinline__ int lds_byte(int r, int c) { const int st = (r >> 4) * 2 + (c >> 5), rr = r & 15, cc = c & 31, ob = rr * 64 + cc * 2; return st * 1024 + (ob ^ (((ob >> 9) & 1) << 5)); }
__host__ __device__ __forceinline__ void stage_rc(int b, int& R, int& C) { const int st = b / 1024, sb = b % 1024, swz = sb ^ (((sb >> 9) & 1) << 5); R = (st >> 1) * 16 + swz / 64; C = (st & 1) * 32 + (swz % 64) / 2; }
__host__ __device__ __forceinline__ int perm32(int rho) { const int n = rho >> 4, i = rho & 15; return 8 * (i >> 2) + 4 * n + (i & 3); }

struct Unit { int pm, pn, sub; };
struct Gemm { const bf16* A; const bf16* Bt; int lda, ldb, nt, ksubA, ksubB; };

struct Order {
    int nM, nN, nwg, G, c, nsub, pperm;
    __device__ void init(int nM_, int nN_, int G_, int c_, int nsub_) { nM = nM_; nN = nN_; nwg = nM * nN; G = G_; c = c_; nsub = nsub_; pperm = 0; }
    __device__ bool next(int i, Unit& u) const {
        const int gi = i / nsub; u.sub = i - gi * nsub;
        const long L = (long)gi * G + c; if (L >= nwg) return false;
        int wgid = (int)L; { const int q = nwg / NXCD, r = nwg % NXCD, xcd = wgid % NXCD, off = wgid / NXCD; wgid = (xcd < r ? xcd * (q + 1) : r * (q + 1) + (xcd - r) * q) + off; }
        const int nig = WGM * nN, gid = wgid / nig, fm = gid * WGM, gsz = (nM - fm) < WGM ? (nM - fm) : WGM;
        u.pm = fm + ((wgid % nig) % gsz); u.pn = (wgid % nig) / gsz;
        if (pperm) { const int p = u.pn; u.pn = p < 4 ? p : (p < 73 ? p + 8 : (p < 81 ? p - 69 : (p == 81 ? 82 : 81))); }
        return true;
    }
};

struct ListOrder {
    int g0, g1, n, nsub;
    __device__ bool next(int i, Unit& u) const {
        const int gi = i / nsub; u.sub = i - gi * nsub; if (gi >= n) return false;
        const int g = gi == 0 ? g0 : g1; u.pm = g >> 3; u.pn = g & 7; return true;
    }
};
template <class Epi, class Sched>
__device__ __forceinline__ void gemm_phase(LAS unsigned char* lds, const Gemm g, const Sched& S, const Epi& E) {
    int tid = threadIdx.x; asm volatile("" : "+v"(tid));
    const int wid = __builtin_amdgcn_readfirstlane(tid >> 6), lane = tid & 63, wr = wid >> 2, wc = wid & 3, fr = lane & 15, fq = lane >> 4;
    const int nt = g.nt;
    unsigned voffA[2], voffB[2];
#pragma unroll
    for (int i = 0; i < 2; ++i) { int R, C; stage_rc(tid * 16 + i * 8192, R, C); const int Rb = Epi::PERM ? ((R & ~31) + perm32(R & 31)) : R;
        voffA[i] = (unsigned)(R * g.lda + C) * 2u; voffB[i] = (unsigned)(Rb * g.ldb + C) * 2u; }
    const size_t kstep = (size_t)(BK * 2);
    const size_t hstepA = (size_t)HALF * g.lda * 2, hstepB = (size_t)HALF * g.ldb * 2;
    const size_t tstepA = 2 * hstepA, tstepB = 2 * hstepB;
    const unsigned ldsw = (unsigned)wid * 1024u;
    const int aoff = lds_byte(wr * 64 + fr, fq * 8), boff = lds_byte(wc * 32 + fr, fq * 8);
#define PG8_SA(b, h) (((b) * 2 + (h)) * HTB)
#define PG8_SB(b, h) ((4 + (b) * 2 + (h)) * HTB)
#define PG8_STAGE(bufoff, gbase, voff) do { _Pragma("unroll") for (int _i = 0; _i < 2; ++_i) \
        __builtin_amdgcn_global_load_lds((const unsigned*)((const char*)(gbase) + (voff)[_i]), (LAS unsigned*)(lds + (bufoff) + ldsw + _i * 8192), 16, 0, 0); } while (0)
#define PG8_LDA(dst, b, h) do { _Pragma("unroll") for (int m = 0; m < 4; ++m) _Pragma("unroll") for (int k = 0; k < 2; ++k) dst[m][k] = *(const LAS bf16x8*)(lds + PG8_SA(b, h) + aoff + m * 2048 + k * 1024); } while (0)
#define PG8_LDB(dst, b, h) do { _Pragma("unroll") for (int n = 0; n < 2; ++n) _Pragma("unroll") for (int k = 0; k < 2; ++k) dst[n][k] = *(const LAS bf16x8*)(lds + PG8_SB(b, h) + boff + n * 2048 + k * 1024); } while (0)
#define PG8_MMA(ai, bj, At, Bt) do { __builtin_amdgcn_s_setprio(1); _Pragma("unroll") for (int m = 0; m < 4; ++m) _Pragma("unroll") for (int n = 0; n < 2; ++n) _Pragma("unroll") for (int k = 0; k < 2; ++k) \
        acc[ai][bj][m][n] = __builtin_amdgcn_mfma_f32_16x16x32_bf16(Bt[n][k], At[m][k], acc[ai][bj][m][n], 0, 0, 0); __builtin_amdgcn_s_setprio(0); } while (0)
#define PG8_WAIT_V(n) asm volatile("s_waitcnt vmcnt(" #n ")" ::: "memory")
#define PG8_WAIT_L(n) asm volatile("s_waitcnt lgkmcnt(" #n ")" ::: "memory")
#define PG8_BAR __builtin_amdgcn_s_barrier()
#define PG8_SCHED __builtin_amdgcn_sched_barrier(0)
    Unit cur, nxt; int ui = 0;
    if (!S.next(0, cur)) return;
    f32x4 acc[2][2][4][2];
#pragma unroll
    for (int a = 0; a < 2; ++a)
#pragma unroll
        for (int b = 0; b < 2; ++b)
#pragma unroll
            for (int m = 0; m < 4; ++m)
#pragma unroll
                for (int n = 0; n < 2; ++n) acc[a][b][m][n] = (f32x4){0.f, 0.f, 0.f, 0.f};
    bf16x8 At[4][2], B0[2][2], B1[2][2];
    const char* cA = (const char*)g.A + (size_t)cur.pm * tstepA + (size_t)cur.sub * g.ksubA * 2; const char* cB = (const char*)g.Bt + (size_t)cur.pn * tstepB + (size_t)cur.sub * g.ksubB * 2;
    E.prefetch(cur, lds, 0);
    PG8_STAGE(PG8_SB(0, 0), cB, voffB); PG8_STAGE(PG8_SB(0, 1), cB + hstepB, voffB); PG8_STAGE(PG8_SA(0, 0), cA, voffA); PG8_STAGE(PG8_SA(0, 1), cA + hstepA, voffA);
    if (wr == 1) PG8_BAR;
    PG8_WAIT_V(2); PG8_BAR;
    PG8_STAGE(PG8_SB(1, 0), cB + kstep, voffB); PG8_STAGE(PG8_SA(1, 0), cA + kstep, voffA); PG8_STAGE(PG8_SB(1, 1), cB + hstepB + kstep, voffB);
    PG8_WAIT_V(6); PG8_BAR;
    for (;;) {
        const bool has_next = S.next(ui + 1, nxt);
        const char* nA = has_next ? (const char*)g.A + (size_t)nxt.pm * tstepA + (size_t)nxt.sub * g.ksubA * 2 : cA;
        const char* nB = has_next ? (const char*)g.Bt + (size_t)nxt.pn * tstepB + (size_t)nxt.sub * g.ksubB * 2 : cB;
        for (int t = 0; t < nt; t += 2) {
            const bool last = (t == nt - 2);
            const char* a1 = cA + (size_t)(t + 1) * kstep;
            const char* a2 = last ? nA : cA + (size_t)(t + 2) * kstep; const char* b2 = last ? nB : cB + (size_t)(t + 2) * kstep;
            const char* a3 = a2 + kstep; const char* b3 = b2 + kstep;
            PG8_LDB(B0, 0, 0); PG8_LDB(B1, 0, 1); PG8_SCHED; PG8_LDA(At, 0, 0); PG8_STAGE(PG8_SA(1, 1), a1 + hstepA, voffA);
            PG8_WAIT_V(8); PG8_WAIT_L(0); PG8_BAR; PG8_MMA(0, 0, At, B0); PG8_MMA(0, 1, At, B1); PG8_BAR; PG8_SCHED;
            PG8_LDA(At, 0, 1); PG8_STAGE(PG8_SB(0, 0), b2, voffB); PG8_STAGE(PG8_SB(0, 1), b2 + hstepB, voffB); PG8_STAGE(PG8_SA(0, 0), a2, voffA);
            PG8_WAIT_V(8); PG8_WAIT_L(0); PG8_BAR; PG8_MMA(1, 0, At, B0); PG8_MMA(1, 1, At, B1); PG8_BAR; PG8_SCHED;
            PG8_LDB(B0, 1, 0); PG8_LDB(B1, 1, 1); PG8_SCHED; PG8_LDA(At, 1, 0); PG8_STAGE(PG8_SA(0, 1), a2 + hstepA, voffA);
            PG8_WAIT_V(8); PG8_WAIT_L(0); PG8_BAR; PG8_MMA(0, 0, At, B0); PG8_MMA(0, 1, At, B1); PG8_BAR; PG8_SCHED;
            PG8_LDA(At, 1, 1); PG8_STAGE(PG8_SB(1, 0), b3, voffB); PG8_STAGE(PG8_SB(1, 1), b3 + hstepB, voffB); PG8_STAGE(PG8_SA(1, 0), a3, voffA);
            PG8_WAIT_V(8); PG8_WAIT_L(0); PG8_BAR; PG8_MMA(1, 0, At, B0); PG8_MMA(1, 1, At, B1); PG8_BAR; PG8_SCHED;
        }
        if (wr == 0) PG8_BAR;
        E(acc, cur, wr, wc, fr, fq, lds, ui & 1);
        E.after(ui, lds);
        if (!has_next) break;
        E.prefetch(nxt, lds, (ui + 1) & 1);
        if (!Epi::ACCUM || nxt.sub == 0) {
#pragma unroll
        for (int a = 0; a < 2; ++a)
#pragma unroll
            for (int b = 0; b < 2; ++b)
#pragma unroll
                for (int m = 0; m < 4; ++m)
#pragma unroll
                    for (int n = 0; n < 2; ++n) acc[a][b][m][n] = (f32x4){0.f, 0.f, 0.f, 0.f};
        }
        cur = nxt; cA = nA; cB = nB; ++ui;
        if (wr == 1) PG8_BAR;
    }
    PG8_WAIT_V(0);
    PG8_BAR;
#undef PG8_SA
#undef PG8_SB
#undef PG8_STAGE
#undef PG8_LDA
#undef PG8_LDB
#undef PG8_MMA
#undef PG8_WAIT_V
#undef PG8_WAIT_L
#undef PG8_BAR
#undef PG8_SCHED
}
}

__device__ __forceinline__ void handoff_arrive(unsigned* ho, volatile LAS unsigned* st);
struct Epi1 {
    static constexpr bool PERM = true, ACCUM = false;
    unsigned char* ws; const u64* ssq; const float* dt_bias; unsigned* ho;
    __device__ __forceinline__ void after(int ui, LAS unsigned char* lds) const { if (ho != nullptr && ui == 10) handoff_arrive(ho, (volatile LAS unsigned*)(lds + LDS_MISC)); }
    __device__ __forceinline__ void prefetch(const pg8::Unit& u, LAS unsigned char* lds, int slot) const {
        int t = threadIdx.x; asm volatile("" : "+v"(t));
        if (t < 256) ((LAS float*)(lds + 131072))[slot * 256 + t] = ssq_to_rstd(ssq[u.pm * 256 + t], 1.0f / 2048.0f, 1e-6f);
    }
    __device__ __forceinline__ void operator()(f32x4 (&acc)[2][2][4][2], const pg8::Unit& u, int wr, int wc, int fr, int fq, LAS unsigned char* lds, int slot) const {
        const TileInfo ti = tile_info(u.pn);
        { const int ln = fresh_lane(); fr = ln & 15; fq = ln >> 4; }
        const int row0 = u.pm * 256 + wr * 64 + fr;
        float rs[2][4];
#pragma unroll
        for (int ai = 0; ai < 2; ++ai)
#pragma unroll
            for (int m = 0; m < 4; ++m) rs[ai][m] = ((const LAS float*)(lds + 131072))[slot * 256 + wr * 64 + fr + ai * 128 + m * 16];
        const int cl = wc * 32 + 8 * fq;
        if (ti.mode == M_SIGR) {
            bf16* base = (bf16*)(ws + ti.dst) + ti.col0 + wc * 16 + 4 * fq;
#pragma unroll
            for (int ai = 0; ai < 2; ++ai)
#pragma unroll
                for (int m = 0; m < 4; ++m) { bf16* rowp = base + (size_t)(row0 + ai * 128 + m * 16) * 8192; const float r = rs[ai][m];
                    float g[4][4];
#pragma unroll
                    for (int b = 0; b < 4; ++b)
#pragma unroll
                        for (int j = 0; j < 4; ++j) g[b][j] = fmaxf(fsigmoid(acc[ai][b >> 1][m][b & 1][j] * r), 1e-12f);
#pragma unroll
                    for (int b = 0; b < 4; ++b) { float v[4];
#pragma unroll
                        for (int j = 0; j < 4; ++j) v[j] = b < 3 ? g[b][j] * __builtin_amdgcn_rcpf(g[b < 3 ? b + 1 : 3][j]) : g[3][j];
                        u32x2 w; w.x = pk2(v[0], v[1]); w.y = pk2(v[2], v[3]);
                        *(u32x2*)(rowp + b * 2048) = w; } }
        } else if (ti.mode <= M_SIG) {
            bf16* base = (bf16*)(ws + ti.dst) + ti.col0 + cl;
#pragma unroll
            for (int ai = 0; ai < 2; ++ai)
#pragma unroll
                for (int m = 0; m < 4; ++m) { bf16* rowp = base + (size_t)(row0 + ai * 128 + m * 16) * ti.ld; const float r = rs[ai][m];
#pragma unroll
                    for (int bj = 0; bj < 2; ++bj) { float v[8];
#pragma unroll
                        for (int j = 0; j < 4; ++j) { v[j] = acc[ai][bj][m][0][j] * r; v[4 + j] = acc[ai][bj][m][1][j] * r; }
                        if (ti.mode == M_SILU) {
#pragma unroll
                            for (int j = 0; j < 8; ++j) v[j] = fsilu(v[j]); }
                        else if (ti.mode == M_SIG) {
#pragma unroll
                            for (int j = 0; j < 8; ++j) v[j] = fsigmoid(v[j]); }
                        u32x4 w; w.x = pk2(v[0], v[1]); w.y = pk2(v[2], v[3]); w.z = pk2(v[4], v[5]); w.w = pk2(v[6], v[7]);
                        *(u32x4*)(rowp + bj * 128) = w; } }
        } else if (ti.mode != M_DT) {
            bf16* base = (bf16*)(ws + ti.dst) + ti.col0 + cl;
#pragma unroll
            for (int ai = 0; ai < 2; ++ai)
#pragma unroll
                for (int m = 0; m < 4; ++m) { bf16* rowp = base + (size_t)(row0 + ai * 128 + m * 16) * ti.ld; const float r = rs[ai][m]; float v[8];
#pragma unroll
                    for (int j = 0; j < 8; ++j) { const float a = acc[ai][0][m][j >> 2][j & 3] * r, b = acc[ai][1][m][j >> 2][j & 3] * r;
                        v[j] = ti.mode == M_GLU ? a * fsigmoid(b) : (ti.mode == M_MUL ? a * b : a * fsilu(b)); }
                    u32x4 w; w.x = pk2(v[0], v[1]); w.y = pk2(v[2], v[3]); w.z = pk2(v[4], v[5]); w.w = pk2(v[6], v[7]);
                    *(u32x4*)rowp = w; }
        } else {
            if (wc == 0 && fq < 2) {
                float* base = (float*)(ws + ti.dst) + 8 * fq;
                const f32x4 b0 = *(const f32x4*)(dt_bias + 8 * fq), b1 = *(const f32x4*)(dt_bias + 8 * fq + 4);
#pragma unroll
                for (int ai = 0; ai < 2; ++ai)
#pragma unroll
                    for (int m = 0; m < 4; ++m) { float* rowp = base + (size_t)(row0 + ai * 128 + m * 16) * 16; const float r = rs[ai][m]; f32x4 o0, o1;
#pragma unroll
                        for (int j = 0; j < 4; ++j) { o0[j] = fsoftplus(acc[ai][0][m][0][j] * r + b0[j]); o1[j] = fsoftplus(acc[ai][0][m][1][j] * r + b1[j]); }
                        *(f32x4*)rowp = o0; *(f32x4*)(rowp + 4) = o1; }
            }
        }
    }
};

struct Args { const float* in[28]; float* out; unsigned char* ws; int ph_lo, ph_hi; };
enum { I_XP = 0, I_XS, I_SSM, I_CSSM, I_CCF, I_CSC, I_CK, I_CVV, I_NORMW, I_WIN, I_SCONVW, I_SCONVB, I_DTB, I_ALOG, I_DSKIP, I_SNORMW, I_WOSSM,
       I_CFCW, I_CFCB, I_CFLNW, I_CFLNB, I_WOCF, I_SCCW, I_WOSC, I_SINK, I_WOATT, I_WO, I_FNW };
#define GAS __attribute__((address_space(1)))
__device__ __forceinline__ const float* inp(const Args& a, int i) { asm volatile("" : "+s"(i)); const GAS float* q = (const GAS float*)a.in[i]; asm volatile("" : "+s"(q)); return (const float*)q; }
__device__ __forceinline__ unsigned char* wsp(const Args& a) { GAS unsigned char* w = (GAS unsigned char*)a.ws; asm volatile("" : "+s"(w)); return (unsigned char*)w; }
__device__ __forceinline__ float* outp(const Args& a) { GAS float* w = (GAS float*)a.out; asm volatile("" : "+s"(w)); return (float*)w; }

struct TrP { const float* W; size_t ldw; int src, valid; const float* ks; int k0; bf16* dst; size_t ldk; int dk0; int gm; };
__device__ __forceinline__ void tr_load(const TrP& P, int lane, f32x4 (&v)[16]) {
    const int q = lane & 15, n4 = q * 4, kq = lane >> 4;
    const int scol = P.src + (P.gm ? (q & 1) * 2048 + (q >> 3) * 16 + ((q >> 1) & 3) * 4 : n4);
#pragma unroll
    for (int i = 0; i < 16; ++i) v[i] = (n4 < P.valid) ? __builtin_nontemporal_load((const f32x4*)(P.W + (size_t)(P.k0 + 4 * i + kq) * P.ldw + scol)) : (f32x4){0.f, 0.f, 0.f, 0.f};
}
__device__ __forceinline__ void tr_finish(const TrP& P, const f32x4 (&v)[16], LAS float* scr, int lane) {
    const int n4 = (lane & 15) * 4, kq = lane >> 4;
#pragma unroll
    for (int i = 0; i < 16; ++i) { const int kk = 4 * i + kq; const float sc = P.ks ? P.ks[P.k0 + kk] : 1.f; LAS float* d = scr + kk * 65 + n4;
        d[0] = v[i].x * sc; d[1] = v[i].y * sc; d[2] = v[i].z * sc; d[3] = v[i].w * sc; }
    LDS_WAIT(); asm volatile("" ::: "memory");
    const int c = lane & 7;
#pragma unroll
    for (int j = 0; j < 8; ++j) { const int n = (lane >> 3) + 8 * j; const LAS float* sp = scr + (8 * c) * 65 + n;
        u32x4 o; o.x = pk2(sp[0 * 65], sp[1 * 65]); o.y = pk2(sp[2 * 65], sp[3 * 65]); o.z = pk2(sp[4 * 65], sp[5 * 65]); o.w = pk2(sp[6 * 65], sp[7 * 65]);
        *(u32x4*)(P.dst + (size_t)n * P.ldk + P.dk0 + P.k0 + 8 * c) = o; }
    LDS_WAIT(); asm volatile("" ::: "memory");
}
__device__ __forceinline__ float wave_sum(float v) {
    v = red16_sum(v);
    return (rl_f(v, 0) + rl_f(v, 16)) + (rl_f(v, 32) + rl_f(v, 48));
}
__device__ __forceinline__ float wave_max(float v) { v = red16_max(v); return fmaxf(fmaxf(rl_f(v, 0), rl_f(v, 16)), fmaxf(rl_f(v, 32), rl_f(v, 48))); }

__device__ __forceinline__ void phase_prologue(const Args& a, LAS unsigned char* lds, int gw, int ngw, int wave, int lane, int l_lo, int l_hi, bool do_x) {
    LAS float* scr = (LAS float*)(lds + wave * 16640);
    constexpr int I1 = (DM / 64) * (N1 / 64), I2 = 4 * (1024 / 64) * (DM / 64), I3 = (DM / 64) * (DM / 64), IL = I1 + I2 + I3;
    auto decode = [&](int it) -> TrP {
        const int l = l_lo + it / IL; int r = it % IL; TrP P;
        if (r < I1) {
            const int nb = r % (N1 / 64), kb = r / (N1 / 64), pn = nb >> 2, sb = nb & 3, half = sb >> 1;
            const TileInfo ti = tile_info(pn);
            int valid = (half ? ti.valid1 : ti.valid0) - (sb & 1) * 64; valid = valid < 0 ? 0 : (valid > 64 ? 64 : valid);
            P.W = inp(a, I_WIN) + (size_t)l * DM * IN_COLS; P.ldw = IN_COLS; P.gm = ti.mode == M_SIGR; P.src = (half ? ti.src1 : ti.src0) + (sb & 1) * (P.gm ? 32 : 64); P.valid = valid; P.ks = inp(a, I_NORMW) + l * DM; P.k0 = kb * 64;
            P.dst = (bf16*)(wsp(a) + WS_W1T + l * W1T_L) + (size_t)(nb * 64) * DM; P.ldk = DM; P.dk0 = 0; return P; }
        r -= I1;
        if (r < I2) {
            const int br = r / (I2 / 4), rr = r % (I2 / 4), nb = rr % (DM / 64), kb = rr / (DM / 64);
            P.W = inp(a, br == 0 ? I_WOSSM : (br == 1 ? I_WOCF : (br == 2 ? I_WOSC : I_WOATT))) + (size_t)l * 1024 * DM; P.ldw = DM; P.src = nb * 64; P.valid = 64; P.gm = 0;
            P.ks = br == 0 ? inp(a, I_SNORMW) + l * 1024 : nullptr; P.k0 = kb * 64;
            P.dst = (bf16*)(wsp(a) + WS_W2T + l * W2T_L) + (size_t)(nb * 64) * 4096; P.ldk = 4096; P.dk0 = br * 1024; return P; }
        r -= I2;
        { const int nb = r % (DM / 64), kb = r / (DM / 64);
          P.W = inp(a, I_WO) + (size_t)l * DM * DM; P.ldw = DM; P.src = nb * 64; P.valid = 64; P.gm = 0; P.ks = nullptr; P.k0 = kb * 64;
          P.dst = (bf16*)(wsp(a) + WS_W3T + l * W3T_L) + (size_t)(nb * 64) * DM; P.ldk = DM; P.dk0 = 0; return P; }
    };
    {
        const int nit = (l_hi - l_lo) * IL;
        if (gw < nit) {
            TrP cur = decode(gw); f32x4 v[16]; tr_load(cur, lane, v);
#pragma unroll 1
            for (int it = gw; ; ) {
                const int nx = it + ngw; const bool more = nx < nit;
                TrP nxt = cur; f32x4 vn[16];
                if (more) { nxt = decode(nx); tr_load(nxt, lane, vn); }
                tr_finish(cur, v, scr, lane);
                if (!more) break;
                cur = nxt; it = nx;
#pragma unroll
                for (int i = 0; i < 16; ++i) v[i] = vn[i];
            }
        }
    }
    if (!do_x) return;
    for (int m = gw; m < TT; m += ngw) {
        const float* xr = (m < TP) ? inp(a, I_XP) + (size_t)m * DM : inp(a, I_XS) + (size_t)(m - TP) * DM;
        const f32x4* x4 = (const f32x4*)xr + lane; u64* o8 = (u64*)((bf16*)(wsp(a) + WS_XB) + (size_t)m * DM) + lane; float s = 0.f;
#pragma unroll
        for (int j = 0; j < 8; ++j) { const f32x4 v = __builtin_nontemporal_load(x4 + 64 * j); s += (v.x * v.x + v.y * v.y) + (v.z * v.z + v.w * v.w); o8[64 * j] = (u64)pk2(v.x, v.y) | ((u64)pk2(v.z, v.w) << 32); }
        s = wave_sum(s);
        if (lane == 0) ((u64*)(wsp(a) + WS_SSQ))[m] = ssq_fix(s);
    }
    for (int i = gw * 64 + lane; i < 2 * TT; i += ngw * 64) { ((u64*)(wsp(a) + WS_SSQ))[TT + i] = 0ull; ((u64*)(wsp(a) + WS_SSQA))[i] = 0ull; }
}


constexpr size_t O_YP = 0, O_YS = 16777216, O_PSSM = 18874368, O_PCSSM = 19922944, O_PCCF = 19972096, O_PCSC = 20217856, O_PK = 20234240, O_PV = 20496384,
                 O_SSSM = 20758528, O_SCSSM = 54312960, O_SCCF = 55885824, O_SCSC = 63750144, O_SK = 64274432, O_SV = 72663040, O_TOTAL = 81051648;

template <bool SAMPLE>
__device__ __forceinline__ void conv_item(const Args& a, int l, int item, LAS unsigned char* lds, int tid, int wave, int lane) {
    asm volatile("" : "+v"(tid), "+v"(lane), "+s"(wave), "+s"(item));
    constexpr int NT = SAMPLE ? 8 : 16;
    int b, row0, t0;
    if (SAMPLE) { b = item; t0 = 0; row0 = TP + 8 * b; } else { b = item >> 7; t0 = (item & 127) * 16; row0 = b * PSEQ + t0; }
    const bf16* U = (const bf16*)(wsp(a) + WS_U); const bf16* CV = (const bf16*)(wsp(a) + WS_CV); const bf16* CM = (const bf16*)(wsp(a) + WS_CM);
    const bf16* CFG = (const bf16*)(wsp(a) + WS_CFG); const bf16* XBC = (const bf16*)(wsp(a) + WS_XBC); bf16* ACT = (bf16*)(wsp(a) + WS_ACT);
    const int c0 = 2 * tid;
    __syncthreads();
    {
        f32x2 wk[31];
        const float* cw = inp(a, I_CFCW) + (size_t)l * 31 * 1024 + c0;
#pragma unroll
        for (int k = 0; k < 31; ++k) wk[k] = *(const f32x2*)(cw + k * 1024);
        const f32x2 bias = *(const f32x2*)(inp(a, I_CFCB) + l * 1024 + c0);
        float acc0[NT], acc1[NT];
#pragma unroll
        for (int t = 0; t < NT; ++t) { acc0[t] = bias.x; acc1[t] = bias.y; }
        unsigned inw[NT + 30]; f32x2 pre[SAMPLE ? 30 : 1];
        if (SAMPLE) {
#pragma unroll
            for (int r = 0; r < 30; ++r) pre[r] = __builtin_nontemporal_load((const f32x2*)(inp(a, I_CCF) + (((size_t)l * SB + b) * 30 + r) * 1024 + c0));
#pragma unroll
            for (int r = 0; r < NT; ++r) inw[30 + r] = *(const unsigned*)(U + (size_t)(row0 + r) * 1024 + c0);
            float* o_cf = outp(a) + O_SCCF + ((size_t)l * SB + b) * 30 * 1024 + c0;
#pragma unroll
            for (int rr = 0; rr < 22; ++rr) __builtin_nontemporal_store(pre[rr + 8], (f32x2*)(o_cf + (size_t)rr * 1024));
#pragma unroll
            for (int rr = 0; rr < 8; ++rr) __builtin_nontemporal_store((f32x2){bf2f(inw[30 + rr] & 0xffffu), bf2f(inw[30 + rr] >> 16)}, (f32x2*)(o_cf + (size_t)(22 + rr) * 1024));
        } else {
#pragma unroll
            for (int i = 0; i < 12; ++i) { const int p = wave + 8 * i; if (p < 92) { const int rowi = p >> 1, half = p & 1;
                if (t0 + rowi - 30 >= 0) __builtin_amdgcn_global_load_lds((const unsigned*)(U + (size_t)(row0 + rowi - 30) * 1024 + half * 512 + lane * 8), (LAS unsigned*)(lds + rowi * 2048 + half * 1024), 16, 0, 0); } }
            asm volatile("s_waitcnt vmcnt(0)" ::: "memory"); __syncthreads(); asm volatile("" ::: "memory");
#pragma unroll
            for (int r = 0; r < NT + 30; ++r) { const unsigned w = *(const LAS unsigned*)(lds + r * 2048 + c0 * 2); inw[r] = (t0 + r - 30 < 0) ? 0u : w; }
        }
#pragma unroll
        for (int r = -30; r < NT; ++r) {
            float v0, v1;
            if (SAMPLE && r < 0) { v0 = pre[r + 30].x; v1 = pre[r + 30].y; }
            else { const unsigned w = inw[r + 30]; v0 = bf2f(w & 0xffffu); v1 = bf2f(w >> 16); }
#pragma unroll
            for (int t = 0; t < NT; ++t) { const int k = r - t + 30; if (k >= 0 && k <= 30) { acc0[t] += wk[k].x * v0; acc1[t] += wk[k].y * v1; } }
        }
        if (!SAMPLE) __syncthreads();
        LAS float* tile = (LAS float*)lds;
#pragma unroll
        for (int t = 0; t < NT; ++t) *(LAS f32x2*)(tile + t * 1024 + c0) = (f32x2){acc0[t], acc1[t]};
    }
    f32x4 lw[4], lb[4]; u32x2 gwv[NT / 8][4];
#pragma unroll
    for (int j = 0; j < 4; ++j) { const int c = 256 * j + 4 * lane; lw[j] = *(const f32x4*)(inp(a, I_CFLNW) + l * 1024 + c); lb[j] = *(const f32x4*)(inp(a, I_CFLNB) + l * 1024 + c);
#pragma unroll
        for (int tt = 0; tt < NT / 8; ++tt) gwv[tt][j] = *(const u32x2*)(CFG + (size_t)(row0 + wave + 8 * tt) * 1024 + c); }
    f32x2 w3[3]; f32x2 in[NT + 2]; unsigned inr[NT + 2], mwv[NT];
#pragma unroll
    for (int k = 0; k < 3; ++k) w3[k] = *(const f32x2*)(inp(a, I_SCCW) + (size_t)l * 3 * 1024 + k * 1024 + c0);
#pragma unroll
    for (int r = -2; r < NT; ++r) {
        if (SAMPLE && r < 0) in[r + 2] = *(const f32x2*)(inp(a, I_CSC) + (((size_t)l * SB + b) * 2 + (2 + r)) * 1024 + c0);
        else { const int rr = (!SAMPLE && t0 + r < 0) ? 0 : r; inr[r + 2] = *(const unsigned*)(CV + (size_t)(row0 + rr) * 1024 + c0); } }
#pragma unroll
    for (int t = 0; t < NT; ++t) mwv[t] = *(const unsigned*)(CM + (size_t)(row0 + t) * 1024 + c0);
    __syncthreads();
    {
        LAS float* tile = (LAS float*)lds;
#pragma unroll
        for (int tt = 0; tt < NT / 8; ++tt) {
            const int t = wave + 8 * tt; const int row = row0 + t;
            f32x4 x[4]; float s = 0.f;
#pragma unroll
            for (int j = 0; j < 4; ++j) { x[j] = *(LAS f32x4*)(tile + t * 1024 + 256 * j + 4 * lane); s += (x[j].x + x[j].y) + (x[j].z + x[j].w); }
            const float mean = wave_sum(s) * (1.f / 1024.f); float q = 0.f;
#pragma unroll
            for (int j = 0; j < 4; ++j) { x[j] = x[j] - mean; q += (x[j].x * x[j].x + x[j].y * x[j].y) + (x[j].z * x[j].z + x[j].w * x[j].w); }
            const float rstd = rsqrtf(wave_sum(q) * (1.f / 1024.f) + 1e-5f);
#pragma unroll
            for (int j = 0; j < 4; ++j) { const int c = 256 * j + 4 * lane; const u32x2 gw = gwv[tt][j];
                float y[4];
#pragma unroll
                for (int e = 0; e < 4; ++e) y[e] = fsilu(x[j][e] * rstd * lw[j][e] + lb[j][e]);
                y[0] *= bf2f(gw.x & 0xffffu); y[1] *= bf2f(gw.x >> 16); y[2] *= bf2f(gw.y & 0xffffu); y[3] *= bf2f(gw.y >> 16);
                u32x2 o; o.x = pk2(y[0], y[1]); o.y = pk2(y[2], y[3]);
                *(u32x2*)(ACT + (size_t)row * 4096 + 1024 + c) = o; }
        }
    }
    {
#pragma unroll
        for (int r = -2; r < NT; ++r) if (!(SAMPLE && r < 0)) { const unsigned w = inr[r + 2]; in[r + 2] = (!SAMPLE && t0 + r < 0) ? (f32x2){0.f, 0.f} : (f32x2){bf2f(w & 0xffffu), bf2f(w >> 16)}; }
#pragma unroll
        for (int t = 0; t < NT; ++t) {
            const unsigned mw = mwv[t];
            const float y0 = (w3[0].x * in[t].x + w3[1].x * in[t + 1].x + w3[2].x * in[t + 2].x) * bf2f(mw & 0xffffu);
            const float y1 = (w3[0].y * in[t].y + w3[1].y * in[t + 1].y + w3[2].y * in[t + 2].y) * bf2f(mw >> 16);
            *(unsigned*)(ACT + (size_t)(row0 + t) * 4096 + 2048 + c0) = pk2(y0, y1);
        }
    }
    if (SAMPLE) {
        float* o_sc = outp(a) + O_SCSC + ((size_t)l * SB + b) * 2 * 1024 + c0;
        float* o_ss = outp(a) + O_SCSSM + ((size_t)l * SB + b) * 3 * 2048 + 4 * tid;
        {   unsigned w[2]; u32x2 x[3];
#pragma unroll
            for (int rr = 0; rr < 2; ++rr) w[rr] = *(const unsigned*)(CV + (size_t)(row0 + 6 + rr) * 1024 + c0);
#pragma unroll
            for (int rr = 0; rr < 3; ++rr) x[rr] = *(const u32x2*)(XBC + (size_t)(row0 + 5 + rr) * 2048 + 4 * tid);
#pragma unroll
            for (int rr = 0; rr < 2; ++rr) *(f32x2*)(o_sc + rr * 1024) = (f32x2){bf2f(w[rr] & 0xffffu), bf2f(w[rr] >> 16)};
#pragma unroll
            for (int rr = 0; rr < 3; ++rr) *(f32x4*)(o_ss + rr * 2048) = (f32x4){bf2f(x[rr].x & 0xffffu), bf2f(x[rr].x >> 16), bf2f(x[rr].y & 0xffffu), bf2f(x[rr].y >> 16)}; }
    } else if ((item & 127) == 127) {
        const int rb = b * PSEQ;
        float* o_cf = outp(a) + O_PCCF + ((size_t)l * PB + b) * 30 * 1024 + c0;
        {   unsigned w[30];
#pragma unroll
            for (int rr = 0; rr < 30; ++rr) w[rr] = *(const unsigned*)(U + (size_t)(rb + 2018 + rr) * 1024 + c0);
#pragma unroll
            for (int rr = 0; rr < 30; ++rr) *(f32x2*)(o_cf + (size_t)rr * 1024) = (f32x2){bf2f(w[rr] & 0xffffu), bf2f(w[rr] >> 16)}; }
        float* o_sc = outp(a) + O_PCSC + ((size_t)l * PB + b) * 2 * 1024 + c0;
        float* o_ss = outp(a) + O_PCSSM + ((size_t)l * PB + b) * 3 * 2048 + 4 * tid;
        {   unsigned w[2]; u32x2 x[3];
#pragma unroll
            for (int rr = 0; rr < 2; ++rr) w[rr] = *(const unsigned*)(CV + (size_t)(rb + 2046 + rr) * 1024 + c0);
#pragma unroll
            for (int rr = 0; rr < 3; ++rr) x[rr] = *(const u32x2*)(XBC + (size_t)(rb + 2045 + rr) * 2048 + 4 * tid);
#pragma unroll
            for (int rr = 0; rr < 2; ++rr) *(f32x2*)(o_sc + rr * 1024) = (f32x2){bf2f(w[rr] & 0xffffu), bf2f(w[rr] >> 16)};
#pragma unroll
            for (int rr = 0; rr < 3; ++rr) *(f32x4*)(o_ss + rr * 2048) = (f32x4){bf2f(x[rr].x & 0xffffu), bf2f(x[rr].x >> 16), bf2f(x[rr].y & 0xffffu), bf2f(x[rr].y >> 16)}; }
        const bf16* KV = (const bf16*)(wsp(a) + WS_KV);
        {   u32x4 w[16];
#pragma unroll
            for (int i = 0; i < 16; ++i) { const int id = tid + 512 * i, jj = id >> 6, c8 = (id & 63) * 8; w[i] = *(const u32x4*)(KV + (size_t)(rb + 1920 + jj) * 512 + c8); }
#pragma unroll
            for (int i = 0; i < 16; ++i) { const int id = tid + 512 * i, jj = id >> 6, c8 = (id & 63) * 8;
                float* o = outp(a) + (c8 < 256 ? O_PK : O_PV) + (((size_t)l * PB + b) * 128 + jj) * 256 + (c8 & 255);
                *(f32x4*)o = (f32x4){bf2f(w[i].x & 0xffffu), bf2f(w[i].x >> 16), bf2f(w[i].y & 0xffffu), bf2f(w[i].y >> 16)};
                *(f32x4*)(o + 4) = (f32x4){bf2f(w[i].z & 0xffffu), bf2f(w[i].z >> 16), bf2f(w[i].w & 0xffffu), bf2f(w[i].w >> 16)}; } }
    }
}

__device__ __forceinline__ float incl_scan64(float v, int lane) {
    v += dpp_f<0x111>(v); v += dpp_f<0x112>(v); v += dpp_f<0x114>(v); v += dpp_f<0x118>(v);
    const float t0 = rl_f(v, 15), t1 = rl_f(v, 31), t2 = rl_f(v, 47); const int row = lane >> 4;
    return v + (row == 0 ? 0.f : (row == 1 ? t0 : (row == 2 ? t0 + t1 : t0 + t1 + t2)));
}
template <int MODE>
__device__ __forceinline__ void ssd_cs(const Args& a, int l, int g, int r0, LAS float* csb, LAS float* dtb, LAS float* auxb, float* cdec, int wave, int lane) {
    if (wave < 4) {
        const int h = 4 * g + wave; const float A = -__expf(inp(a, I_ALOG)[l * HEADS + h]);
        const float* DT = (const float*)(wsp(a) + WS_DT);
        const float d0 = DT[(size_t)(r0 + lane) * 16 + h], d1 = DT[(size_t)(r0 + 64 + lane) * 16 + h];
        const float s0 = incl_scan64(d0 * A, lane); const float tot0 = __shfl(s0, 63);
        const float s1 = incl_scan64(d1 * A, lane) + tot0; const float last = __shfl(s1, 63);
        csb[wave * 128 + lane] = s0; csb[wave * 128 + 64 + lane] = s1; dtb[wave * 128 + lane] = d0; dtb[wave * 128 + 64 + lane] = d1;
        if (MODE == 0) { auxb[wave * 128 + lane] = d0 * __expf(last - s0); auxb[wave * 128 + 64 + lane] = d1 * __expf(last - s1); if (lane == 0) cdec[h] = __expf(last); }
        else { auxb[wave * 128 + lane] = __expf(s0); auxb[wave * 128 + 64 + lane] = __expf(s1); }
    }
}
struct ConvIn { u32x2 raw[11]; f32x4 w[4]; f32x4 bias; };
__device__ __forceinline__ void xbc_conv_load(const Args& a, int l, int r0, bool first_chunk, int l0, int col, ConvIn& ci) {
    const bf16* XBC = (const bf16*)(wsp(a) + WS_XBC);
#pragma unroll
    for (int rr = 0; rr < 11; ++rr) { const int tok = l0 - 3 + rr; const int tk = (first_chunk && tok < 0) ? 0 : tok; ci.raw[rr] = *(const u32x2*)(XBC + (size_t)(r0 + tk) * XBC_W + col); }
#pragma unroll
    for (int k = 0; k < 4; ++k) ci.w[k] = *(const f32x4*)(inp(a, I_SCONVW) + (size_t)l * 4 * XBC_W + k * XBC_W + col);
    ci.bias = *(const f32x4*)(inp(a, I_SCONVB) + l * XBC_W + col);
}
__device__ __forceinline__ void xbc_conv_compute(const ConvIn& ci, bool first_chunk, int l0, float (&o)[8][4]) {
    float in[11][4];
#pragma unroll
    for (int rr = 0; rr < 11; ++rr) { const bool z = first_chunk && (l0 - 3 + rr < 0); const u32x2 v = ci.raw[rr];
        in[rr][0] = z ? 0.f : bf2f(v.x & 0xffffu); in[rr][1] = z ? 0.f : bf2f(v.x >> 16); in[rr][2] = z ? 0.f : bf2f(v.y & 0xffffu); in[rr][3] = z ? 0.f : bf2f(v.y >> 16); }
#pragma unroll
    for (int i = 0; i < 8; ++i)
#pragma unroll
        for (int j = 0; j < 4; ++j) { float sacc = ci.bias[j];
#pragma unroll
            for (int k = 0; k < 4; ++k) sacc += ci.w[k][j] * in[i + k][j];
            o[i][j] = fsilu(sacc); }
}
constexpr int LP = 136;

__device__ __forceinline__ void ssd1_item(const Args& a, int l, int item, LAS unsigned char* lds, int tid, int wave, int lane) {
    asm volatile("" : "+v"(tid), "+v"(lane), "+s"(wave), "+s"(item));
    const int b = item >> 6, c = (item >> 2) & 15, g = item & 3; const int r0 = b * PSEQ + c * CHUNK;
    LAS float* csb = (LAS float*)lds; LAS float* w1b = csb + 512; LAS float* dtb = csb + 1024;
    LAS bf16* xwT = (LAS bf16*)(lds + 8192); LAS bf16* BT = xwT + 4 * 64 * LP;
    __syncthreads();
    {
        ConvIn c0_, c1_, c2_;
        const int tgA = tid >> 6, qA = tid & 63, tgB = (tid + 512) >> 6, qB = (tid + 512) & 63, tgC = tid >> 5, qC = tid & 31;
        xbc_conv_load(a, l, r0, c == 0, 8 * tgA, g * 256 + 4 * qA, c0_);
        xbc_conv_load(a, l, r0, c == 0, 8 * tgB, g * 256 + 4 * qB, c1_);
        xbc_conv_load(a, l, r0, c == 0, 8 * tgC, 1024 + g * 128 + 4 * qC, c2_);
        ssd_cs<0>(a, l, g, r0, csb, dtb, w1b, (float*)(wsp(a) + WS_CDEC) + (b * NCH + c) * HEADS, wave, lane);
        __syncthreads();
#pragma unroll
        for (int ti = 0; ti < 2; ++ti) { float o[8][4]; const int tg = ti ? tgB : tgA, q = ti ? qB : qA, hh = q >> 4, l0 = 8 * tg;
            xbc_conv_compute(ti ? c1_ : c0_, c == 0, l0, o);
#pragma unroll
            for (int j = 0; j < 4; ++j) { float v[8];
#pragma unroll
                for (int i = 0; i < 8; ++i) v[i] = o[i][j] * w1b[hh * 128 + l0 + i];
                u32x4 w; w.x = pk2(v[0], v[1]); w.y = pk2(v[2], v[3]); w.z = pk2(v[4], v[5]); w.w = pk2(v[6], v[7]);
                *(LAS u32x4*)(xwT + (hh * 64 + 4 * (q & 15) + j) * LP + l0) = w; } }
        { float o[8][4]; const int l0 = 8 * tgC;
            xbc_conv_compute(c2_, c == 0, l0, o);
#pragma unroll
            for (int j = 0; j < 4; ++j) { u32x4 w; w.x = pk2(o[0][j], o[1][j]); w.y = pk2(o[2][j], o[3][j]); w.z = pk2(o[4][j], o[5][j]); w.w = pk2(o[6][j], o[7][j]);
                *(LAS u32x4*)(BT + (4 * qC + j) * LP + l0) = w; } }
    }
    __syncthreads();
    {
        const int hh = wave >> 1, ph = wave & 1, fr = lane & 15, fq = lane >> 4;
        f32x4 acc[2][8];
#pragma unroll
        for (int i = 0; i < 2; ++i)
#pragma unroll
            for (int n = 0; n < 8; ++n) acc[i][n] = (f32x4){0.f, 0.f, 0.f, 0.f};
#pragma unroll
        for (int kk = 0; kk < 4; ++kk) {
            bf16x8 af[2];
#pragma unroll
            for (int i = 0; i < 2; ++i) af[i] = *(const LAS bf16x8*)(xwT + (hh * 64 + ph * 32 + i * 16 + fr) * LP + kk * 32 + 8 * fq);
#pragma unroll
            for (int n = 0; n < 8; ++n) { const bf16x8 bfr = *(const LAS bf16x8*)(BT + (n * 16 + fr) * LP + kk * 32 + 8 * fq);
#pragma unroll
                for (int i = 0; i < 2; ++i) acc[i][n] = __builtin_amdgcn_mfma_f32_16x16x32_bf16(af[i], bfr, acc[i][n], 0, 0, 0); }
        }
        float* cst = (float*)(wsp(a) + WS_CST) + ((size_t)((b * NCH + c) * HEADS + 4 * g + hh)) * (HD * NST);
#pragma unroll
        for (int i = 0; i < 2; ++i)
#pragma unroll
            for (int n = 0; n < 8; ++n)
#pragma unroll
                for (int r = 0; r < 4; ++r) cst[(size_t)(ph * 32 + i * 16 + 4 * fq + r) * NST + n * 16 + fr] = acc[i][n][r];
    }
}

__device__ __forceinline__ void ssd_scan_phase(const Args& a, int l, int gthread, int nthreads) {
    const float* CST = (const float*)(wsp(a) + WS_CST); const float* CDEC = (const float*)(wsp(a) + WS_CDEC); bf16* HP = (bf16*)(wsp(a) + WS_HPREV);
    for (int idx = gthread; idx < PB * HEADS * 2048; idx += nthreads) {
        const int b = idx / (HEADS * 2048), h = (idx / 2048) % HEADS, e4 = idx % 2048;
        f32x4 H = (f32x4){0.f, 0.f, 0.f, 0.f};
#pragma unroll 1
        for (int c0 = 0; c0 < NCH; c0 += 8) {
            f32x4 sv[8]; float dv[8];
#pragma unroll
            for (int c = 0; c < 8; ++c) { sv[c] = *(const f32x4*)(CST + ((size_t)((b * NCH + c0 + c) * HEADS + h)) * (HD * NST) + 4 * e4); dv[c] = CDEC[(b * NCH + c0 + c) * HEADS + h]; }
#pragma unroll
            for (int c = 0; c < 8; ++c) { const size_t o = ((size_t)((b * NCH + c0 + c) * HEADS + h)) * (HD * NST) + 4 * e4;
                u32x2 w; w.x = pk2(H.x, H.y); w.y = pk2(H.z, H.w); *(u32x2*)(HP + o) = w;
                H = H * dv[c] + sv[c]; }
        }
        *(f32x4*)(outp(a) + O_PSSM + ((size_t)((l * PB + b) * HEADS + h)) * (HD * NST) + 4 * e4) = H;
    }
}

__device__ __forceinline__ void ssd2_item(const Args& a, int l, int item, LAS unsigned char* lds, int tid, int wave, int lane) {
    asm volatile("" : "+v"(tid), "+v"(lane), "+s"(wave), "+s"(item));
    const int b = item >> 6, c = (item >> 2) & 15, g = item & 3; const int r0 = b * PSEQ + c * CHUNK;
    LAS float* csb = (LAS float*)lds; LAS float* ecs = csb + 512; LAS float* dtb = csb + 1024;
    LAS bf16* Cimg = (LAS bf16*)(lds + 8192); LAS bf16* Bimg = Cimg + 128 * LP; LAS bf16* xT = Bimg + 128 * LP;
    const int fr = lane & 15, fq = lane >> 4;
    __syncthreads();
    {
        const int tgA = tid >> 6, qA = tid & 63, tgB = (tid + 512) >> 6, qB = (tid + 512) & 63, tgC = tid >> 5, qC = tid & 31;
        {   ConvIn c0_, c1_;
            xbc_conv_load(a, l, r0, c == 0, 8 * tgA, g * 256 + 4 * qA, c0_);
            xbc_conv_load(a, l, r0, c == 0, 8 * tgB, g * 256 + 4 * qB, c1_);
            ssd_cs<1>(a, l, g, r0, csb, dtb, ecs, nullptr, wave, lane);
#pragma unroll
            for (int ti = 0; ti < 2; ++ti) { float o[8][4]; const int tg = ti ? tgB : tgA, q = ti ? qB : qA, hh = q >> 4, l0 = 8 * tg;
                xbc_conv_compute(ti ? c1_ : c0_, c == 0, l0, o);
#pragma unroll
                for (int j = 0; j < 4; ++j) { u32x4 w; w.x = pk2(o[0][j], o[1][j]); w.y = pk2(o[2][j], o[3][j]); w.z = pk2(o[4][j], o[5][j]); w.w = pk2(o[6][j], o[7][j]);
                    *(LAS u32x4*)(xT + (hh * 64 + 4 * (q & 15) + j) * LP + l0) = w; } } }
        {   ConvIn c2_, c3_;
            xbc_conv_load(a, l, r0, c == 0, 8 * tgC, 1024 + g * 128 + 4 * qC, c2_);
            xbc_conv_load(a, l, r0, c == 0, 8 * tgC, 1536 + g * 128 + 4 * qC, c3_);
#pragma unroll
            for (int ti = 0; ti < 2; ++ti) { float o[8][4]; const int l0 = 8 * tgC; LAS bf16* img = ti == 0 ? Bimg : Cimg;
                xbc_conv_compute(ti ? c3_ : c2_, c == 0, l0, o);
#pragma unroll
                for (int i = 0; i < 8; ++i) { u32x2 w; w.x = pk2(o[i][0], o[i][1]); w.y = pk2(o[i][2], o[i][3]); *(LAS u32x2*)(img + (l0 + i) * LP + 4 * qC) = w; } } }
    }
    __syncthreads();
    bf16x8 cf[4];
#pragma unroll
    for (int kk = 0; kk < 4; ++kk) cf[kk] = *(const LAS bf16x8*)(Cimg + (16 * wave + fr) * LP + kk * 32 + 8 * fq);
    f32x4 cb[8];
#pragma unroll
    for (int st = 0; st < 8; ++st) { cb[st] = (f32x4){0.f, 0.f, 0.f, 0.f};
        if (st <= wave) {
#pragma unroll
            for (int kk = 0; kk < 4; ++kk) { const bf16x8 bfr = *(const LAS bf16x8*)(Bimg + (st * 16 + fr) * LP + kk * 32 + 8 * fq);
                cb[st] = __builtin_amdgcn_mfma_f32_16x16x32_bf16(cf[kk], bfr, cb[st], 0, 0, 0); } } }
    __syncthreads();
    LAS bf16* Mst = Bimg + wave * 16 * LP;
    const bf16* Zb = (const bf16*)(wsp(a) + WS_Z); bf16* ACT = (bf16*)(wsp(a) + WS_ACT);
    float ssq[4] = {0.f, 0.f, 0.f, 0.f};
#pragma unroll 1
    for (int hh = 0; hh < 4; ++hh) {
        const int h = 4 * g + hh;
        float csl[4];
#pragma unroll
        for (int r = 0; r < 4; ++r) csl[r] = csb[hh * 128 + 16 * wave + 4 * fq + r];
        const bf16* hp = (const bf16*)(wsp(a) + WS_HPREV) + ((size_t)((b * NCH + c) * HEADS + h)) * (HD * NST);
        bf16x8 hf[4][4]; u32x4 zw[2];
#pragma unroll
        for (int pt = 0; pt < 4; ++pt)
#pragma unroll
            for (int kk = 0; kk < 4; ++kk) hf[pt][kk] = *(const bf16x8*)(hp + (size_t)(pt * 16 + fr) * NST + kk * 32 + 8 * fq);
        {   const bf16* zp = Zb + (size_t)(r0 + 16 * wave + (lane >> 2)) * 1024 + h * 64 + 16 * (lane & 3);
            zw[0] = *(const u32x4*)zp; zw[1] = *(const u32x4*)(zp + 8); }
#pragma unroll
        for (int st = 0; st < 8; ++st) if (st <= (wave | 1)) {
            const int s = st * 16 + fr; const float css = csb[hh * 128 + s], dts = dtb[hh * 128 + s];
#pragma unroll
            for (int r = 0; r < 4; ++r) { const int lr = 16 * wave + 4 * fq + r; const float v = (s <= lr) ? cb[st][r] * __expf(csl[r] - css) * dts : 0.f;
                Mst[(4 * fq + r) * LP + s] = (bf16)f2bf(v); } }
        asm volatile("s_waitcnt lgkmcnt(0)" ::: "memory");
        f32x4 y[4];
#pragma unroll
        for (int pt = 0; pt < 4; ++pt) { y[pt] = (f32x4){0.f, 0.f, 0.f, 0.f};
#pragma unroll
            for (int kk = 0; kk < 4; ++kk) y[pt] = __builtin_amdgcn_mfma_f32_16x16x32_bf16(cf[kk], hf[pt][kk], y[pt], 0, 0, 0); }
#pragma unroll
        for (int r = 0; r < 4; ++r) { const float e = ecs[hh * 128 + 16 * wave + 4 * fq + r];
#pragma unroll
            for (int pt = 0; pt < 4; ++pt) y[pt][r] *= e; }
#pragma unroll
        for (int kk = 0; kk < 4; ++kk) if (kk <= (wave >> 1)) {
            const bf16x8 mf = *(const LAS bf16x8*)(Mst + fr * LP + kk * 32 + 8 * fq);
#pragma unroll
            for (int pt = 0; pt < 4; ++pt) { const bf16x8 xf = *(const LAS bf16x8*)(xT + (hh * 64 + pt * 16 + fr) * LP + kk * 32 + 8 * fq);
                y[pt] = __builtin_amdgcn_mfma_f32_16x16x32_bf16(mf, xf, y[pt], 0, 0, 0); } }
        asm volatile("s_waitcnt lgkmcnt(0)" ::: "memory");
        const float Dh = inp(a, I_DSKIP)[l * HEADS + h];
        LAS float* Ost = (LAS float*)Mst;
#pragma unroll
        for (int pt = 0; pt < 4; ++pt) { const int p = pt * 16 + fr;
            const u32x2 xw = *(const LAS u32x2*)(xT + (hh * 64 + p) * LP + 16 * wave + 4 * fq);
            const float xv[4] = {bf2f(xw.x & 0xffffu), bf2f(xw.x >> 16), bf2f(xw.y & 0xffffu), bf2f(xw.y >> 16)};
#pragma unroll
            for (int r = 0; r < 4; ++r) Ost[(4 * fq + r) * 68 + p] = y[pt][r] + Dh * xv[r]; }
        asm volatile("s_waitcnt lgkmcnt(0)" ::: "memory");
        {   const int lr = lane >> 2, ch = lane & 3; const size_t row = (size_t)(r0 + 16 * wave + lr);
            float v[16];
#pragma unroll
            for (int q4 = 0; q4 < 4; ++q4) { const f32x4 t4 = *(const LAS f32x4*)(Ost + lr * 68 + 16 * ch + 4 * q4); v[4 * q4] = t4.x; v[4 * q4 + 1] = t4.y; v[4 * q4 + 2] = t4.z; v[4 * q4 + 3] = t4.w; }
            const unsigned zz[8] = {zw[0].x, zw[0].y, zw[0].z, zw[0].w, zw[1].x, zw[1].y, zw[1].z, zw[1].w};
#pragma unroll
            for (int e = 0; e < 8; ++e) { v[2 * e] *= bf2f(zz[e] & 0xffffu); v[2 * e + 1] *= bf2f(zz[e] >> 16); ssq[0] += v[2 * e] * v[2 * e] + v[2 * e + 1] * v[2 * e + 1]; }
            u32x4 o0, o1; o0.x = pk2(v[0], v[1]); o0.y = pk2(v[2], v[3]); o0.z = pk2(v[4], v[5]); o0.w = pk2(v[6], v[7]); o1.x = pk2(v[8], v[9]); o1.y = pk2(v[10], v[11]); o1.z = pk2(v[12], v[13]); o1.w = pk2(v[14], v[15]);
            bf16* op = ACT + row * 4096 + h * 64 + 16 * ch; *(u32x4*)op = o0; *(u32x4*)(op + 8) = o1; }
        asm volatile("s_waitcnt lgkmcnt(0)" ::: "memory");
    }
    {   float s_ = ssq[0]; s_ += dpp_f<0xB1>(s_); s_ += dpp_f<0x4E>(s_);
        if ((lane & 3) == 0) atomicAdd((u64*)(wsp(a) + WS_SSQA) + (size_t)l * TT + r0 + 16 * wave + (lane >> 2), ssq_fix(s_)); }
}

__device__ __forceinline__ void ssds_item(const Args& a, int l, int item, LAS unsigned char* lds, int tid, int wave, int lane) {
    asm volatile("" : "+v"(tid), "+v"(lane), "+s"(wave), "+s"(item));
    const int b = item >> 2, g = item & 3; const int row0 = TP + 8 * b;
    LAS float* xs = (LAS float*)lds; LAS float* Bs = xs + 8 * 256; LAS float* Cs = Bs + 1024; LAS float* dtv = Cs + 1024; LAS float* dA = dtv + 32;
    const bf16* XBC = (const bf16*)(wsp(a) + WS_XBC);
    const int p = tid >> 3, nq = tid & 7;
    f32x4 hv[4][4];
#pragma unroll
    for (int hh = 0; hh < 4; ++hh) { const float* sp = inp(a, I_SSM) + ((size_t)((l * SB + b) * HEADS + 4 * g + hh)) * (HD * NST) + (size_t)p * NST;
#pragma unroll
        for (int j = 0; j < 4; ++j) hv[hh][j] = *(const f32x4*)(sp + (8 * j + nq) * 4); }
    unsigned short zq[4]; float dq[4];
#pragma unroll
    for (int hh = 0; hh < 4; ++hh) { zq[hh] = ((const bf16*)(wsp(a) + WS_Z))[(size_t)(row0 + nq) * 1024 + (4 * g + hh) * 64 + p]; dq[hh] = inp(a, I_DSKIP)[l * HEADS + 4 * g + hh]; }
    __syncthreads();
    {
        const int ch = tid < 256 ? g * 256 + tid : (tid < 384 ? 1024 + g * 128 + (tid - 256) : 1536 + g * 128 + (tid - 384));
        float w[4], in[11];
#pragma unroll
        for (int k = 0; k < 4; ++k) w[k] = inp(a, I_SCONVW)[(size_t)l * 4 * XBC_W + k * XBC_W + ch];
        const float bias = inp(a, I_SCONVB)[l * XBC_W + ch];
#pragma unroll
        for (int rr = 0; rr < 3; ++rr) in[rr] = inp(a, I_CSSM)[(((size_t)l * SB + b) * 3 + rr) * XBC_W + ch];
#pragma unroll
        for (int rr = 0; rr < 8; ++rr) in[3 + rr] = bf2f(XBC[(size_t)(row0 + rr) * XBC_W + ch]);
        float dval = 0.f, aval = 0.f;
        if (tid < 32) { dval = ((const float*)(wsp(a) + WS_DT))[(size_t)(row0 + (tid & 7)) * 16 + 4 * g + (tid >> 3)]; aval = -__expf(inp(a, I_ALOG)[l * HEADS + 4 * g + (tid >> 3)]); }
#pragma unroll
        for (int t = 0; t < 8; ++t) { const float v = fsilu(bias + w[0] * in[t] + w[1] * in[t + 1] + w[2] * in[t + 2] + w[3] * in[t + 3]);
            if (tid < 256) xs[t * 256 + tid] = v; else if (tid < 384) Bs[t * 128 + tid - 256] = v; else Cs[t * 128 + tid - 384] = v; }
        if (tid < 32) { dtv[tid] = dval; dA[tid] = __expf(aval * dval); }
    }
    __syncthreads();
    bf16* ACT = (bf16*)(wsp(a) + WS_ACT);
    const size_t row = (size_t)(row0 + nq);
    float ssq = 0.f;
#pragma unroll
    for (int hh = 0; hh < 4; ++hh) {
        const int h = 4 * g + hh;
        float hr[16];
#pragma unroll
        for (int j = 0; j < 4; ++j) { hr[4 * j] = hv[hh][j].x; hr[4 * j + 1] = hv[hh][j].y; hr[4 * j + 2] = hv[hh][j].z; hr[4 * j + 3] = hv[hh][j].w; }
        float yk = 0.f;
#pragma unroll 1
        for (int t = 0; t < 8; ++t) {
            const float xv = dtv[hh * 8 + t] * xs[t * 256 + hh * 64 + p], da = dA[hh * 8 + t]; float part = 0.f;
#pragma unroll
            for (int j4 = 0; j4 < 4; ++j4) { const f32x4 bv = *(const LAS f32x4*)(Bs + t * 128 + (8 * j4 + nq) * 4), cv = *(const LAS f32x4*)(Cs + t * 128 + (8 * j4 + nq) * 4);
#pragma unroll
                for (int e = 0; e < 4; ++e) { hr[4 * j4 + e] = hr[4 * j4 + e] * da + xv * bv[e]; part += cv[e] * hr[4 * j4 + e]; } }
            part = red8_sum(part);
            yk = (nq == t) ? part : yk;
        }
        float* so = outp(a) + O_SSSM + ((size_t)((l * SB + b) * HEADS + h)) * (HD * NST) + (size_t)p * NST;
#pragma unroll
        for (int j = 0; j < 4; ++j) __builtin_nontemporal_store((f32x4){hr[4 * j], hr[4 * j + 1], hr[4 * j + 2], hr[4 * j + 3]}, (f32x4*)(so + (8 * j + nq) * 4));
        const float v = (yk + dq[hh] * xs[nq * 256 + hh * 64 + p]) * bf2f(zq[hh]);
        ACT[row * 4096 + h * 64 + p] = (bf16)f2bf(v);
        ssq += v * v;
    }
    ssq += dpp_f<0x128>(ssq); ssq += xor16_f(ssq); ssq += xor32_f(ssq);
    if ((lane >> 3) == 0) atomicAdd((u64*)(wsp(a) + WS_SSQA) + (size_t)l * TT + row, ssq_fix(ssq));
}

struct SsdsIn { f32x4 hv[4][4]; unsigned short zq[4]; float dq[4]; float w[4], pre[3], bias, dval, alog; unsigned short raw[8]; };
__device__ __forceinline__ void ssds_load(const Args& a, int l, int item, int tid, SsdsIn& S) {
    const int b = item >> 2, g = item & 3, row0 = TP + 8 * b, p = tid >> 3, nq = tid & 7;
    const bf16* XBC = (const bf16*)(wsp(a) + WS_XBC);
#pragma unroll
    for (int hh = 0; hh < 4; ++hh) { const float* sp = inp(a, I_SSM) + ((size_t)((l * SB + b) * HEADS + 4 * g + hh)) * (HD * NST) + (size_t)p * NST;
#pragma unroll
        for (int j = 0; j < 4; ++j) S.hv[hh][j] = __builtin_nontemporal_load((const f32x4*)(sp + (8 * j + nq) * 4)); }
#pragma unroll
    for (int hh = 0; hh < 4; ++hh) { S.zq[hh] = ((const bf16*)(wsp(a) + WS_Z))[(size_t)(row0 + nq) * 1024 + (4 * g + hh) * 64 + p]; S.dq[hh] = inp(a, I_DSKIP)[l * HEADS + 4 * g + hh]; }
    const int ch = tid < 256 ? g * 256 + tid : (tid < 384 ? 1024 + g * 128 + (tid - 256) : 1536 + g * 128 + (tid - 384));
#pragma unroll
    for (int k = 0; k < 4; ++k) S.w[k] = inp(a, I_SCONVW)[(size_t)l * 4 * XBC_W + k * XBC_W + ch];
    S.bias = inp(a, I_SCONVB)[l * XBC_W + ch];
#pragma unroll
    for (int rr = 0; rr < 3; ++rr) S.pre[rr] = inp(a, I_CSSM)[(((size_t)l * SB + b) * 3 + rr) * XBC_W + ch];
#pragma unroll
    for (int rr = 0; rr < 8; ++rr) S.raw[rr] = XBC[(size_t)(row0 + rr) * XBC_W + ch];
    S.dval = 0.f; S.alog = 0.f;
    if (tid < 32) { S.dval = ((const float*)(wsp(a) + WS_DT))[(size_t)(row0 + (tid & 7)) * 16 + 4 * g + (tid >> 3)]; S.alog = inp(a, I_ALOG)[l * HEADS + 4 * g + (tid >> 3)]; }
}
__device__ __forceinline__ void ssds_conv(const SsdsIn& S, LAS unsigned char* lds, int tid) {
    LAS float* xs = (LAS float*)lds; LAS float* Bs = xs + 8 * 256; LAS float* Cs = Bs + 1024; LAS float* dtv = Cs + 1024; LAS float* dA = dtv + 32;
    float in[11];
#pragma unroll
    for (int rr = 0; rr < 3; ++rr) in[rr] = S.pre[rr];
#pragma unroll
    for (int rr = 0; rr < 8; ++rr) in[3 + rr] = bf2f(S.raw[rr]);
#pragma unroll
    for (int t = 0; t < 8; ++t) { const float v = fsilu(S.bias + S.w[0] * in[t] + S.w[1] * in[t + 1] + S.w[2] * in[t + 2] + S.w[3] * in[t + 3]);
        if (tid < 256) xs[t * 256 + tid] = v; else if (tid < 384) Bs[t * 128 + tid - 256] = v; else Cs[t * 128 + tid - 384] = v; }
    if (tid < 32) { dtv[tid] = S.dval; dA[tid] = __expf(-__expf(S.alog) * S.dval); }
}
__device__ __forceinline__ void ssds_rec(const Args& a, int l, int item, const SsdsIn& S, LAS unsigned char* lds, int tid, int lane) {
    const int b = item >> 2, g = item & 3, row0 = TP + 8 * b, p = tid >> 3, nq = tid & 7;
    LAS float* xs = (LAS float*)lds; LAS float* Bs = xs + 8 * 256; LAS float* Cs = Bs + 1024; LAS float* dtv = Cs + 1024; LAS float* dA = dtv + 32;
    bf16* ACT = (bf16*)(wsp(a) + WS_ACT);
    const size_t row = (size_t)(row0 + nq);
    float ssq = 0.f;
#pragma unroll
    for (int hh = 0; hh < 4; ++hh) {
        const int h = 4 * g + hh;
        float hr[16];
#pragma unroll
        for (int j = 0; j < 4; ++j) { hr[4 * j] = S.hv[hh][j].x; hr[4 * j + 1] = S.hv[hh][j].y; hr[4 * j + 2] = S.hv[hh][j].z; hr[4 * j + 3] = S.hv[hh][j].w; }
        float yk = 0.f;
#pragma unroll 1
        for (int t = 0; t < 8; ++t) {
            const float xv = dtv[hh * 8 + t] * xs[t * 256 + hh * 64 + p], da = dA[hh * 8 + t]; float part = 0.f;
#pragma unroll
            for (int j4 = 0; j4 < 4; ++j4) { const f32x4 bv = *(const LAS f32x4*)(Bs + t * 128 + (8 * j4 + nq) * 4), cv = *(const LAS f32x4*)(Cs + t * 128 + (8 * j4 + nq) * 4);
#pragma unroll
                for (int e = 0; e < 4; ++e) { hr[4 * j4 + e] = hr[4 * j4 + e] * da + xv * bv[e]; part += cv[e] * hr[4 * j4 + e]; } }
            part = red8_sum(part);
            yk = (nq == t) ? part : yk;
        }
        float* so = outp(a) + O_SSSM + ((size_t)((l * SB + b) * HEADS + h)) * (HD * NST) + (size_t)p * NST;
#pragma unroll
        for (int j = 0; j < 4; ++j) __builtin_nontemporal_store((f32x4){hr[4 * j], hr[4 * j + 1], hr[4 * j + 2], hr[4 * j + 3]}, (f32x4*)(so + (8 * j + nq) * 4));
        const float v = (yk + S.dq[hh] * xs[nq * 256 + hh * 64 + p]) * bf2f(S.zq[hh]);
        ACT[row * 4096 + h * 64 + p] = (bf16)f2bf(v);
        ssq += v * v;
    }
    ssq += dpp_f<0x128>(ssq); ssq += xor16_f(ssq); ssq += xor32_f(ssq);
    if ((lane >> 3) == 0) atomicAdd((u64*)(wsp(a) + WS_SSQA) + (size_t)l * TT + row, ssq_fix(ssq));
}
__device__ __forceinline__ void ssds_pair(const Args& a, int l, int itA, int itB, LAS unsigned char* lds, int tid, int wave, int lane) {
    asm volatile("" : "+v"(tid), "+v"(lane), "+s"(wave), "+s"(itA), "+s"(itB));
    SsdsIn SA, SB;
    __syncthreads();
    ssds_load(a, l, itA, tid, SA);
    ssds_conv(SA, lds, tid);
    __syncthreads();
    ssds_load(a, l, itB, tid, SB);
    ssds_rec(a, l, itA, SA, lds, tid, lane);
    __syncthreads();
    ssds_conv(SB, lds, tid);
    __syncthreads();
    ssds_rec(a, l, itB, SB, lds, tid, lane);
}

constexpr int KP = 72, VP = 264;
__device__ __forceinline__ void attn_item(const Args& a, int l, int item, LAS unsigned char* lds, int tid, int wave, int lane) {
    asm volatile("" : "+v"(tid), "+v"(lane), "+s"(wave), "+s"(item));
    const int b = item >> 6, qb = (item >> 2) & 15, g = item & 3; const int r0 = b * PSEQ + qb * 128;
    LAS bf16* Kimg = (LAS bf16*)lds; LAS bf16* VT = Kimg + 256 * KP;
    const bf16* KV = (const bf16*)(wsp(a) + WS_KV); const bf16* Qb = (const bf16*)(wsp(a) + WS_Q); const bf16* AG = (const bf16*)(wsp(a) + WS_AG); bf16* ACT = (bf16*)(wsp(a) + WS_ACT);
    const int fr = lane & 15, fq = lane >> 4;
    const int hq = wave >> 1, half = wave & 1, h = 4 * g + hq;
    bf16x8 qf[4][2];
#pragma unroll
    for (int qt = 0; qt < 4; ++qt)
#pragma unroll
        for (int kk = 0; kk < 2; ++kk) qf[qt][kk] = *(const bf16x8*)(Qb + (size_t)(r0 + 64 * half + 16 * qt + fr) * 1024 + h * 64 + kk * 32 + 8 * fq);
    __syncthreads();
#pragma unroll
    for (int i = 0; i < 4; ++i) { const int id = tid + 512 * i, j = id >> 3, ch = id & 7; const int t = qb * 128 - 128 + j;
        u32x4 kw = (u32x4){0u, 0u, 0u, 0u}, vw = (u32x4){0u, 0u, 0u, 0u};
        if (t >= 0) { const bf16* rp = KV + (size_t)(b * PSEQ + t) * 512 + g * 64 + 8 * ch; kw = *(const u32x4*)rp; vw = *(const u32x4*)(rp + 256); }
        *(LAS u32x4*)(Kimg + j * KP + 8 * ch) = kw;
        const int slot = (j & ~31) + 8 * ((j & 15) >> 2) + 4 * ((j >> 4) & 1) + (j & 3);
        const unsigned vv[4] = {vw.x, vw.y, vw.z, vw.w};
#pragma unroll
        for (int e = 0; e < 8; ++e) VT[(8 * ch + e) * VP + slot] = (bf16)((vv[e >> 1] >> (16 * (e & 1))) & 0xffffu); }
    __syncthreads();

    const float L2E = 1.4426950408889634f, SC = 0.125f * L2E;
    float m[4], lsum[4]; f32x4 o[4][4];
    const float sinkv = inp(a, I_SINK)[l * HEADS + h] * L2E;
#pragma unroll
    for (int qt = 0; qt < 4; ++qt) { m[qt] = sinkv; lsum[qt] = (fq == 0) ? 1.f : 0.f;
#pragma unroll
        for (int dt = 0; dt < 4; ++dt) o[dt][qt] = (f32x4){0.f, 0.f, 0.f, 0.f}; }
#pragma unroll 1
    for (int kb = 2 * half; kb < 2 * half + 6; ++kb) {
        const int j0 = 32 * kb;
        f32x4 s[2][4];
#pragma unroll
        for (int tk = 0; tk < 2; ++tk) {
            bf16x8 kf[2];
#pragma unroll
            for (int kk = 0; kk < 2; ++kk) kf[kk] = *(const LAS bf16x8*)(Kimg + (j0 + 16 * tk + fr) * KP + kk * 32 + 8 * fq);
#pragma unroll
            for (int qt = 0; qt < 4; ++qt) { s[tk][qt] = (f32x4){0.f, 0.f, 0.f, 0.f};
#pragma unroll
                for (int kk = 0; kk < 2; ++kk) s[tk][qt] = __builtin_amdgcn_mfma_f32_16x16x32_bf16(kf[kk], qf[qt][kk], s[tk][qt], 0, 0, 0); } }
        bf16x8 pf[4];
#pragma unroll
        for (int qt = 0; qt < 4; ++qt) {
            const int qi = 64 * half + 16 * qt + fr; float bm = -INFINITY;
#pragma unroll
            for (int tk = 0; tk < 2; ++tk)
#pragma unroll
                for (int r = 0; r < 4; ++r) { const int j = j0 + 16 * tk + 4 * fq + r; const bool ok = (j > qi) && (j <= qi + 128) && (qb * 128 - 128 + j >= 0);
                    const float v = ok ? s[tk][qt][r] * SC : -INFINITY; s[tk][qt][r] = v; bm = fmaxf(bm, v); }
            bm = fmaxf(bm, xor16_f(bm)); bm = fmaxf(bm, xor32_f(bm));
            const float mn = fmaxf(m[qt], bm), al = __builtin_amdgcn_exp2f(m[qt] - mn); m[qt] = mn;
            float ps = 0.f; float pv[8];
#pragma unroll
            for (int tk = 0; tk < 2; ++tk)
#pragma unroll
                for (int r = 0; r < 4; ++r) { const float p = __builtin_amdgcn_exp2f(s[tk][qt][r] - mn); pv[4 * tk + r] = p; ps += p; }
            lsum[qt] = lsum[qt] * al + ps;
#pragma unroll
            for (int dt = 0; dt < 4; ++dt) o[dt][qt] = o[dt][qt] * al;
            u32x4 w; w.x = pk2(pv[0], pv[1]); w.y = pk2(pv[2], pv[3]); w.z = pk2(pv[4], pv[5]); w.w = pk2(pv[6], pv[7]);
            pf[qt] = __builtin_bit_cast(bf16x8, w);
        }
#pragma unroll
        for (int dt = 0; dt < 4; ++dt) { const bf16x8 vf = *(const LAS bf16x8*)(VT + (dt * 16 + fr) * VP + j0 + 8 * fq);
#pragma unroll
            for (int qt = 0; qt < 4; ++qt) o[dt][qt] = __builtin_amdgcn_mfma_f32_16x16x32_bf16(vf, pf[qt], o[dt][qt], 0, 0, 0); }
    }
    {
        LAS float* Ost = (LAS float*)(lds + 256 * KP * 2 + 64 * VP * 2) + wave * (16 * 68);
        const int oq = lane >> 2, och = lane & 3;
        u32x4 gq[4][2];
#pragma unroll
        for (int qt = 0; qt < 4; ++qt) { const bf16* gp = AG + (size_t)(r0 + 64 * half + 16 * qt + oq) * 1024 + h * 64 + 16 * och; gq[qt][0] = *(const u32x4*)gp; gq[qt][1] = *(const u32x4*)(gp + 8); }
#pragma unroll
        for (int qt = 0; qt < 4; ++qt) { float lt = lsum[qt]; lt += xor16_f(lt); lt += xor32_f(lt); const float inv = 1.f / lt;
#pragma unroll
            for (int dt = 0; dt < 4; ++dt) *(LAS f32x4*)(Ost + fr * 68 + dt * 16 + 4 * fq) = o[dt][qt] * inv;
            asm volatile("s_waitcnt lgkmcnt(0)" ::: "memory");
            float v[16];
#pragma unroll
            for (int k4 = 0; k4 < 4; ++k4) { const f32x4 t4 = *(const LAS f32x4*)(Ost + oq * 68 + 16 * och + 4 * k4); v[4 * k4] = t4.x; v[4 * k4 + 1] = t4.y; v[4 * k4 + 2] = t4.z; v[4 * k4 + 3] = t4.w; }
            asm volatile("s_waitcnt lgkmcnt(0)" ::: "memory");
            const unsigned zz[8] = {gq[qt][0].x, gq[qt][0].y, gq[qt][0].z, gq[qt][0].w, gq[qt][1].x, gq[qt][1].y, gq[qt][1].z, gq[qt][1].w};
            u32x4 o0, o1;
            o0.x = pk2(v[0] * bf2f(zz[0] & 0xffffu), v[1] * bf2f(zz[0] >> 16)); o0.y = pk2(v[2] * bf2f(zz[1] & 0xffffu), v[3] * bf2f(zz[1] >> 16));
            o0.z = pk2(v[4] * bf2f(zz[2] & 0xffffu), v[5] * bf2f(zz[2] >> 16)); o0.w = pk2(v[6] * bf2f(zz[3] & 0xffffu), v[7] * bf2f(zz[3] >> 16));
            o1.x = pk2(v[8] * bf2f(zz[4] & 0xffffu), v[9] * bf2f(zz[4] >> 16)); o1.y = pk2(v[10] * bf2f(zz[5] & 0xffffu), v[11] * bf2f(zz[5] >> 16));
            o1.z = pk2(v[12] * bf2f(zz[6] & 0xffffu), v[13] * bf2f(zz[6] >> 16)); o1.w = pk2(v[14] * bf2f(zz[7] & 0xffffu), v[15] * bf2f(zz[7] >> 16));
            bf16* op = ACT + (size_t)(r0 + 64 * half + 16 * qt + oq) * 4096 + 3072 + h * 64 + 16 * och; *(u32x4*)op = o0; *(u32x4*)(op + 8) = o1; }
    }
}

__device__ __forceinline__ void attns_item(const Args& a, int l, int item, LAS unsigned char* lds, int tid, int wave, int lane) {
    asm volatile("" : "+v"(tid), "+v"(lane), "+s"(wave), "+s"(item));
    const int b = item >> 2, g = item & 3; const int row0 = TP + 8 * b;
    LAS float* Qs = (LAS float*)lds; LAS float* Ks = Qs + 32 * 64; LAS float* Vs = Ks + 136 * 65; LAS float* Sc = Vs + 136 * 64;
    const bf16* KV = (const bf16*)(wsp(a) + WS_KV); const bf16* Qb = (const bf16*)(wsp(a) + WS_Q);
    __syncthreads();
    {
        const int qr = tid >> 4, qd = (tid & 15) * 4;
        const u32x2 qw = *(const u32x2*)(Qb + (size_t)(row0 + (qr & 7)) * 1024 + (4 * g + (qr >> 3)) * 64 + qd);
        f32x4 kc[4], vc[4];
#pragma unroll
        for (int i = 0; i < 4; ++i) { const int id = tid + 512 * i, j = id >> 4, d4 = (id & 15) * 4; const size_t o = (((size_t)l * SB + b) * 128 + j) * 256 + g * 64 + d4;
            kc[i] = *(const f32x4*)(inp(a, I_CK) + o); vc[i] = *(const f32x4*)(inp(a, I_CVV) + o); }
        u32x2 nk = (u32x2){0u, 0u}, nv = (u32x2){0u, 0u};
        if (tid < 128) { const bf16* rp = KV + (size_t)(row0 + (tid >> 4)) * 512 + g * 64 + (tid & 15) * 4; nk = *(const u32x2*)rp; nv = *(const u32x2*)(rp + 256); }
        LAS float* qd_ = Qs + qr * 64 + qd; qd_[0] = bf2f(qw.x & 0xffffu); qd_[1] = bf2f(qw.x >> 16); qd_[2] = bf2f(qw.y & 0xffffu); qd_[3] = bf2f(qw.y >> 16);
#pragma unroll
        for (int i = 0; i < 4; ++i) { const int id = tid + 512 * i, j = id >> 4, d4 = (id & 15) * 4; LAS float* kd = Ks + j * 65 + d4; kd[0] = kc[i].x; kd[1] = kc[i].y; kd[2] = kc[i].z; kd[3] = kc[i].w;
            *(LAS f32x4*)(Vs + j * 64 + d4) = vc[i]; }
        if (tid < 128) { const int j = 128 + (tid >> 4), d4 = (tid & 15) * 4; LAS float* kd = Ks + j * 65 + d4;
            kd[0] = bf2f(nk.x & 0xffffu); kd[1] = bf2f(nk.x >> 16); kd[2] = bf2f(nk.y & 0xffffu); kd[3] = bf2f(nk.y >> 16);
            *(LAS f32x4*)(Vs + j * 64 + d4) = (f32x4){bf2f(nv.x & 0xffffu), bf2f(nv.x >> 16), bf2f(nv.y & 0xffffu), bf2f(nv.y >> 16)}; }
    }
    __syncthreads();
    for (int e = tid; e < 32 * 136; e += 512) { const int r = e / 136, j = e - r * 136, qi = r & 7; float s = 0.f;
#pragma unroll 16
        for (int d = 0; d < 64; ++d) s += Qs[r * 64 + d] * Ks[j * 65 + d];
        const bool ok = j < 128 ? (j > qi) : (j - 128 <= qi);
        Sc[r * 140 + j] = ok ? s * 0.125f : -INFINITY; }
    __syncthreads();
#pragma unroll
    for (int rr = 0; rr < 4; ++rr) { const int r = 4 * wave + rr, hq = r >> 3; const float sink = inp(a, I_SINK)[l * HEADS + 4 * g + hq];
        const float s0 = Sc[r * 140 + lane], s1 = Sc[r * 140 + 64 + lane], s2 = lane < 8 ? Sc[r * 140 + 128 + lane] : -INFINITY;
        float mx = wave_max(fmaxf(fmaxf(s0, s1), s2));
        mx = fmaxf(mx, sink);
        const float p0 = __expf(s0 - mx), p1 = __expf(s1 - mx), p2 = lane < 8 ? __expf(s2 - mx) : 0.f;
        const float den = wave_sum(p0 + p1 + p2) + __expf(sink - mx), inv = 1.f / den;
        Sc[r * 140 + lane] = p0 * inv; Sc[r * 140 + 64 + lane] = p1 * inv; if (lane < 8) Sc[r * 140 + 128 + lane] = p2 * inv; }
    __syncthreads();
    {   const int r = tid >> 4, d4 = (tid & 15) * 4, hq = r >> 3, qi = r & 7; f32x4 o = (f32x4){0.f, 0.f, 0.f, 0.f};
        const size_t row = (size_t)(row0 + qi); const int col = (4 * g + hq) * 64 + d4;
        const u32x2 gw = *(const u32x2*)((const bf16*)(wsp(a) + WS_AG) + row * 1024 + col);
#pragma unroll 8
        for (int j = 0; j < 136; ++j) { const float p = Sc[r * 140 + j]; const f32x4 v = *(const LAS f32x4*)(Vs + j * 64 + d4); o = o + v * p; }
        u32x2 w; w.x = pk2(o.x * bf2f(gw.x & 0xffffu), o.y * bf2f(gw.x >> 16)); w.y = pk2(o.z * bf2f(gw.y & 0xffffu), o.w * bf2f(gw.y >> 16));
        *(u32x2*)((bf16*)(wsp(a) + WS_ACT) + row * 4096 + 3072 + col) = w; }
#pragma unroll
    for (int i = 0; i < 4; ++i) { const int id = tid + 512 * i, jj = id >> 4, d4 = (id & 15) * 4; const size_t o = (((size_t)l * SB + b) * 128 + jj) * 256 + g * 64 + d4;
        const LAS float* kd = Ks + (jj + 8) * 65 + d4;
        *(f32x4*)(outp(a) + O_SK + o) = (f32x4){kd[0], kd[1], kd[2], kd[3]}; *(f32x4*)(outp(a) + O_SV + o) = *(const LAS f32x4*)(Vs + (jj + 8) * 64 + d4); }
}

struct AttnsIn { u32x2 qw; f32x4 kc[4], vc[4]; u32x2 nk, nv; };
__device__ __forceinline__ void attns_load(const Args& a, int l, int item, int tid, AttnsIn& S) {
    const int b = item >> 2, g = item & 3, row0 = TP + 8 * b;
    const bf16* KV = (const bf16*)(wsp(a) + WS_KV); const bf16* Qb = (const bf16*)(wsp(a) + WS_Q);
    const int qr = tid >> 4, qd = (tid & 15) * 4;
    S.qw = *(const u32x2*)(Qb + (size_t)(row0 + (qr & 7)) * 1024 + (4 * g + (qr >> 3)) * 64 + qd);
#pragma unroll
    for (int i = 0; i < 4; ++i) { const int id = tid + 512 * i, j = id >> 4, d4 = (id & 15) * 4; const size_t o = (((size_t)l * SB + b) * 128 + j) * 256 + g * 64 + d4;
        S.kc[i] = __builtin_nontemporal_load((const f32x4*)(inp(a, I_CK) + o)); S.vc[i] = __builtin_nontemporal_load((const f32x4*)(inp(a, I_CVV) + o)); }
    S.nk = (u32x2){0u, 0u}; S.nv = (u32x2){0u, 0u};
    if (tid < 128) { const bf16* rp = KV + (size_t)(row0 + (tid >> 4)) * 512 + g * 64 + (tid & 15) * 4; S.nk = *(const u32x2*)rp; S.nv = *(const u32x2*)(rp + 256); }
}
__device__ __forceinline__ void attns_stage(const Args& a, int l, int item, const AttnsIn& S, LAS unsigned char* lds, int tid) {
    const int b = item >> 2, g = item & 3;
    LAS float* Qs = (LAS float*)lds; LAS float* Ks = Qs + 32 * 64; LAS float* Vs = Ks + 136 * 68;
    const int qr = tid >> 4, qd = (tid & 15) * 4;
    *(LAS f32x4*)(Qs + qr * 64 + qd) = (f32x4){bf2f(S.qw.x & 0xffffu), bf2f(S.qw.x >> 16), bf2f(S.qw.y & 0xffffu), bf2f(S.qw.y >> 16)};
#pragma unroll
    for (int i = 0; i < 4; ++i) { const int id = tid + 512 * i, j = id >> 4, d4 = (id & 15) * 4;
        *(LAS f32x4*)(Ks + j * 68 + d4) = S.kc[i]; *(LAS f32x4*)(Vs + j * 64 + d4) = S.vc[i];
        if (j >= 8) { const size_t o = (((size_t)l * SB + b) * 128 + (j - 8)) * 256 + g * 64 + d4; __builtin_nontemporal_store(S.kc[i], (f32x4*)(outp(a) + O_SK + o)); __builtin_nontemporal_store(S.vc[i], (f32x4*)(outp(a) + O_SV + o)); } }
    if (tid < 128) { const int jn = tid >> 4, d4 = (tid & 15) * 4;
        const f32x4 kf = (f32x4){bf2f(S.nk.x & 0xffffu), bf2f(S.nk.x >> 16), bf2f(S.nk.y & 0xffffu), bf2f(S.nk.y >> 16)}, vf = (f32x4){bf2f(S.nv.x & 0xffffu), bf2f(S.nv.x >> 16), bf2f(S.nv.y & 0xffffu), bf2f(S.nv.y >> 16)};
        *(LAS f32x4*)(Ks + (128 + jn) * 68 + d4) = kf; *(LAS f32x4*)(Vs + (128 + jn) * 64 + d4) = vf;
        const size_t o = (((size_t)l * SB + b) * 128 + (120 + jn)) * 256 + g * 64 + d4; *(f32x4*)(outp(a) + O_SK + o) = kf; *(f32x4*)(outp(a) + O_SV + o) = vf; }
}
__device__ __forceinline__ void attns_compute(const Args& a, int l, int item, LAS unsigned char* lds, int tid, int wave, int lane) {
    const int b = item >> 2, g = item & 3, row0 = TP + 8 * b;
    LAS float* Qs = (LAS float*)lds; LAS float* Ks = Qs + 32 * 64; LAS float* Vs = Ks + 136 * 68; LAS float* Sc = Vs + 136 * 64;
    const int r_ = tid >> 4, d4_ = (tid & 15) * 4;
    const u32x2 gw = *(const u32x2*)((const bf16*)(wsp(a) + WS_AG) + (size_t)(row0 + (r_ & 7)) * 1024 + (4 * g + (r_ >> 3)) * 64 + d4_);
    for (int e = tid; e < 32 * 136; e += 512) { const int r = e / 136, j = e - r * 136, qi = r & 7; float sacc = 0.f;
#pragma unroll
        for (int d4 = 0; d4 < 16; ++d4) { const f32x4 qv = *(const LAS f32x4*)(Qs + r * 64 + 4 * d4), kv = *(const LAS f32x4*)(Ks + j * 68 + 4 * d4); sacc += (qv.x * kv.x + qv.y * kv.y) + (qv.z * kv.z + qv.w * kv.w); }
        const bool ok = j < 128 ? (j > qi) : (j - 128 <= qi);
        Sc[r * 140 + j] = ok ? sacc * 0.125f : -INFINITY; }
    __syncthreads();
#pragma unroll
    for (int rr = 0; rr < 4; ++rr) { const int r = 4 * wave + rr, hq = r >> 3; const float sink = inp(a, I_SINK)[l * HEADS + 4 * g + hq];
        const float s0 = Sc[r * 140 + lane], s1 = Sc[r * 140 + 64 + lane], s2 = lane < 8 ? Sc[r * 140 + 128 + lane] : -INFINITY;
        float mx = wave_max(fmaxf(fmaxf(s0, s1), s2));
        mx = fmaxf(mx, sink);
        const float p0 = __expf(s0 - mx), p1 = __expf(s1 - mx), p2 = lane < 8 ? __expf(s2 - mx) : 0.f;
        const float den = wave_sum(p0 + p1 + p2) + __expf(sink - mx), inv = 1.f / den;
        Sc[r * 140 + lane] = p0 * inv; Sc[r * 140 + 64 + lane] = p1 * inv; if (lane < 8) Sc[r * 140 + 128 + lane] = p2 * inv; }
    __syncthreads();
    {   const int hq = r_ >> 3, qi = r_ & 7; f32x4 o = (f32x4){0.f, 0.f, 0.f, 0.f};
#pragma unroll 8
        for (int j = 0; j < 136; ++j) { const float pw = Sc[r_ * 140 + j]; const f32x4 v = *(const LAS f32x4*)(Vs + j * 64 + d4_); o = o + v * pw; }
        u32x2 w; w.x = pk2(o.x * bf2f(gw.x & 0xffffu), o.y * bf2f(gw.x >> 16)); w.y = pk2(o.z * bf2f(gw.y & 0xffffu), o.w * bf2f(gw.y >> 16));
        *(u32x2*)((bf16*)(wsp(a) + WS_ACT) + (size_t)(row0 + qi) * 4096 + 3072 + (4 * g + hq) * 64 + d4_) = w; }
}
__device__ __forceinline__ void attns_pair(const Args& a, int l, int itA, int itB, LAS unsigned char* lds, int tid, int wave, int lane) {
    asm volatile("" : "+v"(tid), "+v"(lane), "+s"(wave), "+s"(itA), "+s"(itB));
    AttnsIn SA, SB;
    __syncthreads();
    attns_load(a, l, itA, tid, SA);
    attns_stage(a, l, itA, SA, lds, tid);
    __syncthreads();
    attns_load(a, l, itB, tid, SB);
    attns_compute(a, l, itA, lds, tid, wave, lane);
    __syncthreads();
    attns_stage(a, l, itB, SB, lds, tid);
    __syncthreads();
    attns_compute(a, l, itB, lds, tid, wave, lane);
}

struct Epi2 {
    static constexpr bool PERM = true, ACCUM = true;
    const bf16* MG; const u64* ssqa; bf16* H;
    __device__ __forceinline__ void after(int, LAS unsigned char*) const {}
    __device__ __forceinline__ void prefetch(const pg8::Unit&, LAS unsigned char*, int) const {}
    __device__ __forceinline__ void operator()(f32x4 (&acc)[2][2][4][2], const pg8::Unit& u, int wr, int wc, int fr, int fq, LAS unsigned char* lds, int slot) const {
        const int ln = fresh_lane(); const int frv = ln & 15, fqv = ln >> 4;
        const int row0 = u.pm * 256 + wr * 64 + frv, colb = u.pn * 256 + wc * 32 + 8 * fqv;
        u32x4 gw[3][2]; float rsa[3];
#define EPI2_LOAD(k, buf) do { const size_t row_ = (size_t)(row0 + ((k) >> 2) * 128 + ((k) & 3) * 16); \
            rsa[buf] = (u.sub == 0) ? ssq_to_rstd(ssqa[row_], 1.0f / 1024.0f, 1e-5f) : 1.0f; \
            _Pragma("unroll") for (int bj = 0; bj < 2; ++bj) gw[buf][bj] = *(const u32x4*)(MG + row_ * 8192 + colb + bj * 128 + u.sub * 2048); } while (0)
        EPI2_LOAD(0, 0); EPI2_LOAD(1, 1);
#pragma unroll
        for (int k = 0; k < 8; ++k) {
            const int ai = k >> 2, m = k & 3, buf = k % 3;
            if (k + 2 < 8) { if ((k + 2) % 3 == 0) EPI2_LOAD(k + 2, 0); else if ((k + 2) % 3 == 1) EPI2_LOAD(k + 2, 1); else EPI2_LOAD(k + 2, 2); }
            asm volatile("" ::: "memory");
            const size_t row = (size_t)(row0 + ai * 128 + m * 16);
#pragma unroll
            for (int bj = 0; bj < 2; ++bj) {
                const u32x4 a4 = gw[buf][bj];
                float g[8] = {bf2f(a4.x & 0xffffu), bf2f(a4.x >> 16), bf2f(a4.y & 0xffffu), bf2f(a4.y >> 16), bf2f(a4.z & 0xffffu), bf2f(a4.z >> 16), bf2f(a4.w & 0xffffu), bf2f(a4.w >> 16)};
#pragma unroll
                for (int j = 0; j < 8; ++j) g[j] *= rsa[buf];
                if (u.sub < 3) {
#pragma unroll
                    for (int j = 0; j < 8; ++j) acc[ai][bj][m][j >> 2][j & 3] *= g[j];
                } else {
                    float v[8];
#pragma unroll
                    for (int j = 0; j < 8; ++j) v[j] = acc[ai][bj][m][j >> 2][j & 3] * g[j];
                    u32x4 w; w.x = pk2(v[0], v[1]); w.y = pk2(v[2], v[3]); w.z = pk2(v[4], v[5]); w.w = pk2(v[6], v[7]);
                    *(u32x4*)(H + row * 2048 + colb + bj * 128) = w; } }
        }
#undef EPI2_LOAD
    }
};
struct Epi3 {
    static constexpr bool PERM = false, ACCUM = false;
    bf16* XB; u64* ssq;
    __device__ __forceinline__ void after(int, LAS unsigned char*) const {}
    __device__ __forceinline__ void prefetch(const pg8::Unit&, LAS unsigned char*, int) const {}
    __device__ __forceinline__ void operator()(f32x4 (&acc)[2][2][4][2], const pg8::Unit& u, int wr, int wc, int fr, int fq, LAS unsigned char* lds, int slot) const {
        { const int ln = fresh_lane(); fr = ln & 15; fq = ln >> 4; }
        const int row0 = u.pm * 256 + wr * 64 + fr, col0 = u.pn * 256 + wc * 32 + 4 * fq;
        u32x2 xo[4][2][2];
#define EPI3_LOAD(k, buf) do { const int row_ = row0 + ((k) >> 2) * 128 + ((k) & 3) * 16; \
            _Pragma("unroll") for (int bj = 0; bj < 2; ++bj) _Pragma("unroll") for (int n = 0; n < 2; ++n) xo[buf][bj][n] = *(const u32x2*)(XB + (size_t)row_ * DM + col0 + bj * 128 + n * 16); } while (0)
        EPI3_LOAD(0, 0); EPI3_LOAD(1, 1); EPI3_LOAD(2, 2); EPI3_LOAD(3, 3);
#pragma unroll
        for (int k = 0; k < 8; ++k) {
            const int ai = k >> 2, m = k & 3, buf = k & 3;
            const int row = row0 + ai * 128 + m * 16; float s = 0.f;
            u32x2 cur[2][2];
#pragma unroll
            for (int bj = 0; bj < 2; ++bj)
#pragma unroll
                for (int n = 0; n < 2; ++n) cur[bj][n] = xo[buf][bj][n];
            asm volatile("" ::: "memory");
            if (k + 4 < 8) { if (buf == 0) EPI3_LOAD(k + 4, 0); else if (buf == 1) EPI3_LOAD(k + 4, 1); else if (buf == 2) EPI3_LOAD(k + 4, 2); else EPI3_LOAD(k + 4, 3); }
#pragma unroll
            for (int bj = 0; bj < 2; ++bj)
#pragma unroll
                for (int n = 0; n < 2; ++n) { const int col = col0 + bj * 128 + n * 16;
                    const u32x2 xw = cur[bj][n];
                    const f32x4 xn = (f32x4){bf2f(xw.x & 0xffffu), bf2f(xw.x >> 16), bf2f(xw.y & 0xffffu), bf2f(xw.y >> 16)} + acc[ai][bj][m][n];
                    u32x2 w; w.x = pk2(xn[0], xn[1]); w.y = pk2(xn[2], xn[3]); *(u32x2*)(XB + (size_t)row * DM + col) = w;
                    s += (xn[0] * xn[0] + xn[1] * xn[1]) + (xn[2] * xn[2] + xn[3] * xn[3]); }
            s += xor16_f(s); s += xor32_f(s);
            if (fq == 0) atomicAdd(ssq + row, ssq_fix(s));
        }
#undef EPI3_LOAD
    }
};


#define XB_TMO      128
#define XB_XCNT(j)  (256  + 64 * (j))
#define XB_XSUB(j)  (1280 + 64 * (j))
#define XB_XGEN(j)  (2304 + 64 * (j))
#define XB_TOP      3328
#define XB_TOPGEN   3392
#define XCD_BAR_WORDS 3456
#define XB_SPIN_CAP (1u << 18)
__device__ __forceinline__ unsigned xb_ld(unsigned* p)              { return __hip_atomic_load(p, __ATOMIC_RELAXED, __HIP_MEMORY_SCOPE_AGENT); }
__device__ __forceinline__ unsigned xb_add(unsigned* p, unsigned v) { return __hip_atomic_fetch_add(p, v, __ATOMIC_RELAXED, __HIP_MEMORY_SCOPE_AGENT); }
__device__ __forceinline__ unsigned xb_xcc_id() { return (unsigned)__builtin_amdgcn_s_getreg((3 << 11) | 20) & 0xFu; }
#define XB_SPIN(cond, bar) do { unsigned _sp = 0; while (cond) { __builtin_amdgcn_s_sleep(1); \
    if ((++_sp & 255u) == 0u) { if (xb_ld(&(bar)[XB_TMO])) break; if (_sp > XB_SPIN_CAP) { atomicAdd(&(bar)[XB_TMO], 1u); break; } } } } while (0)
__device__ __forceinline__ void xcd_barrier_complete(unsigned* bar, unsigned x, unsigned& nloc, unsigned& nx) {
    const unsigned G = gridDim.x * gridDim.y * gridDim.z;
    unsigned sum, cnt, mine, sp = 0u;
    for (;;) {
        sum = 0u; cnt = 0u; mine = 0u;
#pragma unroll
        for (unsigned j = 0; j < 16; ++j) { const unsigned c = xb_ld(&bar[XB_XCNT(j)]); sum += c; cnt += (c > 0u) ? 1u : 0u; mine = (j == x) ? c : mine; }
        if (sum == G) break;
        __builtin_amdgcn_s_sleep(1);
        if ((++sp & 255u) == 0u) { if (xb_ld(&bar[XB_TMO])) break; if (sp > XB_SPIN_CAP) { atomicAdd(&bar[XB_TMO], 1u); break; } }
    }
    nloc = mine > 0u ? mine : 1u; nx = cnt > 0u ? cnt : 1u;
}
__device__ __forceinline__ void xcd_barrier(unsigned* bar, volatile LAS unsigned* st) {
    asm volatile("s_waitcnt vmcnt(0)" ::: "memory");
    __syncthreads();
    if (threadIdx.x == 0) {
        const unsigned x = xb_xcc_id();
        __builtin_amdgcn_s_waitcnt(0);
        unsigned nloc = st[0], nx = st[1];
        if (nloc == 0u) { xcd_barrier_complete(bar, x, nloc, nx); st[0] = nloc; st[1] = nx; }
        const unsigned old = xb_add(&bar[XB_XSUB(x)], 1u);
        const unsigned gen = old / nloc;
        if (old + 1u == (gen + 1u) * nloc) {
            __builtin_amdgcn_fence(__ATOMIC_RELEASE, "agent");
            asm volatile("s_waitcnt vmcnt(0)" ::: "memory");
            const unsigned og = xb_add(&bar[XB_TOP], 1u);
            const unsigned tg = og / nx;
            if (og + 1u == (tg + 1u) * nx) xb_add(&bar[XB_TOPGEN], 1u);
            else XB_SPIN(xb_ld(&bar[XB_TOPGEN]) == tg, bar);
            __builtin_amdgcn_fence(__ATOMIC_ACQUIRE, "agent");
            xb_add(&bar[XB_XGEN(x)], 1u);
            asm volatile("s_waitcnt vmcnt(0)" ::: "memory");
        } else {
            XB_SPIN(xb_ld(&bar[XB_XGEN(x)]) == gen, bar);
            __builtin_amdgcn_fence(__ATOMIC_ACQUIRE, "agent");
            asm volatile("s_waitcnt vmcnt(0)" ::: "memory");
        }
    }
    __syncthreads();
}

#define HO_WORDS(l) (8192 + 2048 * (l))
__device__ __forceinline__ void handoff_arrive(unsigned* ho, volatile LAS unsigned* st) {
    asm volatile("s_waitcnt vmcnt(0)" ::: "memory");
    __syncthreads();
    if (threadIdx.x == 0) {
        const unsigned x = xb_xcc_id(), nloc = st[0];
        const unsigned old = xb_add(&ho[64 * x], 1u);
        if (old + 1u == nloc) { __builtin_amdgcn_fence(__ATOMIC_RELEASE, "agent"); asm volatile("s_waitcnt vmcnt(0)" ::: "memory"); (void)xb_add(&ho[1024], 1u); }
    }
}
__device__ __forceinline__ void handoff_wait(unsigned* ho, unsigned* bar, volatile LAS unsigned* st) {
    if (threadIdx.x == 0) {
        const unsigned nx = st[1];
        XB_SPIN(xb_ld(&ho[1024]) != nx, bar);
        __builtin_amdgcn_fence(__ATOMIC_ACQUIRE, "agent");
        asm volatile("s_waitcnt vmcnt(0)" ::: "memory");
    }
    __syncthreads();
}

__global__ void __launch_bounds__(512, 2) mk_fwd(Args a) {
    extern __shared__ __attribute__((aligned(16))) unsigned char lds_raw[];
    LAS unsigned char* lds = (LAS unsigned char*)lds_raw;
    const int G = gridDim.x, bx = blockIdx.x;
    const int vcu = (G % 8 == 0) ? (bx % 8) * (G / 8) + bx / 8 : bx;
    const int lo = a.ph_lo, hi = a.ph_hi;
    const bool fuse = (G == 256) && (hi - lo > 1);
#define IN(k) (lo <= (k) && (k) < hi)
#define STAMP(idx) do { if (PROBE_TIMING && bx == 0) { u64* tsp = (u64*)(wsp(a) + WS_DBG) + 64 + (idx); const u64 tv = __builtin_amdgcn_s_memrealtime(); if (threadIdx.x == 0) *tsp = tv; } } while (0)
#define SEAM(k) do { if (IN(k) && IN((k) + 1)) xcd_barrier((unsigned*)(wsp(a) + WS_CTL) + 4096, (volatile LAS unsigned*)(lds + LDS_MISC)); STAMP((k) + 1); } while (0)
#define FRESH_IDS int tid = threadIdx.x; asm volatile("" : "+v"(tid)); const int lane = tid & 63; const int wave = __builtin_amdgcn_readfirstlane(tid >> 6); const int gw = vcu * 8 + wave, ngw = G * 8; (void)lane; (void)gw; (void)ngw;
    if (threadIdx.x < 64) ((LAS unsigned*)(lds + LDS_MISC))[threadIdx.x] = 0u;
    __syncthreads();
    if (hi - lo > 1 && threadIdx.x == 0) (void)xb_add((unsigned*)(wsp(a) + WS_CTL) + 4096 + XB_XCNT(xb_xcc_id()), 1u);
    STAMP(0);
    int ph = 0;
    if (IN(ph)) { FRESH_IDS phase_prologue(a, lds, gw, ngw, wave, lane, 0, (G == 256) ? 1 : NL, true); }
    SEAM(ph); ++ph;
#pragma unroll 1
    for (int l = 0; l < NL; ++l) {
        if (IN(ph)) {
            pg8::Gemm g{(const bf16*)(wsp(a) + WS_XB), (const bf16*)(wsp(a) + WS_W1T + l * W1T_L), DM, DM, DM / 64, 0, 0};
            pg8::Order S; S.init(TT / 256, NT1, G, bx, 1); S.pperm = 1;
            unsigned* ho = fuse ? (unsigned*)(wsp(a) + WS_CTL) + HO_WORDS(l) : nullptr;
            Epi1 E{wsp(a), (const u64*)(wsp(a) + WS_SSQ) + (size_t)l * TT, inp(a, I_DTB) + l * 16, ho};
            if (GEMM_MASK & 1) pg8::gemm_phase<Epi1, pg8::Order>(lds, g, S, E);
        }
#pragma unroll 1
        for (int pos = 0; pos < 2; ++pos) {
            if (pos == 1) { SEAM(ph); ++ph; }
            constexpr int NFULL = (TT / 256) * NT1 - 11 * 256;
            if (fuse ? (pos == 0 && bx >= NFULL) : (pos == 1 && IN(ph))) {
                FRESH_IDS (void)gw; (void)ngw;
                if (fuse) handoff_wait((unsigned*)(wsp(a) + WS_CTL) + HO_WORDS(l), (unsigned*)(wsp(a) + WS_CTL) + 4096, (volatile LAS unsigned*)(lds + LDS_MISC));
                const int it0 = fuse ? bx - NFULL : bx, its = fuse ? 256 - NFULL : G;
#pragma unroll 1
                for (int it = it0; it < 256; it += its) { if (ITEM_MASK & 1) ssd1_item(a, l, it, lds, tid, wave, lane); }
            }
        }
        if (IN(ph)) {
            FRESH_IDS
            const int NCP = (G == 256) ? 0 : 512;
            const int NAT = (G == 256) ? 0 : 256;
            const int N0 = 256, N1_ = N0 + NAT, N2 = N1_ + NCP, N3 = N2 + 512, N4 = N3 + 128, N5 = N4 + 512;
#pragma unroll 1
            for (int it = fuse ? N5 : bx; it < N5; it += G) {
                if (it < N0) { }
                else if (it < N1_) { if (ITEM_MASK & 2) attn_item(a, l, it - N0, lds, tid, wave, lane); }
                else if (it < N2) { if (ITEM_MASK & 4) conv_item<false>(a, l, it - N1_, lds, tid, wave, lane); }
                else if (it < N3) { if (G != 256) { if (ITEM_MASK & 8) attns_item(a, l, it - N2, lds, tid, wave, lane); } }
                else if (it < N4) { if (G != 256) { if (ITEM_MASK & 16) conv_item<true>(a, l, it - N3, lds, tid, wave, lane); } }
                else if (G != 256) { if (ITEM_MASK & 32) ssds_item(a, l, it - N4, lds, tid, wave, lane); }
            }
            if (G == 256) { if (ITEM_MASK & 8) attns_pair(a, l, bx, bx + 256, lds, tid, wave, lane); }
            if (G == 256) { if (ITEM_MASK & 32) ssds_pair(a, l, bx, bx + 256, lds, tid, wave, lane); }
        }
        SEAM(ph); ++ph;
        if (IN(ph)) { FRESH_IDS if (G != 256) ssd_scan_phase(a, l, bx * 512 + tid, G * 512); else if (bx >= 128) ssd_scan_phase(a, l, (bx - 128) * 512 + tid, 128 * 512); }
        if (IN(ph)) { FRESH_IDS
#pragma unroll 1
            for (int it = bx; it < ((G == 256) ? 128 : 0); it += G) { if (ITEM_MASK & 16) conv_item<true>(a, l, it, lds, tid, wave, lane); } }
        SEAM(ph); ++ph;
        if (IN(ph)) {
            if ((vcu & 7) == 0 && G == 256) {
                pg8::Gemm g{(const bf16*)(wsp(a) + WS_ACT), (const bf16*)(wsp(a) + WS_W2T + l * W2T_L), 4096, 4096, 1024 / 64, 1024, 1024};
                pg8::ListOrder S{256 + (vcu >> 3), 0, 1, 4};
                Epi2 E{(const bf16*)(wsp(a) + WS_MG), (const u64*)(wsp(a) + WS_SSQA) + (size_t)l * TT, (bf16*)(wsp(a) + WS_H)};
                if (GEMM_MASK & 2) pg8::gemm_phase<Epi2, pg8::ListOrder>(lds, g, S, E);
            } else {
                FRESH_IDS
                const int q = (G == 256) ? (vcu >> 3) * 7 + (vcu & 7) - 1 : bx, nq = (G == 256) ? 224 : G;
#pragma unroll 1
                for (int it = q; it < 256; it += nq) { if (ITEM_MASK & 64) ssd2_item(a, l, it, lds, tid, wave, lane); }
                if (G == 256 && q >= 32) {
#pragma unroll 1
                    for (int it = q - 32; it < 512; it += 192) { if (ITEM_MASK & 4) conv_item<false>(a, l, it, lds, tid, wave, lane); }
                }
                if (G == 256) {
                    if (q < 32) { if (ITEM_MASK & 2) { attn_item(a, l, q, lds, tid, wave, lane); attn_item(a, l, q + 32, lds, tid, wave, lane); } }
                    else { if (ITEM_MASK & 2) attn_item(a, l, 64 + (q - 32), lds, tid, wave, lane); }
                }
            }
        }
        SEAM(ph); ++ph;
        if (IN(ph)) {
            pg8::Gemm g{(const bf16*)(wsp(a) + WS_ACT), (const bf16*)(wsp(a) + WS_W2T + l * W2T_L), 4096, 4096, 1024 / 64, 1024, 1024};
            Epi2 E{(const bf16*)(wsp(a) + WS_MG), (const u64*)(wsp(a) + WS_SSQA) + (size_t)l * TT, (bf16*)(wsp(a) + WS_H)};
            if (G == 256) { pg8::ListOrder S{vcu, 0, 1, 4}; if (GEMM_MASK & 2) pg8::gemm_phase<Epi2, pg8::ListOrder>(lds, g, S, E); }
            else { pg8::Order S; S.init(TT / 256, DM / 256, G, bx, 4); if (GEMM_MASK & 2) pg8::gemm_phase<Epi2, pg8::Order>(lds, g, S, E); }
        }
        SEAM(ph); ++ph;
        if (IN(ph)) {
            pg8::Gemm g{(const bf16*)(wsp(a) + WS_H), (const bf16*)(wsp(a) + WS_W3T + l * W3T_L), DM, DM, DM / 64, 0, 0};
            pg8::Order S; S.init(TT / 256, DM / 256, G, bx, 1);
            Epi3 E{(bf16*)(wsp(a) + WS_XB), (u64*)(wsp(a) + WS_SSQ) + (size_t)(l + 1) * TT};
            if (GEMM_MASK & 4) pg8::gemm_phase<Epi3, pg8::Order>(lds, g, S, E);
            if (l == 0 && G == 256 && bx >= 32) {
                FRESH_IDS (void)gw; (void)ngw;
                phase_prologue(a, lds, (bx - 32) * 8 + wave, 224 * 8, wave, lane, 1, 2, false);
            }
        }
        SEAM(ph); ++ph;
    }
    if (IN(ph)) {
        FRESH_IDS
        for (int mrow = gw; mrow < TT; mrow += ngw) {
            const u32x2* x2 = (const u32x2*)((const bf16*)(wsp(a) + WS_XB) + (size_t)mrow * DM) + lane; u32x2 v[8];
#pragma unroll
            for (int j = 0; j < 8; ++j) v[j] = x2[64 * j];
            const float rstd = ssq_to_rstd(((const u64*)(wsp(a) + WS_SSQ))[(size_t)NL * TT + mrow], 1.0f / 2048.0f, 1e-6f);
            f32x4* o4 = (f32x4*)(outp(a) + (size_t)mrow * DM) + lane;
#pragma unroll
            for (int j = 0; j < 8; ++j) { const f32x4 w = *((const f32x4*)inp(a, I_FNW) + lane + 64 * j);
                const f32x4 x = (f32x4){bf2f(v[j].x & 0xffffu), bf2f(v[j].x >> 16), bf2f(v[j].y & 0xffffu), bf2f(v[j].y >> 16)};
                __builtin_nontemporal_store(x * rstd * w, o4 + 64 * j); }
        }
    }
    STAMP(ph + 1);
#undef IN
#undef SEAM
}

#if PROBE_CHECK
constexpr int NSTAGE = 40;
__device__ __forceinline__ unsigned hash32(unsigned x) { x ^= x >> 16; x *= 0x7feb352du; x ^= x >> 15; x *= 0x846ca68bu; x ^= x >> 16; return x; }
__device__ __forceinline__ void rec_err(float* dbg, int stage, float got, float ref, float floor_) {
    float e = fabsf(got - ref) / (fabsf(ref) + floor_); if (!(e == e)) e = 1e30f;
    atomicMax((unsigned*)dbg + stage, __float_as_uint(e));
}
__device__ void rec_err2(float* dbg, int stage, float got, float ref, float scale) {
    float e = fabsf(got - ref) / scale; if (!(e == e)) e = 1e30f; if (e == 0.f) e = 1e-30f;
    atomicMax((unsigned*)dbg + stage, __float_as_uint(e));
}
__device__ float chk_xbc(const Args& a, int l, int row, int ch) {
    const bf16* XBC = (const bf16*)(a.ws + WS_XBC); float s = a.in[I_SCONVB][l * XBC_W + ch];
    const bool samp = row >= TP; const int t = samp ? (row - TP) % 8 : row % PSEQ, b = samp ? (row - TP) / 8 : 0;
    for (int k = 0; k < 4; ++k) { const int tt = t - 3 + k; float v;
        if (tt >= 0) v = bf2f(XBC[(size_t)(row - 3 + k) * XBC_W + ch]); else v = samp ? a.in[I_CSSM][(((size_t)l * SB + b) * 3 + (3 + tt)) * XBC_W + ch] : 0.f;
        s += a.in[I_SCONVW][(size_t)l * 4 * XBC_W + k * XBC_W + ch] * v; }
    return s / (1.f + expf(-s));
}
__device__ float chk_cfconv(const Args& a, int l, int row, int ch) {
    const bf16* U = (const bf16*)(a.ws + WS_U); float s = a.in[I_CFCB][l * 1024 + ch];
    const bool samp = row >= TP; const int t = samp ? (row - TP) % 8 : row % PSEQ, b = samp ? (row - TP) / 8 : 0;
    for (int k = 0; k < 31; ++k) { const int tt = t - 30 + k; float v;
        if (tt >= 0) v = bf2f(U[(size_t)(row - 30 + k) * 1024 + ch]); else v = samp ? a.in[I_CCF][(((size_t)l * SB + b) * 30 + (30 + tt)) * 1024 + ch] : 0.f;
        s += a.in[I_CFCW][(size_t)l * 31 * 1024 + k * 1024 + ch] * v; }
    return s;
}
__global__ void chk_kernel(Args a, int layer, int part) {
    float* dbg = (float*)(a.ws + WS_DBG); const int l = layer;
    const int s = blockIdx.x * blockDim.x + threadIdx.x; const unsigned h = hash32(s * 2654435761u + 12345u + 977u * layer);
    const bf16* XB = (const bf16*)(a.ws + WS_XB); const bf16* ACT = (const bf16*)(a.ws + WS_ACT); const float* DT = (const float*)(a.ws + WS_DT);
    const bf16* KV = (const bf16*)(a.ws + WS_KV); const bf16* Zb = (const bf16*)(a.ws + WS_Z);
    if (part == 1) {
        const int row = h % TT, col = (h >> 13) % DM;
        if (layer == 0 && s < 4096) { const bf16* hr = (const bf16*)(a.ws + WS_H) + (size_t)row * DM; const bf16* wr = (const bf16*)(a.ws + WS_W3T + l * W3T_L) + (size_t)col * DM; float d = 0.f, da = 0.f;
            for (int k = 0; k < DM; ++k) { const float t = bf2f(hr[k]) * bf2f(wr[k]); d += t; da += fabsf(t); }
            const float xo = row < TP ? a.in[I_XP][(size_t)row * DM + col] : a.in[I_XS][(size_t)(row - TP) * DM + col];
            rec_err2(dbg, 27, a.out[(size_t)row * DM + col], xo + d, da + fabsf(xo) + 1e-3f); }
        rec_err2(dbg, 28, bf2f(XB[(size_t)row * DM + col]), a.out[(size_t)row * DM + col], fabsf(a.out[(size_t)row * DM + col]) + 0.01f);
        if (s < 2048) { float q = 0.f; for (int i = 0; i < DM; ++i) { const float v = a.out[(size_t)row * DM + i]; q += v * v; }
            rec_err2(dbg, 28, (float)((double)((const u64*)(a.ws + WS_SSQ))[(size_t)(l + 1) * TT + row] / 1048576.0), q, q * 0.25f + 1e-3f); }
        return;
    }
    if (part == 2) {
        if (s < 4096) { const int row = h % TT; float q = 0.f; for (int i = 0; i < DM; ++i) { const float v = a.out[(size_t)row * DM + i] / a.in[I_FNW][i]; q += v * v; }
            rec_err2(dbg, 29, q * (1.f / 2048.f), 1.f, 1.f); }
        return;
    }
    if (layer == 0) {
        const int row = h % TT, k = (h >> 14) % DM;
        const float x = row < TP ? a.in[I_XP][(size_t)row * DM + k] : a.in[I_XS][(size_t)(row - TP) * DM + k];
        rec_err(dbg, 0, bf2f(XB[(size_t)row * DM + k]), x, 0.01f);
        if (s < 4096) { const float* xr = row < TP ? a.in[I_XP] + (size_t)row * DM : a.in[I_XS] + (size_t)(row - TP) * DM; float q = 0.f; for (int i = 0; i < DM; ++i) q += xr[i] * xr[i];
            rec_err(dbg, 1, (float)((double)((const u64*)(a.ws + WS_SSQ))[row] / 1048576.0), q, 0.01f); }
    }
    {
        const unsigned h2 = hash32(h + 77u); const int n = h2 % N1, k = (h2 >> 16) % DM; const int pn = n >> 8, c = n & 255; const TileInfo ti = tile_info(pn);
        const int half = c >> 7, cc = c & 127; const int valid = half ? ti.valid1 : ti.valid0; float ref = 0.f;
        if (cc < valid) ref = a.in[I_WIN][(size_t)layer * DM * IN_COLS + (size_t)k * IN_COLS + (half ? ti.src1 : ti.src0) + cc] * a.in[I_NORMW][layer * DM + k];
        rec_err(dbg, 2, bf2f(((const bf16*)(a.ws + WS_W1T + layer * W1T_L))[(size_t)n * DM + k]), ref, 0.002f);
        const int n2 = h2 % DM, k2 = (h2 >> 12) % 4096, br = k2 >> 10, kk = k2 & 1023;
        float r2 = a.in[br == 0 ? I_WOSSM : (br == 1 ? I_WOCF : (br == 2 ? I_WOSC : I_WOATT))][(size_t)layer * 1024 * DM + (size_t)kk * DM + n2]; if (br == 0) r2 *= a.in[I_SNORMW][layer * 1024 + kk];
        rec_err(dbg, 3, bf2f(((const bf16*)(a.ws + WS_W2T + layer * W2T_L))[(size_t)n2 * 4096 + k2]), r2, 0.002f);
        const int k3 = (h2 >> 11) % DM;
        rec_err(dbg, 4, bf2f(((const bf16*)(a.ws + WS_W3T + layer * W3T_L))[(size_t)n2 * DM + k3]), a.in[I_WO][(size_t)layer * DM * DM + (size_t)k3 * DM + n2], 0.002f);
    }
    {
        const unsigned h3 = hash32(h + 991u); const int row = h3 % TT, pn = s % NT1; const TileInfo ti = tile_info(pn);
        const int ncol = ti.mode == M_DT ? 16 : (ti.mode >= M_GLU ? 128 : 256); const int c = (h3 >> 14) % ncol;
        const bf16* W = (const bf16*)(a.ws + WS_W1T + layer * W1T_L) + (size_t)pn * 256 * DM; const bf16* xr = XB + (size_t)row * DM;
        float d0 = 0.f, d1 = 0.f;
        for (int k = 0; k < DM; ++k) { const float x = bf2f(xr[k]); d0 += x * bf2f(W[(size_t)c * DM + k]); if (ti.mode >= M_GLU && ti.mode <= M_ASILUB) d1 += x * bf2f(W[(size_t)(c + 128) * DM + k]); }
        const float r = ssq_to_rstd(((const u64*)(a.ws + WS_SSQ))[(size_t)layer * TT + row], 1.f / 2048.f, 1e-6f); d0 *= r; d1 *= r;
        float ref, got;
        switch (ti.mode) { case M_ID: ref = d0; break; case M_SILU: ref = d0 / (1.f + expf(-d0)); break; case M_SIG: ref = 1.f / (1.f + expf(-d0)); break;
            case M_GLU: ref = d0 / (1.f + expf(-d1)); break; case M_MUL: ref = d0 * d1; break; case M_ASILUB: ref = d0 * d1 / (1.f + expf(-d1)); break;
            default: ref = log1pf(expf(d0 + a.in[I_DTB][layer * 16 + c])); break; }
        if (ti.mode == M_DT) got = ((const float*)(a.ws + ti.dst))[(size_t)row * 16 + c]; else got = bf2f(((const bf16*)(a.ws + ti.dst))[(size_t)row * ti.ld + ti.col0 + c]);
        rec_err(dbg, 5 + ti.mode, got, ref, ti.mode == M_DT ? 1e-4f : 0.03f);
    }
    const unsigned h4 = hash32(h + 31337u);
    if (s < 2048) {
        const int row = (s & 1) ? TP + (h4 % TS) : (h4 % TP), c = (h4 >> 13) & 1023;
        float sm = 0.f; for (int ch = 0; ch < 1024; ++ch) sm += chk_cfconv(a, l, row, ch);
        const float mean = sm / 1024.f; float q = 0.f; for (int ch = 0; ch < 1024; ++ch) { const float d = chk_cfconv(a, l, row, ch) - mean; q += d * d; }
        const float v = (chk_cfconv(a, l, row, c) - mean) * rsqrtf(q / 1024.f + 1e-5f) * a.in[I_CFLNW][l * 1024 + c] + a.in[I_CFLNB][l * 1024 + c];
        const float ref = v / (1.f + expf(-v)) * bf2f(((const bf16*)(a.ws + WS_CFG))[(size_t)row * 1024 + c]);
        rec_err2(dbg, 12, bf2f(ACT[(size_t)row * 4096 + 1024 + c]), ref, fabsf(ref) + 0.02f);
        const bf16* CV = (const bf16*)(a.ws + WS_CV); const bool samp = row >= TP; const int t = samp ? (row - TP) % 8 : row % PSEQ, b = samp ? (row - TP) / 8 : 0; float y = 0.f, ya = 0.f;
        for (int k = 0; k < 3; ++k) { const int tt = t - 2 + k; float xv; if (tt >= 0) xv = bf2f(CV[(size_t)(row - 2 + k) * 1024 + c]); else xv = samp ? a.in[I_CSC][(((size_t)l * SB + b) * 2 + (2 + tt)) * 1024 + c] : 0.f;
            const float tm = a.in[I_SCCW][(size_t)l * 3 * 1024 + k * 1024 + c] * xv; y += tm; ya += fabsf(tm); }
        const float cm = bf2f(((const bf16*)(a.ws + WS_CM))[(size_t)row * 1024 + c]);
        rec_err2(dbg, 13, bf2f(ACT[(size_t)row * 4096 + 2048 + c]), y * cm, ya * fabsf(cm) + 0.01f);
    }
    if (s < 4096) {
        const int b = h4 & 3, c = (h4 >> 2) & 15, hh = (h4 >> 6) & 15, p = (h4 >> 10) & 63, n = (h4 >> 16) & 127, g = hh >> 2; const int r0 = b * PSEQ + c * CHUNK;
        const float A = -expf(a.in[I_ALOG][l * HEADS + hh]); float last = 0.f; for (int i = 0; i < 128; ++i) last += DT[(size_t)(r0 + i) * 16 + hh] * A;
        float cum = 0.f, ref = 0.f, refa = 0.f;
        for (int i = 0; i < 128; ++i) { const float d = DT[(size_t)(r0 + i) * 16 + hh]; cum += d * A;
            const float tm = chk_xbc(a, l, r0 + i, 1024 + g * 128 + n) * d * expf(last - cum) * chk_xbc(a, l, r0 + i, hh * 64 + p); ref += tm; refa += fabsf(tm); }
        const float* CST = (const float*)(a.ws + WS_CST); const float* CDEC = (const float*)(a.ws + WS_CDEC);
        const size_t eo = (size_t)p * NST + n;
        rec_err2(dbg, 14, CST[((size_t)((b * NCH + c) * HEADS + hh)) * 8192 + eo], ref, refa + 1e-5f);
        rec_err2(dbg, 15, CDEC[(b * NCH + c) * HEADS + hh], expf(last), expf(last) + 1e-6f);
        float H = 0.f; for (int cc = 0; cc < c; ++cc) H = H * CDEC[(b * NCH + cc) * HEADS + hh] + CST[((size_t)((b * NCH + cc) * HEADS + hh)) * 8192 + eo];
        rec_err2(dbg, 16, bf2f(((const bf16*)(a.ws + WS_HPREV))[((size_t)((b * NCH + c) * HEADS + hh)) * 8192 + eo]), H, fabsf(H) + 1e-3f);
        for (int cc = c; cc < NCH; ++cc) H = H * CDEC[(b * NCH + cc) * HEADS + hh] + CST[((size_t)((b * NCH + cc) * HEADS + hh)) * 8192 + eo];
        rec_err2(dbg, 17, a.out[O_PSSM + ((size_t)((l * PB + b) * HEADS + hh)) * 8192 + eo], H, fabsf(H) + 1e-4f);
    }
    if (s < 1024) {
        const int row = h4 % TP, hh = (h4 >> 13) & 15, p = (h4 >> 17) & 63, g = hh >> 2; const int b = row / PSEQ, t = row % PSEQ, c = t / CHUNK, tl = t % CHUNK, r0 = b * PSEQ + c * CHUNK;
        const float A = -expf(a.in[I_ALOG][l * HEADS + hh]); float cst = 0.f; for (int i = 0; i <= tl; ++i) cst += DT[(size_t)(r0 + i) * 16 + hh] * A;
        float y = 0.f, ya = 0.f, css = 0.f;
        for (int i = 0; i <= tl; ++i) { const float d = DT[(size_t)(r0 + i) * 16 + hh]; css += d * A; float gsum = 0.f;
            for (int n = 0; n < 128; ++n) gsum += chk_xbc(a, l, row, 1536 + g * 128 + n) * chk_xbc(a, l, r0 + i, 1024 + g * 128 + n);
            const float tm = gsum * expf(cst - css) * d * chk_xbc(a, l, r0 + i, hh * 64 + p); y += tm; ya += fabsf(tm); }
        const bf16* hp = (const bf16*)(a.ws + WS_HPREV) + ((size_t)((b * NCH + c) * HEADS + hh)) * 8192 + (size_t)p * NST; const float ec = expf(cst);
        for (int n = 0; n < 128; ++n) { const float tm = ec * chk_xbc(a, l, row, 1536 + g * 128 + n) * bf2f(hp[n]); y += tm; ya += fabsf(tm); }
        const float dx = a.in[I_DSKIP][l * HEADS + hh] * chk_xbc(a, l, row, hh * 64 + p), z = bf2f(Zb[(size_t)row * 1024 + hh * 64 + p]);
        rec_err2(dbg, 18, bf2f(ACT[(size_t)row * 4096 + hh * 64 + p]), (y + dx) * z, (ya + fabsf(dx)) * fabsf(z) + 1e-3f);
        const int row2 = (h4 >> 3) % TT; float q = 0.f; for (int i = 0; i < 1024; ++i) { const float v = bf2f(ACT[(size_t)row2 * 4096 + i]); q += v * v; }
        rec_err2(dbg, 19, (float)((double)((const u64*)(a.ws + WS_SSQA))[(size_t)l * TT + row2] / 1048576.0), q, q + 1e-4f);
    }
    if (s < 2048) {
        const int b = h4 & 127, hh = (h4 >> 7) & 15, p = (h4 >> 11) & 63, nsel = (h4 >> 17) & 127, g = hh >> 2; const int row0 = TP + 8 * b;
        const float A = -expf(a.in[I_ALOG][l * HEADS + hh]); float y[8] = {0.f, 0.f, 0.f, 0.f, 0.f, 0.f, 0.f, 0.f}, ya[8] = {0.f, 0.f, 0.f, 0.f, 0.f, 0.f, 0.f, 0.f}; float hfin = 0.f;
        for (int n = 0; n < 128; ++n) { float hn = a.in[I_SSM][((size_t)((l * SB + b) * HEADS + hh)) * 8192 + (size_t)p * NST + n];
#pragma unroll
            for (int t = 0; t < 8; ++t) { const float d = DT[(size_t)(row0 + t) * 16 + hh]; hn = hn * expf(d * A) + d * chk_xbc(a, l, row0 + t, hh * 64 + p) * chk_xbc(a, l, row0 + t, 1024 + g * 128 + n);
                const float tm = chk_xbc(a, l, row0 + t, 1536 + g * 128 + n) * hn; y[t] += tm; ya[t] += fabsf(tm); }
            if (n == nsel) hfin = hn; }
#pragma unroll
        for (int t = 0; t < 8; ++t) { const float dx = a.in[I_DSKIP][l * HEADS + hh] * chk_xbc(a, l, row0 + t, hh * 64 + p), z = bf2f(Zb[(size_t)(row0 + t) * 1024 + hh * 64 + p]);
            rec_err2(dbg, 20, bf2f(ACT[(size_t)(row0 + t) * 4096 + hh * 64 + p]), (y[t] + dx) * z, (ya[t] + fabsf(dx)) * fabsf(z) + 1e-3f); }
        rec_err2(dbg, 21, a.out[O_SSSM + ((size_t)((l * SB + b) * HEADS + hh)) * 8192 + (size_t)p * NST + nsel], hfin, fabsf(hfin) + 1e-3f);
    }
    if (s < 4096) {
        const int row = h4 % TP, hh = (h4 >> 13) & 15, d = (h4 >> 17) & 63, g = hh >> 2; const int t = row % PSEQ; const int klo = t - 127 < 0 ? 0 : t - 127;
        const bf16* q = (const bf16*)(a.ws + WS_Q) + (size_t)row * 1024 + hh * 64; const float sink = a.in[I_SINK][l * HEADS + hh];
        float mx = sink;
        for (int kt = klo; kt <= t; ++kt) { const bf16* kr = KV + (size_t)(row - t + kt) * 512 + g * 64; float sc = 0.f; for (int e = 0; e < 64; ++e) sc += bf2f(q[e]) * bf2f(kr[e]); mx = fmaxf(mx, sc * 0.125f); }
        float den = expf(sink - mx), o = 0.f, oa = 0.f;
        for (int kt = klo; kt <= t; ++kt) { const bf16* kr = KV + (size_t)(row - t + kt) * 512 + g * 64; float sc = 0.f; for (int e = 0; e < 64; ++e) sc += bf2f(q[e]) * bf2f(kr[e]);
            const float pp = expf(sc * 0.125f - mx); den += pp; const float tm = pp * bf2f(kr[256 + d]); o += tm; oa += fabsf(tm); }
        const float gt = bf2f(((const bf16*)(a.ws + WS_AG))[(size_t)row * 1024 + hh * 64 + d]);
        rec_err2(dbg, 22, bf2f(ACT[(size_t)row * 4096 + 3072 + hh * 64 + d]), o / den * gt, oa / den * fabsf(gt) + 1e-3f);
    }
    if (s < 4096) {
        const int b = h4 & 127, qi = (h4 >> 7) & 7, hh = (h4 >> 10) & 15, d = (h4 >> 14) & 63, g = hh >> 2; const int row = TP + 8 * b + qi;
        const bf16* q = (const bf16*)(a.ws + WS_Q) + (size_t)row * 1024 + hh * 64; const float sink = a.in[I_SINK][l * HEADS + hh];
        float mx = sink;
        for (int pass = 0; pass < 1; ++pass) for (int j = 0; j < 136; ++j) { if (j < 128 ? (j <= qi) : (j - 128 > qi)) continue; float sc = 0.f;
            for (int e = 0; e < 64; ++e) { const float kv = j < 128 ? a.in[I_CK][(((size_t)l * SB + b) * 128 + j) * 256 + g * 64 + e] : bf2f(KV[(size_t)(TP + 8 * b + j - 128) * 512 + g * 64 + e]); sc += bf2f(q[e]) * kv; }
            mx = fmaxf(mx, sc * 0.125f); }
        float den = expf(sink - mx), o = 0.f, oa = 0.f;
        for (int j = 0; j < 136; ++j) { if (j < 128 ? (j <= qi) : (j - 128 > qi)) continue; float sc = 0.f;
            for (int e = 0; e < 64; ++e) { const float kv = j < 128 ? a.in[I_CK][(((size_t)l * SB + b) * 128 + j) * 256 + g * 64 + e] : bf2f(KV[(size_t)(TP + 8 * b + j - 128) * 512 + g * 64 + e]); sc += bf2f(q[e]) * kv; }
            const float pp = expf(sc * 0.125f - mx); den += pp; const float vv = j < 128 ? a.in[I_CVV][(((size_t)l * SB + b) * 128 + j) * 256 + g * 64 + d] : bf2f(KV[(size_t)(TP + 8 * b + j - 128) * 512 + 256 + g * 64 + d]);
            const float tm = pp * vv; o += tm; oa += fabsf(tm); }
        const float gt = bf2f(((const bf16*)(a.ws + WS_AG))[(size_t)row * 1024 + hh * 64 + d]);
        rec_err2(dbg, 23, bf2f(ACT[(size_t)row * 4096 + 3072 + hh * 64 + d]), o / den * gt, oa / den * fabsf(gt) + 1e-3f);
        const int jj = (h4 >> 20) & 127; const size_t oo = (((size_t)l * SB + b) * 128 + jj) * 256 + g * 64 + d;
        const float rk = jj < 120 ? a.in[I_CK][oo + 8 * 256] : bf2f(KV[(size_t)(TP + 8 * b + jj - 120) * 512 + g * 64 + d]);
        const float rv = jj < 120 ? a.in[I_CVV][oo + 8 * 256] : bf2f(KV[(size_t)(TP + 8 * b + jj - 120) * 512 + 256 + g * 64 + d]);
        rec_err2(dbg, 24, a.out[O_SK + oo], rk, fabsf(rk) + 1e-3f); rec_err2(dbg, 24, a.out[O_SV + oo], rv, fabsf(rv) + 1e-3f);
    }
    if (s < 4096) {
        const bf16* U = (const bf16*)(a.ws + WS_U); const bf16* CV = (const bf16*)(a.ws + WS_CV); const bf16* XBC = (const bf16*)(a.ws + WS_XBC);
        const int b = h4 & 127, pb = b & 3, c = (h4 >> 7) & 1023, c2 = (h4 >> 7) & 2047, r30 = (h4 >> 18) % 30, r3 = (h4 >> 18) % 3, r2 = (h4 >> 18) & 1, jj = (h4 >> 18) & 127, c512 = (h4 >> 7) & 255;
        float ref;
        ref = bf2f(U[(size_t)(pb * PSEQ + 2018 + r30) * 1024 + c]); rec_err2(dbg, 25, a.out[O_PCCF + (((size_t)l * PB + pb) * 30 + r30) * 1024 + c], ref, fabsf(ref) + 1e-3f);
        ref = bf2f(CV[(size_t)(pb * PSEQ + 2046 + r2) * 1024 + c]); rec_err2(dbg, 25, a.out[O_PCSC + (((size_t)l * PB + pb) * 2 + r2) * 1024 + c], ref, fabsf(ref) + 1e-3f);
        ref = bf2f(XBC[(size_t)(pb * PSEQ + 2045 + r3) * 2048 + c2]); rec_err2(dbg, 25, a.out[O_PCSSM + (((size_t)l * PB + pb) * 3 + r3) * 2048 + c2], ref, fabsf(ref) + 1e-3f);
        ref = bf2f(KV[(size_t)(pb * PSEQ + 1920 + jj) * 512 + c512]); rec_err2(dbg, 25, a.out[O_PK + (((size_t)l * PB + pb) * 128 + jj) * 256 + c512], ref, fabsf(ref) + 1e-3f);
        ref = bf2f(KV[(size_t)(pb * PSEQ + 1920 + jj) * 512 + 256 + c512]); rec_err2(dbg, 25, a.out[O_PV + (((size_t)l * PB + pb) * 128 + jj) * 256 + c512], ref, fabsf(ref) + 1e-3f);
        const int row0 = TP + 8 * b;
        ref = r30 < 22 ? a.in[I_CCF][(((size_t)l * SB + b) * 30 + r30 + 8) * 1024 + c] : bf2f(U[(size_t)(row0 + r30 - 22) * 1024 + c]); rec_err2(dbg, 25, a.out[O_SCCF + (((size_t)l * SB + b) * 30 + r30) * 1024 + c], ref, fabsf(ref) + 1e-3f);
        ref = bf2f(CV[(size_t)(row0 + 6 + r2) * 1024 + c]); rec_err2(dbg, 25, a.out[O_SCSC + (((size_t)l * SB + b) * 2 + r2) * 1024 + c], ref, fabsf(ref) + 1e-3f);
        ref = bf2f(XBC[(size_t)(row0 + 5 + r3) * 2048 + c2]); rec_err2(dbg, 25, a.out[O_SCSSM + (((size_t)l * SB + b) * 3 + r3) * 2048 + c2], ref, fabsf(ref) + 1e-3f);
    }
    if (s < 4096) {
        const int row = h4 % TT, col = (h4 >> 14) % DM; float ref = 0.f, refa = 0.f;
        for (int br = 0; br < 4; ++br) { const bf16* ar = ACT + (size_t)row * 4096 + br * 1024; const bf16* wr = (const bf16*)(a.ws + WS_W2T + l * W2T_L) + (size_t)col * 4096 + br * 1024; float d = 0.f, da = 0.f;
            for (int k = 0; k < 1024; ++k) { const float tm = bf2f(ar[k]) * bf2f(wr[k]); d += tm; da += fabsf(tm); }
            const float gt = bf2f(((const bf16*)(a.ws + WS_MG))[(size_t)row * 8192 + br * 2048 + col]) * (br == 0 ? ssq_to_rstd(((const u64*)(a.ws + WS_SSQA))[(size_t)l * TT + row], 1.f / 1024.f, 1e-5f) : 1.f);
            ref += gt * d; refa += fabsf(gt) * da; }
        rec_err2(dbg, 26, bf2f(((const bf16*)(a.ws + WS_H))[(size_t)row * DM + col]), ref, refa + 1e-3f);
    }
}
__global__ void chk_init(Args a) { float* dbg = (float*)(a.ws + WS_DBG); if (threadIdx.x < NSTAGE) dbg[threadIdx.x] = 0.f; }
__global__ void chk_encode(Args a, int out_size) {
    const float* dbg = (const float*)(a.ws + WS_DBG);
    const size_t i0 = (size_t)blockIdx.x * blockDim.x + threadIdx.x, n = (size_t)gridDim.x * blockDim.x;
    for (size_t i = i0; i < (size_t)out_size; i += n) a.out[i] = 0.f;
    if (i0 == 0) {
        const float tol[NSTAGE] = {0.01f, 1e-3f, 0.01f, 0.01f, 0.01f, 0.02f, 0.02f, 0.02f, 0.02f, 0.02f, 0.02f, 0.01f,
                                   0.02f, 0.02f, 0.02f, 1e-3f, 0.01f, 1e-3f, 0.02f, 0.01f, 0.02f, 1e-3f, 0.02f, 0.02f, 0.01f, 0.01f, 0.02f, 0.01f, 0.02f, 2e-3f};
        float code = 9.9e8f;
        for (int st = 0; st < 30; ++st) { const float e = dbg[st]; if (!(e <= tol[st]) || e == 0.f) { const int bucket = e == 0.f ? 5 : (e < 1e-2f ? 0 : (e < 1e-1f ? 1 : (e < 1.f ? 2 : (e < 10.f ? 3 : 4)))); code = (float)(10 + st) * 100.f * powf(10.f, (float)bucket); break; } }
        a.out[0] = code;
    }
}
#endif


#if PROBE_TIMING
__global__ void timing_encode(Args a) {
    const u64* ts = (const u64*)(a.ws + WS_DBG) + 64;
    float sum = 0.f;
    for (int k = 0; k < 14; ++k) { const float d = (float)(ts[k + 1] - ts[k]) * 0.01f; const int j = (k >= 1 && k <= 12) ? (k - 1) % 6 : -1;
        bool take = false;
        if (PROBE_TIMING == 1) take = (j == 0);
        else if (PROBE_TIMING == 2) take = (j == 1);
        else if (PROBE_TIMING == 3) take = (j == 2 || j == 3);
        else if (PROBE_TIMING == 4) take = (k == 0);
        else if (PROBE_TIMING == 5) take = true;
        else if (PROBE_TIMING == 6) take = (j == 4);
        else if (PROBE_TIMING == 7) take = (j == 5);
        else if (PROBE_TIMING == 8) take = (k == 13);
        else if (PROBE_TIMING >= 100) take = (k == PROBE_TIMING - 100);
        if (take) sum += d; }
    a.out[O_SK] = a.in[I_CK][8 * 256] + 8.0f * log2f(sum);
}
#endif
extern "C" void kernel_launch(void* const* d_in, const int* in_sizes, int n_in, void* d_out, int out_size, void* d_ws, size_t ws_size, hipStream_t stream) {
    static int grid = 0;
    if (grid == 0) {
        int dev = 0, cus = 0, per_cu = 0;
        (void)hipGetDevice(&dev);
        (void)hipDeviceGetAttribute(&cus, hipDeviceAttributeMultiprocessorCount, dev);
        (void)hipFuncSetAttribute((const void*)mk_fwd, hipFuncAttributeMaxDynamicSharedMemorySize, LDS_BYTES);
        (void)hipOccupancyMaxActiveBlocksPerMultiprocessor(&per_cu, (const void*)mk_fwd, 512, LDS_BYTES);
        if (per_cu < 1 || n_in != 28 || ws_size < WS_END) { fprintf(stderr, "kernel_launch: unexpected environment (per_cu %d, n_in %d, ws %zu)\n", per_cu, n_in, ws_size); grid = -1; return; }
        grid = cus;
    }
    if (grid < 0) return;
    (void)hipMemsetAsync((char*)d_ws + WS_CTL, 0, CTL_BYTES, stream);
    Args a{};
    for (int i = 0; i < 28; ++i) a.in[i] = (const float*)d_in[i];
    a.out = (float*)d_out; a.ws = (unsigned char*)d_ws;
    const int NPH = 1 + NL * 6 + 1;
#if PROBE_CHECK
    chk_init<<<1, 64, 0, stream>>>(a);
#endif
#if PROBE_CHECK
    for (int p = 0; p < NPH; ++p) {
        a.ph_lo = p; a.ph_hi = p + 1;
        void* args[] = {&a};
        hipError_t e = hipLaunchCooperativeKernel((const void*)mk_fwd, dim3(grid), dim3(512), args, LDS_BYTES, stream);
        if (e != hipSuccess) fprintf(stderr, "cooperative launch failed: %s (grid %d)\n", hipGetErrorString(e), grid);
        if (p >= 1 && p < NPH - 1 && (p - 1) % 6 == 4) chk_kernel<<<64, 256, 0, stream>>>(a, (p - 1) / 6, 0);
        if (p >= 1 && p < NPH - 1 && (p - 1) % 6 == 5) chk_kernel<<<64, 256, 0, stream>>>(a, (p - 1) / 6, 1);
        if (p == NPH - 1) chk_kernel<<<64, 256, 0, stream>>>(a, 0, 2);
    }
#else
    {
        a.ph_lo = 0; a.ph_hi = NPH;
        hipLaunchKernelGGL(mk_fwd, dim3(grid), dim3(512), LDS_BYTES, stream, a);
        const hipError_t e = hipPeekAtLastError();
        if (e != hipSuccess) fprintf(stderr, "launch failed: %s (grid %d)\n", hipGetErrorString(e), grid);
    }
#endif
#if PROBE_CHECK
    chk_encode<<<256, 256, 0, stream>>>(a, out_size);
#endif
#if PROBE_TIMING
    timing_encode<<<1, 1, 0, stream>>>(a);
#endif
}
```

```cpp
#include <hip/hip_runtime.h>
#include <hip/hip_cooperative_groups.h>
#include <cstdio>
#include <cstdint>
namespace cg = cooperative_groups;

#ifndef PROBE_TIMING
#define PROBE_TIMING 0
#endif
#ifndef GEMM_MASK
#define GEMM_MASK 7
#endif
#ifndef ITEM_MASK
#define ITEM_MASK 127
#endif
#ifndef PROBE_CHECK
#define PROBE_CHECK 0
#endif

#define LAS __attribute__((address_space(3)))
typedef unsigned short bf16;
typedef short bf16x8 __attribute__((ext_vector_type(8)));
typedef float f32x4 __attribute__((ext_vector_type(4)));
typedef float f32x2 __attribute__((ext_vector_type(2)));
typedef unsigned u32x4 __attribute__((ext_vector_type(4)));
typedef unsigned u32x2 __attribute__((ext_vector_type(2)));
typedef unsigned long long u64;

constexpr int DM = 2048, TP = 8192, TS = 1024, TT = TP + TS, NL = 2;
constexpr int PB = 4, PSEQ = 2048, SB = 128, SSEQ = 8;
constexpr int IN_COLS = 21008, NT1 = 83, N1 = NT1 * 256;
constexpr int HEADS = 16, HD = 64, GROUPS = 4, NST = 128, CHUNK = 128, NCH = PSEQ / CHUNK;
constexpr int XBC_W = 2048, CFW = 1024, SCW = 1024;
constexpr int C_Z = 0, C_XBC = 1024, C_DT = 3072, C_CFA = 3088, C_CFB = 4112, C_CFG = 5136, C_GB = 6160, C_GC = 7184, C_SV = 8208, C_SCG = 9232,
              C_Q = 10256, C_K = 11280, C_V = 11536, C_AG = 11792, C_MG = 12816;

constexpr size_t MiB = 1u << 20;
constexpr size_t WS_CTL = 0, CTL_BYTES = 1 * MiB;
constexpr size_t WS_SSQ = 1 * MiB;
constexpr size_t WS_SSQA = 2 * MiB;
constexpr size_t WS_W1T = 16 * MiB;
constexpr size_t W1T_L = (size_t)N1 * DM * 2;
constexpr size_t WS_W2T = 192 * MiB;
constexpr size_t W2T_L = (size_t)DM * 4096 * 2;
constexpr size_t WS_W3T = 224 * MiB;
constexpr size_t W3T_L = (size_t)DM * DM * 2;
constexpr size_t WS_XB = 240 * MiB;
constexpr size_t WS_Z = 276 * MiB;
constexpr size_t WS_XBC = 294 * MiB;
constexpr size_t WS_U = 330 * MiB;
constexpr size_t WS_CFG = 348 * MiB;
constexpr size_t WS_CV = 366 * MiB;
constexpr size_t WS_CM = 384 * MiB;
constexpr size_t WS_Q = 402 * MiB;
constexpr size_t WS_KV = 420 * MiB;
constexpr size_t WS_AG = 429 * MiB;
constexpr size_t WS_MG = 447 * MiB;
constexpr size_t WS_DT = 591 * MiB;
constexpr size_t WS_ACT = 592 * MiB;
constexpr size_t WS_H = 664 * MiB;
constexpr size_t WS_CST = 700 * MiB;
constexpr size_t WS_HPREV = 732 * MiB;
constexpr size_t WS_CDEC = 748 * MiB;
constexpr size_t WS_DBG = 813 * MiB;
constexpr size_t WS_END = 814 * MiB;

constexpr int LDS_MISC = 147456, LDS_BYTES = LDS_MISC + 256;

__device__ __forceinline__ float bf2f(unsigned v) { return __uint_as_float(v << 16); }
typedef float f32x2c_t __attribute__((ext_vector_type(2))); typedef __bf16 bf16x2c_t __attribute__((ext_vector_type(2)));
__device__ __forceinline__ unsigned pk2(float lo, float hi) { const f32x2c_t v = {lo, hi}; const bf16x2c_t b = __builtin_convertvector(v, bf16x2c_t); return __builtin_bit_cast(unsigned, b); }
__device__ __forceinline__ unsigned f2bf(float f) { return pk2(f, 0.f) & 0xffffu; }
__device__ __forceinline__ float fsigmoid(float x) { return __builtin_amdgcn_rcpf(1.0f + __expf(-x)); }
__device__ __forceinline__ float fsilu(float x) { return x * fsigmoid(x); }
__device__ __forceinline__ float fsoftplus(float x) { return x > 15.f ? x : log1pf(__expf(x)); }
__device__ __forceinline__ float ssq_to_rstd(u64 s, float inv_n, float eps) { return rsqrtf((float)s * (inv_n * (1.0f / 1048576.0f)) + eps); }
__device__ __forceinline__ u64 ssq_fix(float s) { return (u64)((double)s * 1048576.0 + 0.5); }
#define LDS_WAIT() asm volatile("s_waitcnt lgkmcnt(0)" ::: "memory")
__device__ __forceinline__ int fresh_lane() { int ln = (int)__builtin_amdgcn_mbcnt_hi(~0u, __builtin_amdgcn_mbcnt_lo(~0u, 0u)); asm volatile("" : "+v"(ln)); return ln; }


template <int CTRL> __device__ __forceinline__ float dpp_f(float v) { return __int_as_float(__builtin_amdgcn_update_dpp(0, __float_as_int(v), CTRL, 0xf, 0xf, true)); }
__device__ __forceinline__ float red8_sum(float v) { v += dpp_f<0xB1>(v); v += dpp_f<0x4E>(v); v += dpp_f<0x141>(v); return v; }
__device__ __forceinline__ float red16_sum(float v) { v = red8_sum(v); v += dpp_f<0x140>(v); return v; }
__device__ __forceinline__ float red16_max(float v) { v = fmaxf(v, dpp_f<0xB1>(v)); v = fmaxf(v, dpp_f<0x4E>(v)); v = fmaxf(v, dpp_f<0x141>(v)); v = fmaxf(v, dpp_f<0x140>(v)); return v; }
__device__ __forceinline__ float rl_f(float v, int l) { return __int_as_float(__builtin_amdgcn_readlane(__float_as_int(v), l)); }
__device__ __forceinline__ float xor16_f(float v) { auto r = __builtin_amdgcn_permlane16_swap(__float_as_uint(v), __float_as_uint(v), false, false); return __uint_as_float(r[0] ^ r[1] ^ __float_as_uint(v)); }
__device__ __forceinline__ float xor32_f(float v) { auto r = __builtin_amdgcn_permlane32_swap(__float_as_uint(v), __float_as_uint(v), false, false); return __uint_as_float(r[0] ^ r[1] ^ __float_as_uint(v)); }

struct TileInfo { int mode, src0, src1, valid0, valid1; size_t dst; int ld, col0; };
enum { M_ID = 0, M_SILU = 1, M_SIG = 2, M_GLU = 3, M_MUL = 4, M_ASILUB = 5, M_DT = 6, M_SIGR = 7 };
__host__ __device__ __forceinline__ TileInfo tile_info(int pn) {
    TileInfo t; t.valid0 = 128; t.valid1 = 128;
    if (pn < 4)       { t.mode = M_SILU;   t.src0 = C_Z + 256 * pn;           t.src1 = t.src0 + 128; t.dst = WS_Z;   t.ld = 1024; t.col0 = 256 * pn; }
    else if (pn < 12) { t.mode = M_ID;     t.src0 = C_XBC + 256 * (pn - 4);   t.src1 = t.src0 + 128; t.dst = WS_XBC; t.ld = 2048; t.col0 = 256 * (pn - 4); }
    else if (pn < 20) { t.mode = M_GLU;    t.src0 = C_CFA + 128 * (pn - 12);  t.src1 = C_CFB + 128 * (pn - 12); t.dst = WS_U; t.ld = 1024; t.col0 = 128 * (pn - 12); }
    else if (pn < 24) { t.mode = M_SILU;   t.src0 = C_CFG + 256 * (pn - 20);  t.src1 = t.src0 + 128; t.dst = WS_CFG; t.ld = 1024; t.col0 = 256 * (pn - 20); }
    else if (pn < 32) { t.mode = M_MUL;    t.src0 = C_GC + 128 * (pn - 24);   t.src1 = C_SV + 128 * (pn - 24); t.dst = WS_CV; t.ld = 1024; t.col0 = 128 * (pn - 24); }
    else if (pn < 40) { t.mode = M_ASILUB; t.src0 = C_GB + 128 * (pn - 32);   t.src1 = C_SCG + 128 * (pn - 32); t.dst = WS_CM; t.ld = 1024; t.col0 = 128 * (pn - 32); }
    else if (pn < 44) { t.mode = M_ID;     t.src0 = C_Q + 256 * (pn - 40);    t.src1 = t.src0 + 128; t.dst = WS_Q;   t.ld = 1024; t.col0 = 256 * (pn - 40); }
    else if (pn < 46) { t.mode = M_ID;     t.src0 = C_K + 256 * (pn - 44);    t.src1 = t.src0 + 128; t.dst = WS_KV;  t.ld = 512;  t.col0 = 256 * (pn - 44); }
    else if (pn < 50) { t.mode = M_SILU;   t.src0 = C_AG + 256 * (pn - 46);   t.src1 = t.src0 + 128; t.dst = WS_AG;  t.ld = 1024; t.col0 = 256 * (pn - 46); }
    else if (pn < 82) { t.mode = M_SIGR;   t.src0 = C_MG + 64 * (pn - 50);    t.src1 = t.src0 + 4096; t.dst = WS_MG; t.ld = 8192; t.col0 = 64 * (pn - 50); }
    else              { t.mode = M_DT;     t.src0 = C_DT; t.src1 = 0; t.valid0 = 16; t.valid1 = 0; t.dst = WS_DT; t.ld = 16; t.col0 = 0; }
    return t;
}

namespace pg8 {
constexpr int BM = 256, BK = 64, HALF = 128, HTB = HALF * BK * 2, STAGE_BYTES = 8 * HTB, NXCD = 8, WGM = 4;
__host__ __device__ __forceinline__ int lds_byte(int r, int c) { const int st = (r >> 4) * 2 + (c >> 5), rr = r & 15, cc = c & 31, ob = rr * 64 + cc * 2; return st * 1024 + (ob ^ (((ob >> 9) & 1) << 5)); }
__host__ __device__ __forceinline__ void stage_rc(int b, int& R, int& C) { const int st = b / 1024, sb = b % 1024, swz = sb ^ (((sb >> 9) & 1) << 5); R = (st >> 1) * 16 + swz / 64; C = (st & 1) * 32 + (swz % 64) / 2; }
__host__ __device__ __forceinline__ int perm32(int rho) { const int n = rho >> 4, i = rho & 15; return 8 * (i >> 2) + 4 * n + (i & 3); }

struct Unit { int pm, pn, sub; };
struct Gemm { const bf16* A; const bf16* Bt; int lda, ldb, nt, ksubA, ksubB; };

struct Order {
    int nM, nN, nwg, G, c, nsub, m249;
    __device__ void init(int nM_, int nN_, int G_, int c_, int nsub_) { nM = nM_; nN = nN_; nwg = nM * nN; G = G_; c = c_; nsub = nsub_; m249 = 0; }
    __device__ bool next(int i, Unit& u) const {
        const int gi = i / nsub; u.sub = i - gi * nsub;
        int wgid;
        if (m249) {
            if (gi >= 12) return false;
            const int x = c & 7, j = c >> 3; wgid = (x ? 384 + 372 * (x - 1) : 0) + gi * (x ? 31 : 32) + j;
        } else {
            const long L = (long)gi * G + c; if (L >= nwg) return false;
            wgid = (int)L; { const int q = nwg / NXCD, r = nwg % NXCD, xcd = wgid % NXCD, off = wgid / NXCD; wgid = (xcd < r ? xcd * (q + 1) : r * (q + 1) + (xcd - r) * q) + off; }
        }
        const int nig = WGM * nN, gid = wgid / nig, fm = gid * WGM, gsz = (nM - fm) < WGM ? (nM - fm) : WGM;
        u.pm = fm + ((wgid % nig) % gsz); u.pn = (wgid % nig) / gsz; return true;
    }
};

struct ListOrder {
    int g0, g1, n, nsub, sb;
    __device__ bool next(int i, Unit& u) const {
        const int gi = i / nsub; u.sub = sb + (i - gi * nsub); if (gi >= n) return false;
        const int g = gi == 0 ? g0 : g1; u.pm = g >> 3; u.pn = g & 7; return true;
    }
};
template <class Epi, class Sched>
__device__ __forceinline__ void gemm_phase(LAS unsigned char* lds, const Gemm g, const Sched& S, const Epi& E) {
    int tid = threadIdx.x; asm volatile("" : "+v"(tid));
    const int wid = __builtin_amdgcn_readfirstlane(tid >> 6), lane = tid & 63, wr = wid >> 2, wc = wid & 3, fr = lane & 15, fq = lane >> 4;
    const int nt = g.nt;
    unsigned voffA[2], voffB[2];
#pragma unroll
    for (int i = 0; i < 2; ++i) { int R, C; stage_rc(tid * 16 + i * 8192, R, C); const int Rb = Epi::PERM ? ((R & ~31) + perm32(R & 31)) : R;
        voffA[i] = (unsigned)(R * g.lda + C) * 2u; voffB[i] = (unsigned)(Rb * g.ldb + C) * 2u; }
    const size_t kstep = (size_t)(BK * 2);
    const size_t hstepA = (size_t)HALF * g.lda * 2, hstepB = (size_t)HALF * g.ldb * 2;
    const size_t tstepA = 2 * hstepA, tstepB = 2 * hstepB;
    const unsigned ldsw = (unsigned)wid * 1024u;
    const int aoff = lds_byte(wr * 64 + fr, fq * 8), boff = lds_byte(wc * 32 + fr, fq * 8);
#define PG8_SA(b, h) (((b) * 2 + (h)) * HTB)
#define PG8_SB(b, h) ((4 + (b) * 2 + (h)) * HTB)
#define PG8_STAGE(bufoff, gbase, voff) do { _Pragma("unroll") for (int _i = 0; _i < 2; ++_i) \
        __builtin_amdgcn_global_load_lds((const unsigned*)((const char*)(gbase) + (voff)[_i]), (LAS unsigned*)(lds + (bufoff) + ldsw + _i * 8192), 16, 0, 0); } while (0)
#define PG8_LDA(dst, b, h) do { _Pragma("unroll") for (int m = 0; m < 4; ++m) _Pragma("unroll") for (int k = 0; k < 2; ++k) dst[m][k] = *(const LAS bf16x8*)(lds + PG8_SA(b, h) + aoff + m * 2048 + k * 1024); } while (0)
#define PG8_LDB(dst, b, h) do { _Pragma("unroll") for (int n = 0; n < 2; ++n) _Pragma("unroll") for (int k = 0; k < 2; ++k) dst[n][k] = *(const LAS bf16x8*)(lds + PG8_SB(b, h) + boff + n * 2048 + k * 1024); } while (0)
#define PG8_MMA(ai, bj, At, Bt) do { __builtin_amdgcn_s_setprio(1); _Pragma("unroll") for (int m = 0; m < 4; ++m) _Pragma("unroll") for (int n = 0; n < 2; ++n) _Pragma("unroll") for (int k = 0; k < 2; ++k) \
        acc[ai][bj][m][n] = __builtin_amdgcn_mfma_f32_16x16x32_bf16(Bt[n][k], At[m][k], acc[ai][bj][m][n], 0, 0, 0); __builtin_amdgcn_s_setprio(0); } while (0)
#define PG8_WAIT_V(n) asm volatile("s_waitcnt vmcnt(" #n ")" ::: "memory")
#define PG8_WAIT_L(n) asm volatile("s_waitcnt lgkmcnt(" #n ")" ::: "memory")
#define PG8_BAR __builtin_amdgcn_s_barrier()
#define PG8_SCHED __builtin_amdgcn_sched_barrier(0)
    Unit cur, nxt; int ui = 0;
    if (!S.next(0, cur)) return;
    f32x4 acc[2][2][4][2];
#pragma unroll
    for (int a = 0; a < 2; ++a)
#pragma unroll
        for (int b = 0; b < 2; ++b)
#pragma unroll
            for (int m = 0; m < 4; ++m)
#pragma unroll
                for (int n = 0; n < 2; ++n) acc[a][b][m][n] = (f32x4){0.f, 0.f, 0.f, 0.f};
    bf16x8 At[4][2], B0[2][2], B1[2][2];
    const char* cA = (const char*)g.A + (size_t)cur.pm * tstepA + (size_t)cur.sub * g.ksubA * 2; const char* cB = (const char*)g.Bt + (size_t)cur.pn * tstepB + (size_t)cur.sub * g.ksubB * 2;
    E.prefetch(cur, lds, 0);
    PG8_STAGE(PG8_SB(0, 0), cB, voffB); PG8_STAGE(PG8_SB(0, 1), cB + hstepB, voffB); PG8_STAGE(PG8_SA(0, 0), cA, voffA); PG8_STAGE(PG8_SA(0, 1), cA + hstepA, voffA);
    if (wr == 1) PG8_BAR;
    PG8_WAIT_V(2); PG8_BAR;
    PG8_STAGE(PG8_SB(1, 0), cB + kstep, voffB); PG8_STAGE(PG8_SA(1, 0), cA + kstep, voffA); PG8_STAGE(PG8_SB(1, 1), cB + hstepB + kstep, voffB);
    PG8_WAIT_V(6); PG8_BAR;
    for (;;) {
        const bool has_next = S.next(ui + 1, nxt);
        const char* nA = has_next ? (const char*)g.A + (size_t)nxt.pm * tstepA + (size_t)nxt.sub * g.ksubA * 2 : cA;
        const char* nB = has_next ? (const char*)g.Bt + (size_t)nxt.pn * tstepB + (size_t)nxt.sub * g.ksubB * 2 : cB;
        for (int t = 0; t < nt; t += 2) {
            const bool last = (t == nt - 2);
            const char* a1 = cA + (size_t)(t + 1) * kstep;
            const char* a2 = last ? nA : cA + (size_t)(t + 2) * kstep; const char* b2 = last ? nB : cB + (size_t)(t + 2) * kstep;
            const char* a3 = a2 + kstep; const char* b3 = b2 + kstep;
            PG8_LDB(B0, 0, 0); PG8_LDB(B1, 0, 1); PG8_SCHED; PG8_LDA(At, 0, 0); PG8_STAGE(PG8_SA(1, 1), a1 + hstepA, voffA);
            PG8_WAIT_V(8); PG8_WAIT_L(0); PG8_BAR; PG8_MMA(0, 0, At, B0); PG8_MMA(0, 1, At, B1); PG8_BAR; PG8_SCHED;
            PG8_LDA(At, 0, 1); PG8_STAGE(PG8_SB(0, 0), b2, voffB); PG8_STAGE(PG8_SB(0, 1), b2 + hstepB, voffB); PG8_STAGE(PG8_SA(0, 0), a2, voffA);
            PG8_WAIT_V(8); PG8_WAIT_L(0); PG8_BAR; PG8_MMA(1, 0, At, B0); PG8_MMA(1, 1, At, B1); PG8_BAR; PG8_SCHED;
            PG8_LDB(B0, 1, 0); PG8_LDB(B1, 1, 1); PG8_SCHED; PG8_LDA(At, 1, 0); PG8_STAGE(PG8_SA(0, 1), a2 + hstepA, voffA);
            PG8_WAIT_V(8); PG8_WAIT_L(0); PG8_BAR; PG8_MMA(0, 0, At, B0); PG8_MMA(0, 1, At, B1); PG8_BAR; PG8_SCHED;
            PG8_LDA(At, 1, 1); PG8_STAGE(PG8_SB(1, 0), b3, voffB); PG8_STAGE(PG8_SB(1, 1), b3 + hstepB, voffB); PG8_STAGE(PG8_SA(1, 0), a3, voffA);
            PG8_WAIT_V(8); PG8_WAIT_L(0); PG8_BAR; PG8_MMA(1, 0, At, B0); PG8_MMA(1, 1, At, B1); PG8_BAR; PG8_SCHED;
        }
        if (wr == 0) PG8_BAR;
        E(acc, cur, wr, wc, fr, fq, lds, ui & 1);
        if (!has_next) break;
        E.prefetch(nxt, lds, (ui + 1) & 1);
        if (!Epi::ACCUM || nxt.sub == 0) {
#pragma unroll
        for (int a = 0; a < 2; ++a)
#pragma unroll
            for (int b = 0; b < 2; ++b)
#pragma unroll
                for (int m = 0; m < 4; ++m)
#pragma unroll
                    for (int n = 0; n < 2; ++n) acc[a][b][m][n] = (f32x4){0.f, 0.f, 0.f, 0.f};
        }
        cur = nxt; cA = nA; cB = nB; ++ui;
        if (wr == 1) PG8_BAR;
    }
    PG8_WAIT_V(0);
    PG8_BAR;
#undef PG8_SA
#undef PG8_SB
#undef PG8_STAGE
#undef PG8_LDA
#undef PG8_LDB
#undef PG8_MMA
#undef PG8_WAIT_V
#undef PG8_WAIT_L
#undef PG8_BAR
#undef PG8_SCHED
}
}

struct Epi1 {
    static constexpr bool PERM = true, ACCUM = false;
    unsigned char* ws; const u64* ssq; const float* dt_bias;
    __device__ __forceinline__ void prefetch(const pg8::Unit& u, LAS unsigned char* lds, int slot) const {
        int t = threadIdx.x; asm volatile("" : "+v"(t));
        if (t < 256) ((LAS float*)(lds + 131072))[slot * 256 + t] = ssq_to_rstd(ssq[u.pm * 256 + t], 1.0f / 2048.0f, 1e-6f);
    }
    __device__ __forceinline__ void operator()(f32x4 (&acc)[2][2][4][2], const pg8::Unit& u, int wr, int wc, int fr, int fq, LAS unsigned char* lds, int slot) const {
        const TileInfo ti = tile_info(u.pn);
        { const int ln = fresh_lane(); fr = ln & 15; fq = ln >> 4; }
        const int row0 = u.pm * 256 + wr * 64 + fr;
        float rs[2][4];
#pragma unroll
        for (int ai = 0; ai < 2; ++ai)
#pragma unroll
            for (int m = 0; m < 4; ++m) rs[ai][m] = ((const LAS float*)(lds + 131072))[slot * 256 + wr * 64 + fr + ai * 128 + m * 16];
        const int cl = wc * 32 + 8 * fq;
        if (ti.mode == M_SIGR) {
            bf16* base = (bf16*)(ws + ti.dst) + ti.col0 + wc * 16 + 4 * fq;
#pragma unroll
            for (int ai = 0; ai < 2; ++ai)
#pragma unroll
                for (int m = 0; m < 4; ++m) { bf16* rowp = base + (size_t)(row0 + ai * 128 + m * 16) * 8192; const float r = rs[ai][m];
                    float e1[4][4];
#pragma unroll
                    for (int b = 0; b < 4; ++b)
#pragma unroll
                        for (int j = 0; j < 4; ++j) e1[b][j] = 1.0f + fminf(__expf(-(acc[ai][b >> 1][m][b & 1][j] * r)), 1e12f);
#pragma unroll
                    for (int b = 0; b < 4; ++b) { float v[4];
#pragma unroll
                        for (int j = 0; j < 4; ++j) { const float gb = __builtin_amdgcn_rcpf(e1[b][j]); v[j] = b < 3 ? gb * e1[b < 3 ? b + 1 : 3][j] : gb; }
                        u32x2 w; w.x = pk2(v[0], v[1]); w.y = pk2(v[2], v[3]);
                        *(u32x2*)(rowp + b * 2048) = w; } }
        } else if (ti.mode <= M_SIG) {
            bf16* base = (bf16*)(ws + ti.dst) + ti.col0 + cl;
#pragma unroll
            for (int ai = 0; ai < 2; ++ai)
#pragma unroll
                for (int m = 0; m < 4; ++m) { bf16* rowp = base + (size_t)(row0 + ai * 128 + m * 16) * ti.ld; const float r = rs[ai][m];
#pragma unroll
                    for (int bj = 0; bj < 2; ++bj) { float v[8];
#pragma unroll
                        for (int j = 0; j < 4; ++j) { v[j] = acc[ai][bj][m][0][j] * r; v[4 + j] = acc[ai][bj][m][1][j] * r; }
                        if (ti.mode == M_SILU) {
#pragma unroll
                            for (int j = 0; j < 8; ++j) v[j] = fsilu(v[j]); }
                        else if (ti.mode == M_SIG) {
#pragma unroll
                            for (int j = 0; j < 8; ++j) v[j] = fsigmoid(v[j]); }
                        u32x4 w; w.x = pk2(v[0], v[1]); w.y = pk2(v[2], v[3]); w.z = pk2(v[4], v[5]); w.w = pk2(v[6], v[7]);
                        *(u32x4*)(rowp + bj * 128) = w; } }
        } else if (ti.mode != M_DT) {
            bf16* base = (bf16*)(ws + ti.dst) + ti.col0 + cl;
#pragma unroll
            for (int ai = 0; ai < 2; ++ai)
#pragma unroll
                for (int m = 0; m < 4; ++m) { bf16* rowp = base + (size_t)(row0 + ai * 128 + m * 16) * ti.ld; const float r = rs[ai][m]; float v[8];
#pragma unroll
                    for (int j = 0; j < 8; ++j) { const float a = acc[ai][0][m][j >> 2][j & 3] * r, b = acc[ai][1][m][j >> 2][j & 3] * r;
                        v[j] = ti.mode == M_GLU ? a * fsigmoid(b) : (ti.mode == M_MUL ? a * b : a * fsilu(b)); }
                    u32x4 w; w.x = pk2(v[0], v[1]); w.y = pk2(v[2], v[3]); w.z = pk2(v[4], v[5]); w.w = pk2(v[6], v[7]);
                    *(u32x4*)rowp = w; }
        } else {
            if (wc == 0 && fq < 2) {
                float* base = (float*)(ws + ti.dst) + 8 * fq;
                const f32x4 b0 = *(const f32x4*)(dt_bias + 8 * fq), b1 = *(const f32x4*)(dt_bias + 8 * fq + 4);
#pragma unroll
                for (int ai = 0; ai < 2; ++ai)
#pragma unroll
                    for (int m = 0; m < 4; ++m) { float* rowp = base + (size_t)(row0 + ai * 128 + m * 16) * 16; const float r = rs[ai][m]; f32x4 o0, o1;
#pragma unroll
                        for (int j = 0; j < 4; ++j) { o0[j] = fsoftplus(acc[ai][0][m][0][j] * r + b0[j]); o1[j] = fsoftplus(acc[ai][0][m][1][j] * r + b1[j]); }
                        *(f32x4*)rowp = o0; *(f32x4*)(rowp + 4) = o1; }
            }
        }
    }
};

struct Args { const float* in[28]; float* out; unsigned char* ws; int ph_lo, ph_hi; };
enum { I_XP = 0, I_XS, I_SSM, I_CSSM, I_CCF, I_CSC, I_CK, I_CVV, I_NORMW, I_WIN, I_SCONVW, I_SCONVB, I_DTB, I_ALOG, I_DSKIP, I_SNORMW, I_WOSSM,
       I_CFCW, I_CFCB, I_CFLNW, I_CFLNB, I_WOCF, I_SCCW, I_WOSC, I_SINK, I_WOATT, I_WO, I_FNW };
#define GAS __attribute__((address_space(1)))
__device__ __forceinline__ const float* inp(const Args& a, int i) { asm volatile("" : "+s"(i)); const GAS float* q = (const GAS float*)a.in[i]; asm volatile("" : "+s"(q)); return (const float*)q; }
__device__ __forceinline__ unsigned char* wsp(const Args& a) { GAS unsigned char* w = (GAS unsigned char*)a.ws; asm volatile("" : "+s"(w)); return (unsigned char*)w; }
__device__ __forceinline__ float* outp(const Args& a) { GAS float* w = (GAS float*)a.out; asm volatile("" : "+s"(w)); return (float*)w; }

struct TrP { const float* W; size_t ldw; int src, valid; const float* ks; int k0; bf16* dst; size_t ldk; int dk0; int gm; };
__device__ __forceinline__ void tr_load(const TrP& P, int lane, f32x4 (&v)[16]) {
    const int q = lane & 15, n4 = q * 4, kq = lane >> 4;
    const int scol = P.src + (P.gm ? (q & 1) * 2048 + (q >> 3) * 16 + ((q >> 1) & 3) * 4 : n4);
#pragma unroll
    for (int i = 0; i < 16; ++i) v[i] = (n4 < P.valid) ? __builtin_nontemporal_load((const f32x4*)(P.W + (size_t)(P.k0 + 4 * i + kq) * P.ldw + scol)) : (f32x4){0.f, 0.f, 0.f, 0.f};
}
__device__ __forceinline__ void tr_finish(const TrP& P, const f32x4 (&v)[16], LAS float* scr, int lane) {
    const int n4 = (lane & 15) * 4, kq = lane >> 4;
#pragma unroll
    for (int i = 0; i < 16; ++i) { const int kk = 4 * i + kq; const float sc = P.ks ? P.ks[P.k0 + kk] : 1.f; LAS float* d = scr + kk * 65 + n4;
        d[0] = v[i].x * sc; d[1] = v[i].y * sc; d[2] = v[i].z * sc; d[3] = v[i].w * sc; }
    LDS_WAIT(); asm volatile("" ::: "memory");
    const int c = lane & 7;
#pragma unroll
    for (int j = 0; j < 8; ++j) { const int n = (lane >> 3) + 8 * j; const LAS float* sp = scr + (8 * c) * 65 + n;
        u32x4 o; o.x = pk2(sp[0 * 65], sp[1 * 65]); o.y = pk2(sp[2 * 65], sp[3 * 65]); o.z = pk2(sp[4 * 65], sp[5 * 65]); o.w = pk2(sp[6 * 65], sp[7 * 65]);
        *(u32x4*)(P.dst + (size_t)n * P.ldk + P.dk0 + P.k0 + 8 * c) = o; }
    LDS_WAIT(); asm volatile("" ::: "memory");
}
__device__ __forceinline__ float wave_sum(float v) {
    v = red16_sum(v);
    return (rl_f(v, 0) + rl_f(v, 16)) + (rl_f(v, 32) + rl_f(v, 48));
}
__device__ __forceinline__ float wave_max(float v) { v = red16_max(v); return fmaxf(fmaxf(rl_f(v, 0), rl_f(v, 16)), fmaxf(rl_f(v, 32), rl_f(v, 48))); }

__device__ __forceinline__ void phase_prologue(const Args& a, LAS unsigned char* lds, int gw, int ngw, int wave, int lane, int l_lo, int l_hi, bool do_x, int i0, int i1) {
    LAS float* scr = (LAS float*)(lds + wave * 16640);
    constexpr int I1 = (DM / 64) * (N1 / 64), I2 = 4 * (1024 / 64) * (DM / 64), I3 = (DM / 64) * (DM / 64), IL = I1 + I2 + I3;
    auto decode = [&](int it) -> TrP {
        const int l = l_lo + it / IL; int r = it % IL; TrP P;
        if (r < I1) {
            const int nb = r % (N1 / 64), kb = r / (N1 / 64), pn = nb >> 2, sb = nb & 3, half = sb >> 1;
            const TileInfo ti = tile_info(pn);
            int valid = (half ? ti.valid1 : ti.valid0) - (sb & 1) * 64; valid = valid < 0 ? 0 : (valid > 64 ? 64 : valid);
            P.W = inp(a, I_WIN) + (size_t)l * DM * IN_COLS; P.ldw = IN_COLS; P.gm = ti.mode == M_SIGR; P.src = (half ? ti.src1 : ti.src0) + (sb & 1) * (P.gm ? 32 : 64); P.valid = valid; P.ks = inp(a, I_NORMW) + l * DM; P.k0 = kb * 64;
            P.dst = (bf16*)(wsp(a) + WS_W1T + l * W1T_L) + (size_t)(nb * 64) * DM; P.ldk = DM; P.dk0 = 0; return P; }
        r -= I1;
        if (r < I2) {
            const int br = r / (I2 / 4), rr = r % (I2 / 4), nb = rr % (DM / 64), kb = rr / (DM / 64);
            P.W = inp(a, br == 0 ? I_WOSSM : (br == 1 ? I_WOCF : (br == 2 ? I_WOSC : I_WOATT))) + (size_t)l * 1024 * DM; P.ldw = DM; P.src = nb * 64; P.valid = 64; P.gm = 0;
            P.ks = br == 0 ? inp(a, I_SNORMW) + l * 1024 : nullptr; P.k0 = kb * 64;
            P.dst = (bf16*)(wsp(a) + WS_W2T + l * W2T_L) + (size_t)(nb * 64) * 4096; P.ldk = 4096; P.dk0 = br * 1024; return P; }
        r -= I2;
        { const int nb = r % (DM / 64), kb = r / (DM / 64);
          P.W = inp(a, I_WO) + (size_t)l * DM * DM; P.ldw = DM; P.src = nb * 64; P.valid = 64; P.gm = 0; P.ks = nullptr; P.k0 = kb * 64;
          P.dst = (bf16*)(wsp(a) + WS_W3T + l * W3T_L) + (size_t)(nb * 64) * DM; P.ldk = DM; P.dk0 = 0; return P; }
    };
    {
        const int nit = i1 < 0 ? (l_hi - l_lo) * IL : i1;
        if (i0 + gw < nit) {
            TrP cur = decode(i0 + gw); f32x4 v[16]; tr_load(cur, lane, v);
#pragma unroll 1
            for (int it = i0 + gw; ; ) {
                const int nx = it + ngw; const bool more = nx < nit;
                TrP nxt = cur; f32x4 vn[16];
                if (more) { nxt = decode(nx); tr_load(nxt, lane, vn); }
                tr_finish(cur, v, scr, lane);
                if (!more) break;
                cur = nxt; it = nx;
#pragma unroll
                for (int i = 0; i < 16; ++i) v[i] = vn[i];
            }
        }
    }
    if (!do_x) return;
    for (int m = gw; m < TT; m += ngw) {
        const float* xr = (m < TP) ? inp(a, I_XP) + (size_t)m * DM : inp(a, I_XS) + (size_t)(m - TP) * DM;
        const f32x4* x4 = (const f32x4*)xr + lane; u64* o8 = (u64*)((bf16*)(wsp(a) + WS_XB) + (size_t)m * DM) + lane; float s = 0.f;
#pragma unroll
        for (int j = 0; j < 8; ++j) { const f32x4 v = __builtin_nontemporal_load(x4 + 64 * j); s += (v.x * v.x + v.y * v.y) + (v.z * v.z + v.w * v.w); o8[64 * j] = (u64)pk2(v.x, v.y) | ((u64)pk2(v.z, v.w) << 32); }
        s = wave_sum(s);
        if (lane == 0) ((u64*)(wsp(a) + WS_SSQ))[m] = ssq_fix(s);
    }
    for (int i = gw * 64 + lane; i < 2 * TT; i += ngw * 64) { ((u64*)(wsp(a) + WS_SSQ))[TT + i] = 0ull; ((u64*)(wsp(a) + WS_SSQA))[i] = 0ull; }
}


constexpr size_t O_YP = 0, O_YS = 16777216, O_PSSM = 18874368, O_PCSSM = 19922944, O_PCCF = 19972096, O_PCSC = 20217856, O_PK = 20234240, O_PV = 20496384,
                 O_SSSM = 20758528, O_SCSSM = 54312960, O_SCCF = 55885824, O_SCSC = 63750144, O_SK = 64274432, O_SV = 72663040, O_TOTAL = 81051648;

template <bool SAMPLE>
__device__ __forceinline__ void conv_item(const Args& a, int l, int item, LAS unsigned char* lds, int tid, int wave, int lane) {
    asm volatile("" : "+v"(tid), "+v"(lane), "+s"(wave), "+s"(item));
    constexpr int NT = SAMPLE ? 8 : 16;
    int b, row0, t0;
    if (SAMPLE) { b = item; t0 = 0; row0 = TP + 8 * b; } else { b = item >> 7; t0 = (item & 127) * 16; row0 = b * PSEQ + t0; }
    const bf16* U = (const bf16*)(wsp(a) + WS_U); const bf16* CV = (const bf16*)(wsp(a) + WS_CV); const bf16* CM = (const bf16*)(wsp(a) + WS_CM);
    const bf16* CFG = (const bf16*)(wsp(a) + WS_CFG); const bf16* XBC = (const bf16*)(wsp(a) + WS_XBC); bf16* ACT = (bf16*)(wsp(a) + WS_ACT);
    const int c0 = 2 * tid;
    __syncthreads();
    {
        f32x2 wk[31];
        const float* cw = inp(a, I_CFCW) + (size_t)l * 31 * 1024 + c0;
#pragma unroll
        for (int k = 0; k < 31; ++k) wk[k] = *(const f32x2*)(cw + k * 1024);
        const f32x2 bias = *(const f32x2*)(inp(a, I_CFCB) + l * 1024 + c0);
        float acc0[NT], acc1[NT];
#pragma unroll
        for (int t = 0; t < NT; ++t) { acc0[t] = bias.x; acc1[t] = bias.y; }
        unsigned inw[NT + 30]; f32x2 pre[SAMPLE ? 30 : 1];
        if (SAMPLE) {
#pragma unroll
            for (int r = 0; r < 30; ++r) pre[r] = __builtin_nontemporal_load((const f32x2*)(inp(a, I_CCF) + (((size_t)l * SB + b) * 30 + r) * 1024 + c0));
#pragma unroll
            for (int r = 0; r < NT; ++r) inw[30 + r] = *(const unsigned*)(U + (size_t)(row0 + r) * 1024 + c0);
            float* o_cf = outp(a) + O_SCCF + ((size_t)l * SB + b) * 30 * 1024 + c0;
#pragma unroll
            for (int rr = 0; rr < 22; ++rr) __builtin_nontemporal_store(pre[rr + 8], (f32x2*)(o_cf + (size_t)rr * 1024));
#pragma unroll
            for (int rr = 0; rr < 8; ++rr) __builtin_nontemporal_store((f32x2){bf2f(inw[30 + rr] & 0xffffu), bf2f(inw[30 + rr] >> 16)}, (f32x2*)(o_cf + (size_t)(22 + rr) * 1024));
        } else {
#pragma unroll
            for (int i = 0; i < 12; ++i) { const int p = wave + 8 * i; if (p < 92) { const int rowi = p >> 1, half = p & 1;
                if (t0 + rowi - 30 >= 0) __builtin_amdgcn_global_load_lds((const unsigned*)(U + (size_t)(row0 + rowi - 30) * 1024 + half * 512 + lane * 8), (LAS unsigned*)(lds + rowi * 2048 + half * 1024), 16, 0, 0); } }
            asm volatile("s_waitcnt vmcnt(0)" ::: "memory"); __syncthreads(); asm volatile("" ::: "memory");
#pragma unroll
            for (int r = 0; r < NT + 30; ++r) { const unsigned w = *(const LAS unsigned*)(lds + r * 2048 + c0 * 2); inw[r] = (t0 + r - 30 < 0) ? 0u : w; }
        }
#pragma unroll
        for (int r = -30; r < NT; ++r) {
            float v0, v1;
            if (SAMPLE && r < 0) { v0 = pre[r + 30].x; v1 = pre[r + 30].y; }
            else { const unsigned w = inw[r + 30]; v0 = bf2f(w & 0xffffu); v1 = bf2f(w >> 16); }
#pragma unroll
            for (int t = 0; t < NT; ++t) { const int k = r - t + 30; if (k >= 0 && k <= 30) { acc0[t] += wk[k].x * v0; acc1[t] += wk[k].y * v1; } }
        }
        if (!SAMPLE) __syncthreads();
        LAS float* tile = (LAS float*)lds;
#pragma unroll
        for (int t = 0; t < NT; ++t) *(LAS f32x2*)(tile + t * 1024 + c0) = (f32x2){acc0[t], acc1[t]};
    }
    f32x4 lw[4], lb[4]; u32x2 gwv[NT / 8][4];
#pragma unroll
    for (int j = 0; j < 4; ++j) { const int c = 256 * j + 4 * lane; lw[j] = *(const f32x4*)(inp(a, I_CFLNW) + l * 1024 + c); lb[j] = *(const f32x4*)(inp(a, I_CFLNB) + l * 1024 + c);
#pragma unroll
        for (int tt = 0; tt < NT / 8; ++tt) gwv[tt][j] = *(const u32x2*)(CFG + (size_t)(row0 + wave + 8 * tt) * 1024 + c); }
    f32x2 w3[3]; f32x2 in[NT + 2]; unsigned inr[NT + 2], mwv[NT];
#pragma unroll
    for (int k = 0; k < 3; ++k) w3[k] = *(const f32x2*)(inp(a, I_SCCW) + (size_t)l * 3 * 1024 + k * 1024 + c0);
#pragma unroll
    for (int r = -2; r < NT; ++r) {
        if (SAMPLE && r < 0) in[r + 2] = *(const f32x2*)(inp(a, I_CSC) + (((size_t)l * SB + b) * 2 + (2 + r)) * 1024 + c0);
        else { const int rr = (!SAMPLE && t0 + r < 0) ? 0 : r; inr[r + 2] = *(const unsigned*)(CV + (size_t)(row0 + rr) * 1024 + c0); } }
#pragma unroll
    for (int t = 0; t < NT; ++t) mwv[t] = *(const unsigned*)(CM + (size_t)(row0 + t) * 1024 + c0);
    __syncthreads();
    {
        LAS float* tile = (LAS float*)lds;
#pragma unroll
        for (int tt = 0; tt < NT / 8; ++tt) {
            const int t = wave + 8 * tt; const int row = row0 + t;
            f32x4 x[4]; float s = 0.f;
#pragma unroll
            for (int j = 0; j < 4; ++j) { x[j] = *(LAS f32x4*)(tile + t * 1024 + 256 * j + 4 * lane); s += (x[j].x + x[j].y) + (x[j].z + x[j].w); }
            const float mean = wave_sum(s) * (1.f / 1024.f); float q = 0.f;
#pragma unroll
            for (int j = 0; j < 4; ++j) { x[j] = x[j] - mean; q += (x[j].x * x[j].x + x[j].y * x[j].y) + (x[j].z * x[j].z + x[j].w * x[j].w); }
            const float rstd = rsqrtf(wave_sum(q) * (1.f / 1024.f) + 1e-5f);
#pragma unroll
            for (int j = 0; j < 4; ++j) { const int c = 256 * j + 4 * lane; const u32x2 gw = gwv[tt][j];
                float y[4];
#pragma unroll
                for (int e = 0; e < 4; ++e) y[e] = fsilu(x[j][e] * rstd * lw[j][e] + lb[j][e]);
                y[0] *= bf2f(gw.x & 0xffffu); y[1] *= bf2f(gw.x >> 16); y[2] *= bf2f(gw.y & 0xffffu); y[3] *= bf2f(gw.y >> 16);
                u32x2 o; o.x = pk2(y[0], y[1]); o.y = pk2(y[2], y[3]);
                *(u32x2*)(ACT + (size_t)row * 4096 + 1024 + c) = o; }
        }
    }
    {
#pragma unroll
        for (int r = -2; r < NT; ++r) if (!(SAMPLE && r < 0)) { const unsigned w = inr[r + 2]; in[r + 2] = (!SAMPLE && t0 + r < 0) ? (f32x2){0.f, 0.f} : (f32x2){bf2f(w & 0xffffu), bf2f(w >> 16)}; }
#pragma unroll
        for (int t = 0; t < NT; ++t) {
            const unsigned mw = mwv[t];
            const float y0 = (w3[0].x * in[t].x + w3[1].x * in[t + 1].x + w3[2].x * in[t + 2].x) * bf2f(mw & 0xffffu);
            const float y1 = (w3[0].y * in[t].y + w3[1].y * in[t + 1].y + w3[2].y * in[t + 2].y) * bf2f(mw >> 16);
            *(unsigned*)(ACT + (size_t)(row0 + t) * 4096 + 2048 + c0) = pk2(y0, y1);
        }
    }
    if (SAMPLE) {
        float* o_sc = outp(a) + O_SCSC + ((size_t)l * SB + b) * 2 * 1024 + c0;
        float* o_ss = outp(a) + O_SCSSM + ((size_t)l * SB + b) * 3 * 2048 + 4 * tid;
        {   unsigned w[2]; u32x2 x[3];
#pragma unroll
            for (int rr = 0; rr < 2; ++rr) w[rr] = *(const unsigned*)(CV + (size_t)(row0 + 6 + rr) * 1024 + c0);
#pragma unroll
            for (int rr = 0; rr < 3; ++rr) x[rr] = *(const u32x2*)(XBC + (size_t)(row0 + 5 + rr) * 2048 + 4 * tid);
#pragma unroll
            for (int rr = 0; rr < 2; ++rr) *(f32x2*)(o_sc + rr * 1024) = (f32x2){bf2f(w[rr] & 0xffffu), bf2f(w[rr] >> 16)};
#pragma unroll
            for (int rr = 0; rr < 3; ++rr) *(f32x4*)(o_ss + rr * 2048) = (f32x4){bf2f(x[rr].x & 0xffffu), bf2f(x[rr].x >> 16), bf2f(x[rr].y & 0xffffu), bf2f(x[rr].y >> 16)}; }
    } else if ((item & 127) == 127) {
        const int rb = b * PSEQ;
        float* o_cf = outp(a) + O_PCCF + ((size_t)l * PB + b) * 30 * 1024 + c0;
        {   unsigned w[30];
#pragma unroll
            for (int rr = 0; rr < 30; ++rr) w[rr] = *(const unsigned*)(U + (size_t)(rb + 2018 + rr) * 1024 + c0);
#pragma unroll
            for (int rr = 0; rr < 30; ++rr) *(f32x2*)(o_cf + (size_t)rr * 1024) = (f32x2){bf2f(w[rr] & 0xffffu), bf2f(w[rr] >> 16)}; }
        float* o_sc = outp(a) + O_PCSC + ((size_t)l * PB + b) * 2 * 1024 + c0;
        float* o_ss = outp(a) + O_PCSSM + ((size_t)l * PB + b) * 3 * 2048 + 4 * tid;
        {   unsigned w[2]; u32x2 x[3];
#pragma unroll
            for (int rr = 0; rr < 2; ++rr) w[rr] = *(const unsigned*)(CV + (size_t)(rb + 2046 + rr) * 1024 + c0);
#pragma unroll
            for (int rr = 0; rr < 3; ++rr) x[rr] = *(const u32x2*)(XBC + (size_t)(rb + 2045 + rr) * 2048 + 4 * tid);
#pragma unroll
            for (int rr = 0; rr < 2; ++rr) *(f32x2*)(o_sc + rr * 1024) = (f32x2){bf2f(w[rr] & 0xffffu), bf2f(w[rr] >> 16)};
#pragma unroll
            for (int rr = 0; rr < 3; ++rr) *(f32x4*)(o_ss + rr * 2048) = (f32x4){bf2f(x[rr].x & 0xffffu), bf2f(x[rr].x >> 16), bf2f(x[rr].y & 0xffffu), bf2f(x[rr].y >> 16)}; }
        const bf16* KV = (const bf16*)(wsp(a) + WS_KV);
        {   u32x4 w[16];
#pragma unroll
            for (int i = 0; i < 16; ++i) { const int id = tid + 512 * i, jj = id >> 6, c8 = (id & 63) * 8; w[i] = *(const u32x4*)(KV + (size_t)(rb + 1920 + jj) * 512 + c8); }
#pragma unroll
            for (int i = 0; i < 16; ++i) { const int id = tid + 512 * i, jj = id >> 6, c8 = (id & 63) * 8;
                float* o = outp(a) + (c8 < 256 ? O_PK : O_PV) + (((size_t)l * PB + b) * 128 + jj) * 256 + (c8 & 255);
                *(f32x4*)o = (f32x4){bf2f(w[i].x & 0xffffu), bf2f(w[i].x >> 16), bf2f(w[i].y & 0xffffu), bf2f(w[i].y >> 16)};
                *(f32x4*)(o + 4) = (f32x4){bf2f(w[i].z & 0xffffu), bf2f(w[i].z >> 16), bf2f(w[i].w & 0xffffu), bf2f(w[i].w >> 16)}; } }
    }
}

__device__ __forceinline__ float incl_scan64(float v, int lane) {
    v += dpp_f<0x111>(v); v += dpp_f<0x112>(v); v += dpp_f<0x114>(v); v += dpp_f<0x118>(v);
    const float t0 = rl_f(v, 15), t1 = rl_f(v, 31), t2 = rl_f(v, 47); const int row = lane >> 4;
    return v + (row == 0 ? 0.f : (row == 1 ? t0 : (row == 2 ? t0 + t1 : t0 + t1 + t2)));
}
template <int MODE>
__device__ __forceinline__ void ssd_cs(const Args& a, int l, int g, int r0, LAS float* csb, LAS float* dtb, LAS float* auxb, float* cdec, int wave, int lane) {
    if (wave < 4) {
        const int h = 4 * g + wave; const float A = -__expf(inp(a, I_ALOG)[l * HEADS + h]);
        const float* DT = (const float*)(wsp(a) + WS_DT);
        const float d0 = DT[(size_t)(r0 + lane) * 16 + h], d1 = DT[(size_t)(r0 + 64 + lane) * 16 + h];
        const float s0 = incl_scan64(d0 * A, lane); const float tot0 = __shfl(s0, 63);
        const float s1 = incl_scan64(d1 * A, lane) + tot0; const float last = __shfl(s1, 63);
        csb[wave * 128 + lane] = s0; csb[wave * 128 + 64 + lane] = s1; dtb[wave * 128 + lane] = d0; dtb[wave * 128 + 64 + lane] = d1;
        if (MODE == 0) { auxb[wave * 128 + lane] = d0 * __expf(last - s0); auxb[wave * 128 + 64 + lane] = d1 * __expf(last - s1); if (lane == 0) cdec[h] = __expf(last); }
        else { auxb[wave * 128 + lane] = __expf(s0); auxb[wave * 128 + 64 + lane] = __expf(s1); }
    }
}
struct ConvIn { u32x2 raw[11]; f32x4 w[4]; f32x4 bias; };
__device__ __forceinline__ void xbc_conv_load(const Args& a, int l, int r0, bool first_chunk, int l0, int col, ConvIn& ci) {
    const bf16* XBC = (const bf16*)(wsp(a) + WS_XBC);
#pragma unroll
    for (int rr = 0; rr < 11; ++rr) { const int tok = l0 - 3 + rr; const int tk = (first_chunk && tok < 0) ? 0 : tok; ci.raw[rr] = *(const u32x2*)(XBC + (size_t)(r0 + tk) * XBC_W + col); }
#pragma unroll
    for (int k = 0; k < 4; ++k) ci.w[k] = *(const f32x4*)(inp(a, I_SCONVW) + (size_t)l * 4 * XBC_W + k * XBC_W + col);
    ci.bias = *(const f32x4*)(inp(a, I_SCONVB) + l * XBC_W + col);
}
__device__ __forceinline__ void xbc_conv_compute(const ConvIn& ci, bool first_chunk, int l0, float (&o)[8][4]) {
    float in[11][4];
#pragma unroll
    for (int rr = 0; rr < 11; ++rr) { const bool z = first_chunk && (l0 - 3 + rr < 0); const u32x2 v = ci.raw[rr];
        in[rr][0] = z ? 0.f : bf2f(v.x & 0xffffu); in[rr][1] = z ? 0.f : bf2f(v.x >> 16); in[rr][2] = z ? 0.f : bf2f(v.y & 0xffffu); in[rr][3] = z ? 0.f : bf2f(v.y >> 16); }
#pragma unroll
    for (int i = 0; i < 8; ++i)
#pragma unroll
        for (int j = 0; j < 4; ++j) { float sacc = ci.bias[j];
#pragma unroll
            for (int k = 0; k < 4; ++k) sacc += ci.w[k][j] * in[i + k][j];
            o[i][j] = fsilu(sacc); }
}
constexpr int LP = 136;

__device__ __forceinline__ void ssd1_item(const Args& a, int l, int item, LAS unsigned char* lds, int tid, int wave, int lane) {
    asm volatile("" : "+v"(tid), "+v"(lane), "+s"(wave), "+s"(item));
    const int b = item >> 6, c = (item >> 2) & 15, g = item & 3; const int r0 = b * PSEQ + c * CHUNK;
    LAS float* csb = (LAS float*)lds; LAS float* w1b = csb + 512; LAS float* dtb = csb + 1024;
    LAS bf16* xwT = (LAS bf16*)(lds + 8192); LAS bf16* BT = xwT + 4 * 64 * LP;
    __syncthreads();
    {
        ConvIn c0_, c1_, c2_;
        const int tgA = tid >> 6, qA = tid & 63, tgB = (tid + 512) >> 6, qB = (tid + 512) & 63, tgC = tid >> 5, qC = tid & 31;
        xbc_conv_load(a, l, r0, c == 0, 8 * tgA, g * 256 + 4 * qA, c0_);
        xbc_conv_load(a, l, r0, c == 0, 8 * tgB, g * 256 + 4 * qB, c1_);
        xbc_conv_load(a, l, r0, c == 0, 8 * tgC, 1024 + g * 128 + 4 * qC, c2_);
        ssd_cs<0>(a, l, g, r0, csb, dtb, w1b, (float*)(wsp(a) + WS_CDEC) + (b * NCH + c) * HEADS, wave, lane);
        __syncthreads();
#pragma unroll
        for (int ti = 0; ti < 2; ++ti) { float o[8][4]; const int tg = ti ? tgB : tgA, q = ti ? qB : qA, hh = q >> 4, l0 = 8 * tg;
            xbc_conv_compute(ti ? c1_ : c0_, c == 0, l0, o);
#pragma unroll
            for (int j = 0; j < 4; ++j) { float v[8];
#pragma unroll
                for (int i = 0; i < 8; ++i) v[i] = o[i][j] * w1b[hh * 128 + l0 + i];
                u32x4 w; w.x = pk2(v[0], v[1]); w.y = pk2(v[2], v[3]); w.z = pk2(v[4], v[5]); w.w = pk2(v[6], v[7]);
                *(LAS u32x4*)(xwT + (hh * 64 + 4 * (q & 15) + j) * LP + l0) = w; } }
        { float o[8][4]; const int l0 = 8 * tgC;
            xbc_conv_compute(c2_, c == 0, l0, o);
#pragma unroll
            for (int j = 0; j < 4; ++j) { u32x4 w; w.x = pk2(o[0][j], o[1][j]); w.y = pk2(o[2][j], o[3][j]); w.z = pk2(o[4][j], o[5][j]); w.w = pk2(o[6][j], o[7][j]);
                *(LAS u32x4*)(BT + (4 * qC + j) * LP + l0) = w; } }
    }
    __syncthreads();
    {
        const int hh = wave >> 1, ph = wave & 1, fr = lane & 15, fq = lane >> 4;
        f32x4 acc[2][8];
#pragma unroll
        for (int i = 0; i < 2; ++i)
#pragma unroll
            for (int n = 0; n < 8; ++n) acc[i][n] = (f32x4){0.f, 0.f, 0.f, 0.f};
#pragma unroll
        for (int kk = 0; kk < 4; ++kk) {
            bf16x8 af[2];
#pragma unroll
            for (int i = 0; i < 2; ++i) af[i] = *(const LAS bf16x8*)(xwT + (hh * 64 + ph * 32 + i * 16 + fr) * LP + kk * 32 + 8 * fq);
#pragma unroll
            for (int n = 0; n < 8; ++n) { const bf16x8 bfr = *(const LAS bf16x8*)(BT + (n * 16 + fr) * LP + kk * 32 + 8 * fq);
#pragma unroll
                for (int i = 0; i < 2; ++i) acc[i][n] = __builtin_amdgcn_mfma_f32_16x16x32_bf16(af[i], bfr, acc[i][n], 0, 0, 0); }
        }
        float* cst = (float*)(wsp(a) + WS_CST) + ((size_t)((b * NCH + c) * HEADS + 4 * g + hh)) * (HD * NST);
#pragma unroll
        for (int i = 0; i < 2; ++i)
#pragma unroll
            for (int n = 0; n < 8; ++n)
#pragma unroll
                for (int r = 0; r < 4; ++r) cst[(size_t)(ph * 32 + i * 16 + 4 * fq + r) * NST + n * 16 + fr] = acc[i][n][r];
    }
}

__device__ __forceinline__ void ssd_scan_phase(const Args& a, int l, int gthread, int nthreads) {
    const float* CST = (const float*)(wsp(a) + WS_CST); const float* CDEC = (const float*)(wsp(a) + WS_CDEC); bf16* HP = (bf16*)(wsp(a) + WS_HPREV);
    for (int idx = gthread; idx < PB * HEADS * 2048; idx += nthreads) {
        const int b = idx / (HEADS * 2048), h = (idx / 2048) % HEADS, e4 = idx % 2048;
        f32x4 H = (f32x4){0.f, 0.f, 0.f, 0.f};
#pragma unroll 1
        for (int c0 = 0; c0 < NCH; c0 += 8) {
            f32x4 sv[8]; float dv[8];
#pragma unroll
            for (int c = 0; c < 8; ++c) { sv[c] = *(const f32x4*)(CST + ((size_t)((b * NCH + c0 + c) * HEADS + h)) * (HD * NST) + 4 * e4); dv[c] = CDEC[(b * NCH + c0 + c) * HEADS + h]; }
#pragma unroll
            for (int c = 0; c < 8; ++c) { const size_t o = ((size_t)((b * NCH + c0 + c) * HEADS + h)) * (HD * NST) + 4 * e4;
                u32x2 w; w.x = pk2(H.x, H.y); w.y = pk2(H.z, H.w); *(u32x2*)(HP + o) = w;
                H = H * dv[c] + sv[c]; }
        }
        *(f32x4*)(outp(a) + O_PSSM + ((size_t)((l * PB + b) * HEADS + h)) * (HD * NST) + 4 * e4) = H;
    }
}

__device__ __forceinline__ void ssd2_item(const Args& a, int l, int item, LAS unsigned char* lds, int tid, int wave, int lane) {
    asm volatile("" : "+v"(tid), "+v"(lane), "+s"(wave), "+s"(item));
    const int b = item >> 6, c = (item >> 2) & 15, g = item & 3; const int r0 = b * PSEQ + c * CHUNK;
    LAS float* csb = (LAS float*)lds; LAS float* ecs = csb + 512; LAS float* dtb = csb + 1024;
    LAS bf16* Cimg = (LAS bf16*)(lds + 8192); LAS bf16* Bimg = Cimg + 128 * LP; LAS bf16* xT = Bimg + 128 * LP;
    const int fr = lane & 15, fq = lane >> 4;
    __syncthreads();
    {
        const int tgA = tid >> 6, qA = tid & 63, tgB = (tid + 512) >> 6, qB = (tid + 512) & 63, tgC = tid >> 5, qC = tid & 31;
        {   ConvIn c0_, c1_;
            xbc_conv_load(a, l, r0, c == 0, 8 * tgA, g * 256 + 4 * qA, c0_);
            xbc_conv_load(a, l, r0, c == 0, 8 * tgB, g * 256 + 4 * qB, c1_);
            ssd_cs<1>(a, l, g, r0, csb, dtb, ecs, nullptr, wave, lane);
#pragma unroll
            for (int ti = 0; ti < 2; ++ti) { float o[8][4]; const int tg = ti ? tgB : tgA, q = ti ? qB : qA, hh = q >> 4, l0 = 8 * tg;
                xbc_conv_compute(ti ? c1_ : c0_, c == 0, l0, o);
#pragma unroll
                for (int j = 0; j < 4; ++j) { u32x4 w; w.x = pk2(o[0][j], o[1][j]); w.y = pk2(o[2][j], o[3][j]); w.z = pk2(o[4][j], o[5][j]); w.w = pk2(o[6][j], o[7][j]);
                    *(LAS u32x4*)(xT + (hh * 64 + 4 * (q & 15) + j) * LP + l0) = w; } } }
        {   ConvIn c2_, c3_;
            xbc_conv_load(a, l, r0, c == 0, 8 * tgC, 1024 + g * 128 + 4 * qC, c2_);
            xbc_conv_load(a, l, r0, c == 0, 8 * tgC, 1536 + g * 128 + 4 * qC, c3_);
#pragma unroll
            for (int ti = 0; ti < 2; ++ti) { float o[8][4]; const int l0 = 8 * tgC; LAS bf16* img = ti == 0 ? Bimg : Cimg;
                xbc_conv_compute(ti ? c3_ : c2_, c == 0, l0, o);
#pragma unroll
                for (int i = 0; i < 8; ++i) { u32x2 w; w.x = pk2(o[i][0], o[i][1]); w.y = pk2(o[i][2], o[i][3]); *(LAS u32x2*)(img + (l0 + i) * LP + 4 * qC) = w; } } }
    }
    __syncthreads();
    bf16x8 cf[4];
#pragma unroll
    for (int kk = 0; kk < 4; ++kk) cf[kk] = *(const LAS bf16x8*)(Cimg + (16 * wave + fr) * LP + kk * 32 + 8 * fq);
    f32x4 cb[8];
#pragma unroll
    for (int st = 0; st < 8; ++st) { cb[st] = (f32x4){0.f, 0.f, 0.f, 0.f};
        if (st <= wave) {
#pragma unroll
            for (int kk = 0; kk < 4; ++kk) { const bf16x8 bfr = *(const LAS bf16x8*)(Bimg + (st * 16 + fr) * LP + kk * 32 + 8 * fq);
                cb[st] = __builtin_amdgcn_mfma_f32_16x16x32_bf16(cf[kk], bfr, cb[st], 0, 0, 0); } } }
    __syncthreads();
    LAS bf16* Mst = Bimg + wave * 16 * LP;
    const bf16* Zb = (const bf16*)(wsp(a) + WS_Z); bf16* ACT = (bf16*)(wsp(a) + WS_ACT);
    float ssq[4] = {0.f, 0.f, 0.f, 0.f};
#pragma unroll 1
    for (int hh = 0; hh < 4; ++hh) {
        const int h = 4 * g + hh;
        float csl[4];
#pragma unroll
        for (int r = 0; r < 4; ++r) csl[r] = csb[hh * 128 + 16 * wave + 4 * fq + r];
        const bf16* hp = (const bf16*)(wsp(a) + WS_HPREV) + ((size_t)((b * NCH + c) * HEADS + h)) * (HD * NST);
        bf16x8 hf[4][4]; u32x4 zw[2];
#pragma unroll
        for (int pt = 0; pt < 4; ++pt)
#pragma unroll
            for (int kk = 0; kk < 4; ++kk) hf[pt][kk] = *(const bf16x8*)(hp + (size_t)(pt * 16 + fr) * NST + kk * 32 + 8 * fq);
        {   const bf16* zp = Zb + (size_t)(r0 + 16 * wave + (lane >> 2)) * 1024 + h * 64 + 16 * (lane & 3);
            zw[0] = *(const u32x4*)zp; zw[1] = *(const u32x4*)(zp + 8); }
#pragma unroll
        for (int st = 0; st < 8; ++st) if (st <= (wave | 1)) {
            const int s = st * 16 + fr; const float css = csb[hh * 128 + s], dts = dtb[hh * 128 + s];
#pragma unroll
            for (int r = 0; r < 4; ++r) { const int lr = 16 * wave + 4 * fq + r; const float v = (s <= lr) ? cb[st][r] * __expf(csl[r] - css) * dts : 0.f;
                Mst[(4 * fq + r) * LP + s] = (bf16)f2bf(v); } }
        asm volatile("s_waitcnt lgkmcnt(0)" ::: "memory");
        f32x4 y[4];
#pragma unroll
        for (int pt = 0; pt < 4; ++pt) { y[pt] = (f32x4){0.f, 0.f, 0.f, 0.f};
#pragma unroll
            for (int kk = 0; kk < 4; ++kk) y[pt] = __builtin_amdgcn_mfma_f32_16x16x32_bf16(cf[kk], hf[pt][kk], y[pt], 0, 0, 0); }
#pragma unroll
        for (int r = 0; r < 4; ++r) { const float e = ecs[hh * 128 + 16 * wave + 4 * fq + r];
#pragma unroll
            for (int pt = 0; pt < 4; ++pt) y[pt][r] *= e; }
#pragma unroll
        for (int kk = 0; kk < 4; ++kk) if (kk <= (wave >> 1)) {
            const bf16x8 mf = *(const LAS bf16x8*)(Mst + fr * LP + kk * 32 + 8 * fq);
#pragma unroll
            for (int pt = 0; pt < 4; ++pt) { const bf16x8 xf = *(const LAS bf16x8*)(xT + (hh * 64 + pt * 16 + fr) * LP + kk * 32 + 8 * fq);
                y[pt] = __builtin_amdgcn_mfma_f32_16x16x32_bf16(mf, xf, y[pt], 0, 0, 0); } }
        asm volatile("s_waitcnt lgkmcnt(0)" ::: "memory");
        const float Dh = inp(a, I_DSKIP)[l * HEADS + h];
        LAS float* Ost = (LAS float*)Mst;
#pragma unroll
        for (int pt = 0; pt < 4; ++pt) { const int p = pt * 16 + fr;
            const u32x2 xw = *(const LAS u32x2*)(xT + (hh * 64 + p) * LP + 16 * wave + 4 * fq);
            const float xv[4] = {bf2f(xw.x & 0xffffu), bf2f(xw.x >> 16), bf2f(xw.y & 0xffffu), bf2f(xw.y >> 16)};
#pragma unroll
            for (int r = 0; r < 4; ++r) Ost[(4 * fq + r) * 68 + p] = y[pt][r] + Dh * xv[r]; }
        asm volatile("s_waitcnt lgkmcnt(0)" ::: "memory");
        {   const int lr = lane >> 2, ch = lane & 3; const size_t row = (size_t)(r0 + 16 * wave + lr);
            float v[16];
#pragma unroll
            for (int q4 = 0; q4 < 4; ++q4) { const f32x4 t4 = *(const LAS f32x4*)(Ost + lr * 68 + 16 * ch + 4 * q4); v[4 * q4] = t4.x; v[4 * q4 + 1] = t4.y; v[4 * q4 + 2] = t4.z; v[4 * q4 + 3] = t4.w; }
            const unsigned zz[8] = {zw[0].x, zw[0].y, zw[0].z, zw[0].w, zw[1].x, zw[1].y, zw[1].z, zw[1].w};
#pragma unroll
            for (int e = 0; e < 8; ++e) { v[2 * e] *= bf2f(zz[e] & 0xffffu); v[2 * e + 1] *= bf2f(zz[e] >> 16); ssq[0] += v[2 * e] * v[2 * e] + v[2 * e + 1] * v[2 * e + 1]; }
            u32x4 o0, o1; o0.x = pk2(v[0], v[1]); o0.y = pk2(v[2], v[3]); o0.z = pk2(v[4], v[5]); o0.w = pk2(v[6], v[7]); o1.x = pk2(v[8], v[9]); o1.y = pk2(v[10], v[11]); o1.z = pk2(v[12], v[13]); o1.w = pk2(v[14], v[15]);
            bf16* op = ACT + row * 4096 + h * 64 + 16 * ch; *(u32x4*)op = o0; *(u32x4*)(op + 8) = o1; }
        asm volatile("s_waitcnt lgkmcnt(0)" ::: "memory");
    }
    {   float s_ = ssq[0]; s_ += dpp_f<0xB1>(s_); s_ += dpp_f<0x4E>(s_);
        if ((lane & 3) == 0) atomicAdd((u64*)(wsp(a) + WS_SSQA) + (size_t)l * TT + r0 + 16 * wave + (lane >> 2), ssq_fix(s_)); }
}

__device__ __forceinline__ void ssds_item(const Args& a, int l, int item, LAS unsigned char* lds, int tid, int wave, int lane) {
    asm volatile("" : "+v"(tid), "+v"(lane), "+s"(wave), "+s"(item));
    const int b = item >> 2, g = item & 3; const int row0 = TP + 8 * b;
    LAS float* xs = (LAS float*)lds; LAS float* Bs = xs + 8 * 256; LAS float* Cs = Bs + 1024; LAS float* dtv = Cs + 1024; LAS float* dA = dtv + 32;
    const bf16* XBC = (const bf16*)(wsp(a) + WS_XBC);
    const int p = tid >> 3, nq = tid & 7;
    f32x4 hv[4][4];
#pragma unroll
    for (int hh = 0; hh < 4; ++hh) { const float* sp = inp(a, I_SSM) + ((size_t)((l * SB + b) * HEADS + 4 * g + hh)) * (HD * NST) + (size_t)p * NST;
#pragma unroll
        for (int j = 0; j < 4; ++j) hv[hh][j] = *(const f32x4*)(sp + (8 * j + nq) * 4); }
    unsigned short zq[4]; float dq[4];
#pragma unroll
    for (int hh = 0; hh < 4; ++hh) { zq[hh] = ((const bf16*)(wsp(a) + WS_Z))[(size_t)(row0 + nq) * 1024 + (4 * g + hh) * 64 + p]; dq[hh] = inp(a, I_DSKIP)[l * HEADS + 4 * g + hh]; }
    __syncthreads();
    {
        const int ch = tid < 256 ? g * 256 + tid : (tid < 384 ? 1024 + g * 128 + (tid - 256) : 1536 + g * 128 + (tid - 384));
        float w[4], in[11];
#pragma unroll
        for (int k = 0; k < 4; ++k) w[k] = inp(a, I_SCONVW)[(size_t)l * 4 * XBC_W + k * XBC_W + ch];
        const float bias = inp(a, I_SCONVB)[l * XBC_W + ch];
#pragma unroll
        for (int rr = 0; rr < 3; ++rr) in[rr] = inp(a, I_CSSM)[(((size_t)l * SB + b) * 3 + rr) * XBC_W + ch];
#pragma unroll
        for (int rr = 0; rr < 8; ++rr) in[3 + rr] = bf2f(XBC[(size_t)(row0 + rr) * XBC_W + ch]);
        float dval = 0.f, aval = 0.f;
        if (tid < 32) { dval = ((const float*)(wsp(a) + WS_DT))[(size_t)(row0 + (tid & 7)) * 16 + 4 * g + (tid >> 3)]; aval = -__expf(inp(a, I_ALOG)[l * HEADS + 4 * g + (tid >> 3)]); }
#pragma unroll
        for (int t = 0; t < 8; ++t) { const float v = fsilu(bias + w[0] * in[t] + w[1] * in[t + 1] + w[2] * in[t + 2] + w[3] * in[t + 3]);
            if (tid < 256) xs[t * 256 + tid] = v; else if (tid < 384) Bs[t * 128 + tid - 256] = v; else Cs[t * 128 + tid - 384] = v; }
        if (tid < 32) { dtv[tid] = dval; dA[tid] = __expf(aval * dval); }
    }
    __syncthreads();
    bf16* ACT = (bf16*)(wsp(a) + WS_ACT);
    const size_t row = (size_t)(row0 + nq);
    float ssq = 0.f;
#pragma unroll
    for (int hh = 0; hh < 4; ++hh) {
        const int h = 4 * g + hh;
        float hr[16];
#pragma unroll
        for (int j = 0; j < 4; ++j) { hr[4 * j] = hv[hh][j].x; hr[4 * j + 1] = hv[hh][j].y; hr[4 * j + 2] = hv[hh][j].z; hr[4 * j + 3] = hv[hh][j].w; }
        float yk = 0.f;
#pragma unroll 1
        for (int t = 0; t < 8; ++t) {
            const float xv = dtv[hh * 8 + t] * xs[t * 256 + hh * 64 + p], da = dA[hh * 8 + t]; float part = 0.f;
#pragma unroll
            for (int j4 = 0; j4 < 4; ++j4) { const f32x4 bv = *(const LAS f32x4*)(Bs + t * 128 + (8 * j4 + nq) * 4), cv = *(const LAS f32x4*)(Cs + t * 128 + (8 * j4 + nq) * 4);
#pragma unroll
                for (int e = 0; e < 4; ++e) { hr[4 * j4 + e] = hr[4 * j4 + e] * da + xv * bv[e]; part += cv[e] * hr[4 * j4 + e]; } }
            part = red8_sum(part);
            yk = (nq == t) ? part : yk;
        }
        float* so = outp(a) + O_SSSM + ((size_t)((l * SB + b) * HEADS + h)) * (HD * NST) + (size_t)p * NST;
#pragma unroll
        for (int j = 0; j < 4; ++j) __builtin_nontemporal_store((f32x4){hr[4 * j], hr[4 * j + 1], hr[4 * j + 2], hr[4 * j + 3]}, (f32x4*)(so + (8 * j + nq) * 4));
        const float v = (yk + dq[hh] * xs[nq * 256 + hh * 64 + p]) * bf2f(zq[hh]);
        ACT[row * 4096 + h * 64 + p] = (bf16)f2bf(v);
        ssq += v * v;
    }
    ssq += dpp_f<0x128>(ssq); ssq += xor16_f(ssq); ssq += xor32_f(ssq);
    if ((lane >> 3) == 0) atomicAdd((u64*)(wsp(a) + WS_SSQA) + (size_t)l * TT + row, ssq_fix(ssq));
}

struct SsdsIn { f32x4 hv[4][4]; unsigned short zq[4]; float dq[4]; float w[4], pre[3], bias, dval, alog; unsigned short raw[8]; };
__device__ __forceinline__ void ssds_load(const Args& a, int l, int item, int tid, SsdsIn& S) {
    const int b = item >> 2, g = item & 3, row0 = TP + 8 * b, p = tid >> 3, nq = tid & 7;
    const bf16* XBC = (const bf16*)(wsp(a) + WS_XBC);
#pragma unroll
    for (int hh = 0; hh < 4; ++hh) { const float* sp = inp(a, I_SSM) + ((size_t)((l * SB + b) * HEADS + 4 * g + hh)) * (HD * NST) + (size_t)p * NST;
#pragma unroll
        for (int j = 0; j < 4; ++j) S.hv[hh][j] = __builtin_nontemporal_load((const f32x4*)(sp + (8 * j + nq) * 4)); }
#pragma unroll
    for (int hh = 0; hh < 4; ++hh) { S.zq[hh] = ((const bf16*)(wsp(a) + WS_Z))[(size_t)(row0 + nq) * 1024 + (4 * g + hh) * 64 + p]; S.dq[hh] = inp(a, I_DSKIP)[l * HEADS + 4 * g + hh]; }
    const int ch = tid < 256 ? g * 256 + tid : (tid < 384 ? 1024 + g * 128 + (tid - 256) : 1536 + g * 128 + (tid - 384));
#pragma unroll
    for (int k = 0; k < 4; ++k) S.w[k] = inp(a, I_SCONVW)[(size_t)l * 4 * XBC_W + k * XBC_W + ch];
    S.bias = inp(a, I_SCONVB)[l * XBC_W + ch];
#pragma unroll
    for (int rr = 0; rr < 3; ++rr) S.pre[rr] = inp(a, I_CSSM)[(((size_t)l * SB + b) * 3 + rr) * XBC_W + ch];
#pragma unroll
    for (int rr = 0; rr < 8; ++rr) S.raw[rr] = XBC[(size_t)(row0 + rr) * XBC_W + ch];
    S.dval = 0.f; S.alog = 0.f;
    if (tid < 32) { S.dval = ((const float*)(wsp(a) + WS_DT))[(size_t)(row0 + (tid & 7)) * 16 + 4 * g + (tid >> 3)]; S.alog = inp(a, I_ALOG)[l * HEADS + 4 * g + (tid >> 3)]; }
}
__device__ __forceinline__ void ssds_conv(const SsdsIn& S, LAS unsigned char* lds, int tid) {
    LAS float* xs = (LAS float*)lds; LAS float* Bs = xs + 8 * 256; LAS float* Cs = Bs + 1024; LAS float* dtv = Cs + 1024; LAS float* dA = dtv + 32;
    float in[11];
#pragma unroll
    for (int rr = 0; rr < 3; ++rr) in[rr] = S.pre[rr];
#pragma unroll
    for (int rr = 0; rr < 8; ++rr) in[3 + rr] = bf2f(S.raw[rr]);
#pragma unroll
    for (int t = 0; t < 8; ++t) { const float v = fsilu(S.bias + S.w[0] * in[t] + S.w[1] * in[t + 1] + S.w[2] * in[t + 2] + S.w[3] * in[t + 3]);
        if (tid < 256) xs[t * 256 + tid] = v; else if (tid < 384) Bs[t * 128 + tid - 256] = v; else Cs[t * 128 + tid - 384] = v; }
    if (tid < 32) { dtv[tid] = S.dval; dA[tid] = __expf(-__expf(S.alog) * S.dval); }
}
__device__ __forceinline__ void ssds_rec(const Args& a, int l, int item, const SsdsIn& S, LAS unsigned char* lds, int tid, int lane) {
    const int b = item >> 2, g = item & 3, row0 = TP + 8 * b, p = tid >> 3, nq = tid & 7;
    LAS float* xs = (LAS float*)lds; LAS float* Bs = xs + 8 * 256; LAS float* Cs = Bs + 1024; LAS float* dtv = Cs + 1024; LAS float* dA = dtv + 32;
    bf16* ACT = (bf16*)(wsp(a) + WS_ACT);
    const size_t row = (size_t)(row0 + nq);
    float ssq = 0.f;
#pragma unroll
    for (int hh = 0; hh < 4; ++hh) {
        const int h = 4 * g + hh;
        float hr[16];
#pragma unroll
        for (int j = 0; j < 4; ++j) { hr[4 * j] = S.hv[hh][j].x; hr[4 * j + 1] = S.hv[hh][j].y; hr[4 * j + 2] = S.hv[hh][j].z; hr[4 * j + 3] = S.hv[hh][j].w; }
        float yk = 0.f;
#pragma unroll 1
        for (int t = 0; t < 8; ++t) {
            const float xv = dtv[hh * 8 + t] * xs[t * 256 + hh * 64 + p], da = dA[hh * 8 + t]; float part = 0.f;
#pragma unroll
            for (int j4 = 0; j4 < 4; ++j4) { const f32x4 bv = *(const LAS f32x4*)(Bs + t * 128 + (8 * j4 + nq) * 4), cv = *(const LAS f32x4*)(Cs + t * 128 + (8 * j4 + nq) * 4);
#pragma unroll
                for (int e = 0; e < 4; ++e) { hr[4 * j4 + e] = hr[4 * j4 + e] * da + xv * bv[e]; part += cv[e] * hr[4 * j4 + e]; } }
            part = red8_sum(part);
            yk = (nq == t) ? part : yk;
        }
        float* so = outp(a) + O_SSSM + ((size_t)((l * SB + b) * HEADS + h)) * (HD * NST) + (size_t)p * NST;
#pragma unroll
        for (int j = 0; j < 4; ++j) __builtin_nontemporal_store((f32x4){hr[4 * j], hr[4 * j + 1], hr[4 * j + 2], hr[4 * j + 3]}, (f32x4*)(so + (8 * j + nq) * 4));
        const float v = (yk + S.dq[hh] * xs[nq * 256 + hh * 64 + p]) * bf2f(S.zq[hh]);
        ACT[row * 4096 + h * 64 + p] = (bf16)f2bf(v);
        ssq += v * v;
    }
    ssq += dpp_f<0x128>(ssq); ssq += xor16_f(ssq); ssq += xor32_f(ssq);
    if ((lane >> 3) == 0) atomicAdd((u64*)(wsp(a) + WS_SSQA) + (size_t)l * TT + row, ssq_fix(ssq));
}
__device__ __forceinline__ void ssds_pair(const Args& a, int l, int itA, int itB, LAS unsigned char* lds, int tid, int wave, int lane) {
    asm volatile("" : "+v"(tid), "+v"(lane), "+s"(wave), "+s"(itA), "+s"(itB));
    SsdsIn SA, SB;
    __syncthreads();
    ssds_load(a, l, itA, tid, SA);
    ssds_conv(SA, lds, tid);
    __syncthreads();
    ssds_load(a, l, itB, tid, SB);
    ssds_rec(a, l, itA, SA, lds, tid, lane);
    __syncthreads();
    ssds_conv(SB, lds, tid);
    __syncthreads();
    ssds_rec(a, l, itB, SB, lds, tid, lane);
}

constexpr int KP = 72, VP = 264;
__device__ __forceinline__ void attn_item(const Args& a, int l, int item, LAS unsigned char* lds, int tid, int wave, int lane) {
    asm volatile("" : "+v"(tid), "+v"(lane), "+s"(wave), "+s"(item));
    const int b = item >> 6, qb = (item >> 2) & 15, g = item & 3; const int r0 = b * PSEQ + qb * 128;
    LAS bf16* Kimg = (LAS bf16*)lds; LAS bf16* VT = Kimg + 256 * KP;
    const bf16* KV = (const bf16*)(wsp(a) + WS_KV); const bf16* Qb = (const bf16*)(wsp(a) + WS_Q); const bf16* AG = (const bf16*)(wsp(a) + WS_AG); bf16* ACT = (bf16*)(wsp(a) + WS_ACT);
    const int fr = lane & 15, fq = lane >> 4;
    const int hq = wave >> 1, half = wave & 1, h = 4 * g + hq;
    bf16x8 qf[4][2];
#pragma unroll
    for (int qt = 0; qt < 4; ++qt)
#pragma unroll
        for (int kk = 0; kk < 2; ++kk) qf[qt][kk] = *(const bf16x8*)(Qb + (size_t)(r0 + 64 * half + 16 * qt + fr) * 1024 + h * 64 + kk * 32 + 8 * fq);
    __syncthreads();
#pragma unroll
    for (int i = 0; i < 4; ++i) { const int id = tid + 512 * i, j = id >> 3, ch = id & 7; const int t = qb * 128 - 128 + j;
        u32x4 kw = (u32x4){0u, 0u, 0u, 0u}, vw = (u32x4){0u, 0u, 0u, 0u};
        if (t >= 0) { const bf16* rp = KV + (size_t)(b * PSEQ + t) * 512 + g * 64 + 8 * ch; kw = *(const u32x4*)rp; vw = *(const u32x4*)(rp + 256); }
        *(LAS u32x4*)(Kimg + j * KP + 8 * ch) = kw;
        const int slot = (j & ~31) + 8 * ((j & 15) >> 2) + 4 * ((j >> 4) & 1) + (j & 3);
        const unsigned vv[4] = {vw.x, vw.y, vw.z, vw.w};
#pragma unroll
        for (int e = 0; e < 8; ++e) VT[(8 * ch + e) * VP + slot] = (bf16)((vv[e >> 1] >> (16 * (e & 1))) & 0xffffu); }
    __syncthreads();

    const float L2E = 1.4426950408889634f, SC = 0.125f * L2E;
    float m[4], lsum[4]; f32x4 o[4][4];
    const float sinkv = inp(a, I_SINK)[l * HEADS + h] * L2E;
#pragma unroll
    for (int qt = 0; qt < 4; ++qt) { m[qt] = sinkv; lsum[qt] = (fq == 0) ? 1.f : 0.f;
#pragma unroll
        for (int dt = 0; dt < 4; ++dt) o[dt][qt] = (f32x4){0.f, 0.f, 0.f, 0.f}; }
#pragma unroll 1
    for (int kb = 2 * half; kb < 2 * half + 6; ++kb) {
        const int j0 = 32 * kb;
        f32x4 s[2][4];
#pragma unroll
        for (int tk = 0; tk < 2; ++tk) {
            bf16x8 kf[2];
#pragma unroll
            for (int kk = 0; kk < 2; ++kk) kf[kk] = *(const LAS bf16x8*)(Kimg + (j0 + 16 * tk + fr) * KP + kk * 32 + 8 * fq);
#pragma unroll
            for (int qt = 0; qt < 4; ++qt) { s[tk][qt] = (f32x4){0.f, 0.f, 0.f, 0.f};
#pragma unroll
                for (int kk = 0; kk < 2; ++kk) s[tk][qt] = __builtin_amdgcn_mfma_f32_16x16x32_bf16(kf[kk], qf[qt][kk], s[tk][qt], 0, 0, 0); } }
        bf16x8 pf[4];
#pragma unroll
        for (int qt = 0; qt < 4; ++qt) {
            const int qi = 64 * half + 16 * qt + fr; float bm = -INFINITY;
#pragma unroll
            for (int tk = 0; tk < 2; ++tk)
#pragma unroll
                for (int r = 0; r < 4; ++r) { const int j = j0 + 16 * tk + 4 * fq + r; const bool ok = (j > qi) && (j <= qi + 128) && (qb * 128 - 128 + j >= 0);
                    const float v = ok ? s[tk][qt][r] * SC : -INFINITY; s[tk][qt][r] = v; bm = fmaxf(bm, v); }
            bm = fmaxf(bm, xor16_f(bm)); bm = fmaxf(bm, xor32_f(bm));
            const float mn = fmaxf(m[qt], bm), al = __builtin_amdgcn_exp2f(m[qt] - mn); m[qt] = mn;
            float ps = 0.f; float pv[8];
#pragma unroll
            for (int tk = 0; tk < 2; ++tk)
#pragma unroll
                for (int r = 0; r < 4; ++r) { const float p = __builtin_amdgcn_exp2f(s[tk][qt][r] - mn); pv[4 * tk + r] = p; ps += p; }
            lsum[qt] = lsum[qt] * al + ps;
#pragma unroll
            for (int dt = 0; dt < 4; ++dt) o[dt][qt] = o[dt][qt] * al;
            u32x4 w; w.x = pk2(pv[0], pv[1]); w.y = pk2(pv[2], pv[3]); w.z = pk2(pv[4], pv[5]); w.w = pk2(pv[6], pv[7]);
            pf[qt] = __builtin_bit_cast(bf16x8, w);
        }
#pragma unroll
        for (int dt = 0; dt < 4; ++dt) { const bf16x8 vf = *(const LAS bf16x8*)(VT + (dt * 16 + fr) * VP + j0 + 8 * fq);
#pragma unroll
            for (int qt = 0; qt < 4; ++qt) o[dt][qt] = __builtin_amdgcn_mfma_f32_16x16x32_bf16(vf, pf[qt], o[dt][qt], 0, 0, 0); }
    }
    {
        LAS float* Ost = (LAS float*)(lds + 256 * KP * 2 + 64 * VP * 2) + wave * (16 * 68);
        const int oq = lane >> 2, och = lane & 3;
        u32x4 gq[4][2];
#pragma unroll
        for (int qt = 0; qt < 4; ++qt) { const bf16* gp = AG + (size_t)(r0 + 64 * half + 16 * qt + oq) * 1024 + h * 64 + 16 * och; gq[qt][0] = *(const u32x4*)gp; gq[qt][1] = *(const u32x4*)(gp + 8); }
#pragma unroll
        for (int qt = 0; qt < 4; ++qt) { float lt = lsum[qt]; lt += xor16_f(lt); lt += xor32_f(lt); const float inv = 1.f / lt;
#pragma unroll
            for (int dt = 0; dt < 4; ++dt) *(LAS f32x4*)(Ost + fr * 68 + dt * 16 + 4 * fq) = o[dt][qt] * inv;
            asm volatile("s_waitcnt lgkmcnt(0)" ::: "memory");
            float v[16];
#pragma unroll
            for (int k4 = 0; k4 < 4; ++k4) { const f32x4 t4 = *(const LAS f32x4*)(Ost + oq * 68 + 16 * och + 4 * k4); v[4 * k4] = t4.x; v[4 * k4 + 1] = t4.y; v[4 * k4 + 2] = t4.z; v[4 * k4 + 3] = t4.w; }
            asm volatile("s_waitcnt lgkmcnt(0)" ::: "memory");
            const unsigned zz[8] = {gq[qt][0].x, gq[qt][0].y, gq[qt][0].z, gq[qt][0].w, gq[qt][1].x, gq[qt][1].y, gq[qt][1].z, gq[qt][1].w};
            u32x4 o0, o1;
            o0.x = pk2(v[0] * bf2f(zz[0] & 0xffffu), v[1] * bf2f(zz[0] >> 16)); o0.y = pk2(v[2] * bf2f(zz[1] & 0xffffu), v[3] * bf2f(zz[1] >> 16));
            o0.z = pk2(v[4] * bf2f(zz[2] & 0xffffu), v[5] * bf2f(zz[2] >> 16)); o0.w = pk2(v[6] * bf2f(zz[3] & 0xffffu), v[7] * bf2f(zz[3] >> 16));
            o1.x = pk2(v[8] * bf2f(zz[4] & 0xffffu), v[9] * bf2f(zz[4] >> 16)); o1.y = pk2(v[10] * bf2f(zz[5] & 0xffffu), v[11] * bf2f(zz[5] >> 16));
            o1.z = pk2(v[12] * bf2f(zz[6] & 0xffffu), v[13] * bf2f(zz[6] >> 16)); o1.w = pk2(v[14] * bf2f(zz[7] & 0xffffu), v[15] * bf2f(zz[7] >> 16));
            bf16* op = ACT + (size_t)(r0 + 64 * half + 16 * qt + oq) * 4096 + 3072 + h * 64 + 16 * och; *(u32x4*)op = o0; *(u32x4*)(op + 8) = o1; }
    }
}

__device__ __forceinline__ void attns_item(const Args& a, int l, int item, LAS unsigned char* lds, int tid, int wave, int lane) {
    asm volatile("" : "+v"(tid), "+v"(lane), "+s"(wave), "+s"(item));
    const int b = item >> 2, g = item & 3; const int row0 = TP + 8 * b;
    LAS float* Qs = (LAS float*)lds; LAS float* Ks = Qs + 32 * 64; LAS float* Vs = Ks + 136 * 65; LAS float* Sc = Vs + 136 * 64;
    const bf16* KV = (const bf16*)(wsp(a) + WS_KV); const bf16* Qb = (const bf16*)(wsp(a) + WS_Q);
    __syncthreads();
    {
        const int qr = tid >> 4, qd = (tid & 15) * 4;
        const u32x2 qw = *(const u32x2*)(Qb + (size_t)(row0 + (qr & 7)) * 1024 + (4 * g + (qr >> 3)) * 64 + qd);
        f32x4 kc[4], vc[4];
#pragma unroll
        for (int i = 0; i < 4; ++i) { const int id = tid + 512 * i, j = id >> 4, d4 = (id & 15) * 4; const size_t o = (((size_t)l * SB + b) * 128 + j) * 256 + g * 64 + d4;
            kc[i] = *(const f32x4*)(inp(a, I_CK) + o); vc[i] = *(const f32x4*)(inp(a, I_CVV) + o); }
        u32x2 nk = (u32x2){0u, 0u}, nv = (u32x2){0u, 0u};
        if (tid < 128) { const bf16* rp = KV + (size_t)(row0 + (tid >> 4)) * 512 + g * 64 + (tid & 15) * 4; nk = *(const u32x2*)rp; nv = *(const u32x2*)(rp + 256); }
        LAS float* qd_ = Qs + qr * 64 + qd; qd_[0] = bf2f(qw.x & 0xffffu); qd_[1] = bf2f(qw.x >> 16); qd_[2] = bf2f(qw.y & 0xffffu); qd_[3] = bf2f(qw.y >> 16);
#pragma unroll
        for (int i = 0; i < 4; ++i) { const int id = tid + 512 * i, j = id >> 4, d4 = (id & 15) * 4; LAS float* kd = Ks + j * 65 + d4; kd[0] = kc[i].x; kd[1] = kc[i].y; kd[2] = kc[i].z; kd[3] = kc[i].w;
            *(LAS f32x4*)(Vs + j * 64 + d4) = vc[i]; }
        if (tid < 128) { const int j = 128 + (tid >> 4), d4 = (tid & 15) * 4; LAS float* kd = Ks + j * 65 + d4;
            kd[0] = bf2f(nk.x & 0xffffu); kd[1] = bf2f(nk.x >> 16); kd[2] = bf2f(nk.y & 0xffffu); kd[3] = bf2f(nk.y >> 16);
            *(LAS f32x4*)(Vs + j * 64 + d4) = (f32x4){bf2f(nv.x & 0xffffu), bf2f(nv.x >> 16), bf2f(nv.y & 0xffffu), bf2f(nv.y >> 16)}; }
    }
    __syncthreads();
    for (int e = tid; e < 32 * 136; e += 512) { const int r = e / 136, j = e - r * 136, qi = r & 7; float s = 0.f;
#pragma unroll 16
        for (int d = 0; d < 64; ++d) s += Qs[r * 64 + d] * Ks[j * 65 + d];
        const bool ok = j < 128 ? (j > qi) : (j - 128 <= qi);
        Sc[r * 140 + j] = ok ? s * 0.125f : -INFINITY; }
    __syncthreads();
#pragma unroll
    for (int rr = 0; rr < 4; ++rr) { const int r = 4 * wave + rr, hq = r >> 3; const float sink = inp(a, I_SINK)[l * HEADS + 4 * g + hq];
        const float s0 = Sc[r * 140 + lane], s1 = Sc[r * 140 + 64 + lane], s2 = lane < 8 ? Sc[r * 140 + 128 + lane] : -INFINITY;
        float mx = wave_max(fmaxf(fmaxf(s0, s1), s2));
        mx = fmaxf(mx, sink);
        const float p0 = __expf(s0 - mx), p1 = __expf(s1 - mx), p2 = lane < 8 ? __expf(s2 - mx) : 0.f;
        const float den = wave_sum(p0 + p1 + p2) + __expf(sink - mx), inv = 1.f / den;
        Sc[r * 140 + lane] = p0 * inv; Sc[r * 140 + 64 + lane] = p1 * inv; if (lane < 8) Sc[r * 140 + 128 + lane] = p2 * inv; }
    __syncthreads();
    {   const int r = tid >> 4, d4 = (tid & 15) * 4, hq = r >> 3, qi = r & 7; f32x4 o = (f32x4){0.f, 0.f, 0.f, 0.f};
        const size_t row = (size_t)(row0 + qi); const int col = (4 * g + hq) * 64 + d4;
        const u32x2 gw = *(const u32x2*)((const bf16*)(wsp(a) + WS_AG) + row * 1024 + col);
#pragma unroll 8
        for (int j = 0; j < 136; ++j) { const float p = Sc[r * 140 + j]; const f32x4 v = *(const LAS f32x4*)(Vs + j * 64 + d4); o = o + v * p; }
        u32x2 w; w.x = pk2(o.x * bf2f(gw.x & 0xffffu), o.y * bf2f(gw.x >> 16)); w.y = pk2(o.z * bf2f(gw.y & 0xffffu), o.w * bf2f(gw.y >> 16));
        *(u32x2*)((bf16*)(wsp(a) + WS_ACT) + row * 4096 + 3072 + col) = w; }
#pragma unroll
    for (int i = 0; i < 4; ++i) { const int id = tid + 512 * i, jj = id >> 4, d4 = (id & 15) * 4; const size_t o = (((size_t)l * SB + b) * 128 + jj) * 256 + g * 64 + d4;
        const LAS float* kd = Ks + (jj + 8) * 65 + d4;
        *(f32x4*)(outp(a) + O_SK + o) = (f32x4){kd[0], kd[1], kd[2], kd[3]}; *(f32x4*)(outp(a) + O_SV + o) = *(const LAS f32x4*)(Vs + (jj + 8) * 64 + d4); }
}

struct AttnsIn { u32x2 qw; f32x4 kc[4], vc[4]; u32x2 nk, nv; };
__device__ __forceinline__ void attns_load(const Args& a, int l, int item, int tid, AttnsIn& S) {
    const int b = item >> 2, g = item & 3, row0 = TP + 8 * b;
    const bf16* KV = (const bf16*)(wsp(a) + WS_KV); const bf16* Qb = (const bf16*)(wsp(a) + WS_Q);
    const int qr = tid >> 4, qd = (tid & 15) * 4;
    S.qw = *(const u32x2*)(Qb + (size_t)(row0 + (qr & 7)) * 1024 + (4 * g + (qr >> 3)) * 64 + qd);
#pragma unroll
    for (int i = 0; i < 4; ++i) { const int id = tid + 512 * i, j = id >> 4, d4 = (id & 15) * 4; const size_t o = (((size_t)l * SB + b) * 128 + j) * 256 + g * 64 + d4;
        S.kc[i] = __builtin_nontemporal_load((const f32x4*)(inp(a, I_CK) + o)); S.vc[i] = __builtin_nontemporal_load((const f32x4*)(inp(a, I_CVV) + o)); }
    S.nk = (u32x2){0u, 0u}; S.nv = (u32x2){0u, 0u};
    if (tid < 128) { const bf16* rp = KV + (size_t)(row0 + (tid >> 4)) * 512 + g * 64 + (tid & 15) * 4; S.nk = *(const u32x2*)rp; S.nv = *(const u32x2*)(rp + 256); }
}
__device__ __forceinline__ void attns_stage(const Args& a, int l, int item, const AttnsIn& S, LAS unsigned char* lds, int tid) {
    const int b = item >> 2, g = item & 3;
    LAS float* Qs = (LAS float*)lds; LAS float* Ks = Qs + 32 * 64; LAS float* Vs = Ks + 136 * 68;
    const int qr = tid >> 4, qd = (tid & 15) * 4;
    *(LAS f32x4*)(Qs + qr * 64 + qd) = (f32x4){bf2f(S.qw.x & 0xffffu), bf2f(S.qw.x >> 16), bf2f(S.qw.y & 0xffffu), bf2f(S.qw.y >> 16)};
#pragma unroll
    for (int i = 0; i < 4; ++i) { const int id = tid + 512 * i, j = id >> 4, d4 = (id & 15) * 4;
        *(LAS f32x4*)(Ks + j * 68 + d4) = S.kc[i]; *(LAS f32x4*)(Vs + j * 64 + d4) = S.vc[i];
        if (j >= 8) { const size_t o = (((size_t)l * SB + b) * 128 + (j - 8)) * 256 + g * 64 + d4; __builtin_nontemporal_store(S.kc[i], (f32x4*)(outp(a) + O_SK + o)); __builtin_nontemporal_store(S.vc[i], (f32x4*)(outp(a) + O_SV + o)); } }
    if (tid < 128) { const int jn = tid >> 4, d4 = (tid & 15) * 4;
        const f32x4 kf = (f32x4){bf2f(S.nk.x & 0xffffu), bf2f(S.nk.x >> 16), bf2f(S.nk.y & 0xffffu), bf2f(S.nk.y >> 16)}, vf = (f32x4){bf2f(S.nv.x & 0xffffu), bf2f(S.nv.x >> 16), bf2f(S.nv.y & 0xffffu), bf2f(S.nv.y >> 16)};
        *(LAS f32x4*)(Ks + (128 + jn) * 68 + d4) = kf; *(LAS f32x4*)(Vs + (128 + jn) * 64 + d4) = vf;
        const size_t o = (((size_t)l * SB + b) * 128 + (120 + jn)) * 256 + g * 64 + d4; *(f32x4*)(outp(a) + O_SK + o) = kf; *(f32x4*)(outp(a) + O_SV + o) = vf; }
}
__device__ __forceinline__ void attns_compute(const Args& a, int l, int item, LAS unsigned char* lds, int tid, int wave, int lane) {
    const int b = item >> 2, g = item & 3, row0 = TP + 8 * b;
    LAS float* Qs = (LAS float*)lds; LAS float* Ks = Qs + 32 * 64; LAS float* Vs = Ks + 136 * 68; LAS float* Sc = Vs + 136 * 64;
    const int r_ = tid >> 4, d4_ = (tid & 15) * 4;
    const u32x2 gw = *(const u32x2*)((const bf16*)(wsp(a) + WS_AG) + (size_t)(row0 + (r_ & 7)) * 1024 + (4 * g + (r_ >> 3)) * 64 + d4_);
    for (int e = tid; e < 32 * 136; e += 512) { const int r = e / 136, j = e - r * 136, qi = r & 7; float sacc = 0.f;
#pragma unroll
        for (int d4 = 0; d4 < 16; ++d4) { const f32x4 qv = *(const LAS f32x4*)(Qs + r * 64 + 4 * d4), kv = *(const LAS f32x4*)(Ks + j * 68 + 4 * d4); sacc += (qv.x * kv.x + qv.y * kv.y) + (qv.z * kv.z + qv.w * kv.w); }
        const bool ok = j < 128 ? (j > qi) : (j - 128 <= qi);
        Sc[r * 140 + j] = ok ? sacc * 0.125f : -INFINITY; }
    __syncthreads();
#pragma unroll
    for (int rr = 0; rr < 4; ++rr) { const int r = 4 * wave + rr, hq = r >> 3; const float sink = inp(a, I_SINK)[l * HEADS + 4 * g + hq];
        const float s0 = Sc[r * 140 + lane], s1 = Sc[r * 140 + 64 + lane], s2 = lane < 8 ? Sc[r * 140 + 128 + lane] : -INFINITY;
        float mx = wave_max(fmaxf(fmaxf(s0, s1), s2));
        mx = fmaxf(mx, sink);
        const float p0 = __expf(s0 - mx), p1 = __expf(s1 - mx), p2 = lane < 8 ? __expf(s2 - mx) : 0.f;
        const float den = wave_sum(p0 + p1 + p2) + __expf(sink - mx), inv = 1.f / den;
        Sc[r * 140 + lane] = p0 * inv; Sc[r * 140 + 64 + lane] = p1 * inv; if (lane < 8) Sc[r * 140 + 128 + lane] = p2 * inv; }
    __syncthreads();
    {   const int hq = r_ >> 3, qi = r_ & 7; f32x4 o = (f32x4){0.f, 0.f, 0.f, 0.f};
#pragma unroll 8
        for (int j = 0; j < 136; ++j) { const float pw = Sc[r_ * 140 + j]; const f32x4 v = *(const LAS f32x4*)(Vs + j * 64 + d4_); o = o + v * pw; }
        u32x2 w; w.x = pk2(o.x * bf2f(gw.x & 0xffffu), o.y * bf2f(gw.x >> 16)); w.y = pk2(o.z * bf2f(gw.y & 0xffffu), o.w * bf2f(gw.y >> 16));
        *(u32x2*)((bf16*)(wsp(a) + WS_ACT) + (size_t)(row0 + qi) * 4096 + 3072 + (4 * g + hq) * 64 + d4_) = w; }
}
__device__ __forceinline__ void attns_pair(const Args& a, int l, int itA, int itB, LAS unsigned char* lds, int tid, int wave, int lane) {
    asm volatile("" : "+v"(tid), "+v"(lane), "+s"(wave), "+s"(itA), "+s"(itB));
    AttnsIn SA, SB;
    __syncthreads();
    attns_load(a, l, itA, tid, SA);
    attns_stage(a, l, itA, SA, lds, tid);
    __syncthreads();
    attns_load(a, l, itB, tid, SB);
    attns_compute(a, l, itA, lds, tid, wave, lane);
    __syncthreads();
    attns_stage(a, l, itB, SB, lds, tid);
    __syncthreads();
    attns_compute(a, l, itB, lds, tid, wave, lane);
}

struct Epi2 {
    static constexpr bool PERM = true, ACCUM = true;
    const bf16* MG; const u64* ssqa; bf16* H;
    __device__ __forceinline__ void prefetch(const pg8::Unit&, LAS unsigned char*, int) const {}
    __device__ __forceinline__ void operator()(f32x4 (&acc)[2][2][4][2], const pg8::Unit& u, int wr, int wc, int fr, int fq, LAS unsigned char* lds, int slot) const {
        const int ln = fresh_lane(); const int frv = ln & 15, fqv = ln >> 4;
        const int row0 = u.pm * 256 + wr * 64 + frv, colb = u.pn * 256 + wc * 32 + 8 * fqv;
        u32x4 gw[3][2]; float rsa[3];
#define EPI2_LOAD(k, buf) do { const size_t row_ = (size_t)(row0 + ((k) >> 2) * 128 + ((k) & 3) * 16); \
            rsa[buf] = (u.sub == 0) ? ssq_to_rstd(ssqa[row_], 1.0f / 1024.0f, 1e-5f) : 1.0f; \
            _Pragma("unroll") for (int bj = 0; bj < 2; ++bj) gw[buf][bj] = *(const u32x4*)(MG + row_ * 8192 + colb + bj * 128 + u.sub * 2048); } while (0)
        EPI2_LOAD(0, 0); EPI2_LOAD(1, 1);
#pragma unroll
        for (int k = 0; k < 8; ++k) {
            const int ai = k >> 2, m = k & 3, buf = k % 3;
            if (k + 2 < 8) { if ((k + 2) % 3 == 0) EPI2_LOAD(k + 2, 0); else if ((k + 2) % 3 == 1) EPI2_LOAD(k + 2, 1); else EPI2_LOAD(k + 2, 2); }
            asm volatile("" ::: "memory");
            const size_t row = (size_t)(row0 + ai * 128 + m * 16);
#pragma unroll
            for (int bj = 0; bj < 2; ++bj) {
                const u32x4 a4 = gw[buf][bj];
                float g[8] = {bf2f(a4.x & 0xffffu), bf2f(a4.x >> 16), bf2f(a4.y & 0xffffu), bf2f(a4.y >> 16), bf2f(a4.z & 0xffffu), bf2f(a4.z >> 16), bf2f(a4.w & 0xffffu), bf2f(a4.w >> 16)};
#pragma unroll
                for (int j = 0; j < 8; ++j) g[j] *= rsa[buf];
                if (u.sub < 3) {
#pragma unroll
                    for (int j = 0; j < 8; ++j) acc[ai][bj][m][j >> 2][j & 3] *= g[j];
                } else {
                    float v[8];
#pragma unroll
                    for (int j = 0; j < 8; ++j) v[j] = acc[ai][bj][m][j >> 2][j & 3] * g[j];
                    u32x4 w; w.x = pk2(v[0], v[1]); w.y = pk2(v[2], v[3]); w.z = pk2(v[4], v[5]); w.w = pk2(v[6], v[7]);
                    *(u32x4*)(H + row * 2048 + colb + bj * 128) = w; } }
        }
#undef EPI2_LOAD
    }
};
struct Epi3 {
    static constexpr bool PERM = false, ACCUM = false;
    bf16* XB; u64* ssq;
    __device__ __forceinline__ void prefetch(const pg8::Unit&, LAS unsigned char*, int) const {}
    __device__ __forceinline__ void operator()(f32x4 (&acc)[2][2][4][2], const pg8::Unit& u, int wr, int wc, int fr, int fq, LAS unsigned char* lds, int slot) const {
        { const int ln = fresh_lane(); fr = ln & 15; fq = ln >> 4; }
        const int row0 = u.pm * 256 + wr * 64 + fr, col0 = u.pn * 256 + wc * 32 + 4 * fq;
        u32x2 xo[4][2][2];
#define EPI3_LOAD(k, buf) do { const int row_ = row0 + ((k) >> 2) * 128 + ((k) & 3) * 16; \
            _Pragma("unroll") for (int bj = 0; bj < 2; ++bj) _Pragma("unroll") for (int n = 0; n < 2; ++n) xo[buf][bj][n] = *(const u32x2*)(XB + (size_t)row_ * DM + col0 + bj * 128 + n * 16); } while (0)
        EPI3_LOAD(0, 0); EPI3_LOAD(1, 1); EPI3_LOAD(2, 2); EPI3_LOAD(3, 3);
#pragma unroll
        for (int k = 0; k < 8; ++k) {
            const int ai = k >> 2, m = k & 3, buf = k & 3;
            const int row = row0 + ai * 128 + m * 16; float s = 0.f;
            u32x2 cur[2][2];
#pragma unroll
            for (int bj = 0; bj < 2; ++bj)
#pragma unroll
                for (int n = 0; n < 2; ++n) cur[bj][n] = xo[buf][bj][n];
            asm volatile("" ::: "memory");
            if (k + 4 < 8) { if (buf == 0) EPI3_LOAD(k + 4, 0); else if (buf == 1) EPI3_LOAD(k + 4, 1); else if (buf == 2) EPI3_LOAD(k + 4, 2); else EPI3_LOAD(k + 4, 3); }
#pragma unroll
            for (int bj = 0; bj < 2; ++bj)
#pragma unroll
                for (int n = 0; n < 2; ++n) { const int col = col0 + bj * 128 + n * 16;
                    const u32x2 xw = cur[bj][n];
                    const f32x4 xn = (f32x4){bf2f(xw.x & 0xffffu), bf2f(xw.x >> 16), bf2f(xw.y & 0xffffu), bf2f(xw.y >> 16)} + acc[ai][bj][m][n];
                    u32x2 w; w.x = pk2(xn[0], xn[1]); w.y = pk2(xn[2], xn[3]); *(u32x2*)(XB + (size_t)row * DM + col) = w;
                    s += (xn[0] * xn[0] + xn[1] * xn[1]) + (xn[2] * xn[2] + xn[3] * xn[3]); }
            s += xor16_f(s); s += xor32_f(s);
            if (fq == 0) atomicAdd(ssq + row, ssq_fix(s));
        }
#undef EPI3_LOAD
    }
};


struct EpiP {
    static constexpr bool PERM = false, ACCUM = false;
    float* P;
    __device__ __forceinline__ void after(int, LAS unsigned char*) const {}
    __device__ __forceinline__ void prefetch(const pg8::Unit&, LAS unsigned char*, int) const {}
    __device__ __forceinline__ void operator()(f32x4 (&acc)[2][2][4][2], const pg8::Unit& u, int wr, int wc, int fr, int fq, LAS unsigned char* lds, int slot) const {
        { const int ln = fresh_lane(); fr = ln & 15; fq = ln >> 4; }
        const int row0 = (u.pm - TP / 256) * 256 + wr * 64 + fr, col0 = u.pn * 256 + wc * 32 + 4 * fq;
        float* base = P + ((size_t)u.sub * (TT - TP) + row0) * DM + col0;
#pragma unroll
        for (int ai = 0; ai < 2; ++ai)
#pragma unroll
            for (int m = 0; m < 4; ++m)
#pragma unroll
                for (int bj = 0; bj < 2; ++bj)
#pragma unroll
                    for (int n = 0; n < 2; ++n) *(f32x4*)(base + (size_t)(ai * 128 + m * 16) * DM + bj * 128 + n * 16) = acc[ai][bj][m][n];
    }
};

constexpr int CONV_I1 = (DM / 64) * (N1 / 64), CONV_IL = CONV_I1 + 4 * (1024 / 64) * (DM / 64) + (DM / 64) * (DM / 64);
constexpr int XCONV = 512;
#define XB_TMO      128
#define XB_XCNT(j)  (256  + 64 * (j))
#define XB_XSUB(j)  (1280 + 64 * (j))
#define XB_XGEN(j)  (2304 + 64 * (j))
#define XB_TOP      3328
#define XB_TOPGEN   3392
#define XCD_BAR_WORDS 3456
#define XB_SPIN_CAP (1u << 18)
__device__ __forceinline__ unsigned xb_ld(unsigned* p)              { return __hip_atomic_load(p, __ATOMIC_RELAXED, __HIP_MEMORY_SCOPE_AGENT); }
__device__ __forceinline__ unsigned xb_add(unsigned* p, unsigned v) { return __hip_atomic_fetch_add(p, v, __ATOMIC_RELAXED, __HIP_MEMORY_SCOPE_AGENT); }
__device__ __forceinline__ unsigned xb_xcc_id() { return (unsigned)__builtin_amdgcn_s_getreg((3 << 11) | 20) & 0xFu; }
#define XB_SPIN(cond, bar) do { unsigned _sp = 0; while (cond) { __builtin_amdgcn_s_sleep(1); \
    if ((++_sp & 255u) == 0u) { if (xb_ld(&(bar)[XB_TMO])) break; if (_sp > XB_SPIN_CAP) { atomicAdd(&(bar)[XB_TMO], 1u); break; } } } } while (0)
__device__ __forceinline__ void xcd_barrier_complete(unsigned* bar, unsigned x, unsigned& nloc, unsigned& nx) {
    const unsigned G = gridDim.x * gridDim.y * gridDim.z;
    unsigned sum, cnt, mine, sp = 0u;
    for (;;) {
        sum = 0u; cnt = 0u; mine = 0u;
#pragma unroll
        for (unsigned j = 0; j < 16; ++j) { const unsigned c = xb_ld(&bar[XB_XCNT(j)]); sum += c; cnt += (c > 0u) ? 1u : 0u; mine = (j == x) ? c : mine; }
        if (sum == G) break;
        __builtin_amdgcn_s_sleep(1);
        if ((++sp & 255u) == 0u) { if (xb_ld(&bar[XB_TMO])) break; if (sp > XB_SPIN_CAP) { atomicAdd(&bar[XB_TMO], 1u); break; } }
    }
    nloc = mine > 0u ? mine : 1u; nx = cnt > 0u ? cnt : 1u;
}
__device__ __forceinline__ void xcd_barrier(unsigned* bar, volatile LAS unsigned* st) {
    asm volatile("s_waitcnt vmcnt(0)" ::: "memory");
    __syncthreads();
    if (threadIdx.x == 0) {
        const unsigned x = xb_xcc_id();
        __builtin_amdgcn_s_waitcnt(0);
        unsigned nloc = st[0], nx = st[1];
        if (nloc == 0u) { xcd_barrier_complete(bar, x, nloc, nx); st[0] = nloc; st[1] = nx; }
        const unsigned old = xb_add(&bar[XB_XSUB(x)], 1u);
        const unsigned gen = old / nloc;
        if (old + 1u == (gen + 1u) * nloc) {
            __builtin_amdgcn_fence(__ATOMIC_RELEASE, "agent");
            asm volatile("s_waitcnt vmcnt(0)" ::: "memory");
            const unsigned og = xb_add(&bar[XB_TOP], 1u);
            const unsigned tg = og / nx;
            if (og + 1u == (tg + 1u) * nx) xb_add(&bar[XB_TOPGEN], 1u);
            else XB_SPIN(xb_ld(&bar[XB_TOPGEN]) == tg, bar);
            __builtin_amdgcn_fence(__ATOMIC_ACQUIRE, "agent");
            xb_add(&bar[XB_XGEN(x)], 1u);
            asm volatile("s_waitcnt vmcnt(0)" ::: "memory");
        } else {
            XB_SPIN(xb_ld(&bar[XB_XGEN(x)]) == gen, bar);
            __builtin_amdgcn_fence(__ATOMIC_ACQUIRE, "agent");
            asm volatile("s_waitcnt vmcnt(0)" ::: "memory");
        }
    }
    __syncthreads();
}

__global__ void __launch_bounds__(512, 2) mk_fwd(Args a) {
    extern __shared__ __attribute__((aligned(16))) unsigned char lds_raw[];
    LAS unsigned char* lds = (LAS unsigned char*)lds_raw;
    const int G = gridDim.x, bx = blockIdx.x;
    const int vcu = (G % 8 == 0) ? (bx % 8) * (G / 8) + bx / 8 : bx;
    const int lo = a.ph_lo, hi = a.ph_hi;
    const bool fuse = (G == 256) && (hi - lo > 1);
#define IN(k) (lo <= (k) && (k) < hi)
#define STAMP(idx) do { if (PROBE_TIMING && bx == 0) { u64* tsp = (u64*)(wsp(a) + WS_DBG) + 64 + (idx); const u64 tv = __builtin_amdgcn_s_memrealtime(); if (threadIdx.x == 0) *tsp = tv; } } while (0)
#define SEAM(k) do { if (IN(k) && IN((k) + 1)) xcd_barrier((unsigned*)(wsp(a) + WS_CTL) + 4096, (volatile LAS unsigned*)(lds + LDS_MISC)); STAMP((k) + 1); } while (0)
#define FRESH_IDS int tid = threadIdx.x; asm volatile("" : "+v"(tid)); const int lane = tid & 63; const int wave = __builtin_amdgcn_readfirstlane(tid >> 6); const int gw = vcu * 8 + wave, ngw = G * 8; (void)lane; (void)gw; (void)ngw;
    if (threadIdx.x < 64) ((LAS unsigned*)(lds + LDS_MISC))[threadIdx.x] = 0u;
    __syncthreads();
    if (hi - lo > 1 && threadIdx.x == 0) (void)xb_add((unsigned*)(wsp(a) + WS_CTL) + 4096 + XB_XCNT(xb_xcc_id()), 1u);
    STAMP(0);
    int ph = 0;
    if (IN(ph)) { FRESH_IDS phase_prologue(a, lds, gw, ngw, wave, lane, 0, (G == 256) ? 1 : NL, true, 0, (G == 256) ? CONV_I1 : -1); }
    SEAM(ph); ++ph;
#pragma unroll 1
    for (int l = 0; l < NL; ++l) {
        if (IN(ph)) {
            pg8::Gemm g{(const bf16*)(wsp(a) + WS_XB), (const bf16*)(wsp(a) + WS_W1T + l * W1T_L), DM, DM, DM / 64, 0, 0};
            pg8::Order S; S.init(TT / 256, NT1, G, bx, 1);
            const bool side = (G == 256);
            S.m249 = side ? 1 : 0;
            Epi1 E{wsp(a), (const u64*)(wsp(a) + WS_SSQ) + (size_t)l * TT, inp(a, I_DTB) + l * 16};
            if (side && bx >= 249) {
                FRESH_IDS (void)gw; (void)ngw;
                phase_prologue(a, lds, (bx - 249) * 8 + wave, 7 * 8, wave, lane, l, (l + 2 < NL) ? l + 2 : NL, false, CONV_I1, (l + 1 < NL) ? CONV_IL + XCONV : CONV_IL);
            } else
            if (GEMM_MASK & 1) pg8::gemm_phase<Epi1, pg8::Order>(lds, g, S, E);
        }
        SEAM(ph); ++ph;
        if (IN(ph)) {
            FRESH_IDS
            const int NCP = (G == 256) ? 0 : 512;
            const int NAT = (G == 256) ? 0 : 256;
            const int N0 = 256, N1_ = N0 + NAT, N2 = N1_ + NCP, N3 = N2 + 512, N4 = N3 + 128, N5 = N4 + 512;
#pragma unroll 1
            for (int it = bx; it < N5; it += G) {
                if (it < N0) { if (ITEM_MASK & 1) ssd1_item(a, l, it, lds, tid, wave, lane); }
                else if (it < N1_) { if (ITEM_MASK & 2) attn_item(a, l, it - N0, lds, tid, wave, lane); }
                else if (it < N2) { if (ITEM_MASK & 4) conv_item<false>(a, l, it - N1_, lds, tid, wave, lane); }
                else if (it < N3) { if (G != 256) { if (ITEM_MASK & 8) attns_item(a, l, it - N2, lds, tid, wave, lane); } }
                else if (it < N4) { if (G != 256) { if (ITEM_MASK & 16) conv_item<true>(a, l, it - N3, lds, tid, wave, lane); } }
                else if (G != 256) { if (ITEM_MASK & 32) ssds_item(a, l, it - N4, lds, tid, wave, lane); }
            }
            if (G == 256) { if (ITEM_MASK & 8) attns_pair(a, l, bx, bx + 256, lds, tid, wave, lane); }
            if (G == 256) { if (ITEM_MASK & 32) ssds_pair(a, l, bx, bx + 256, lds, tid, wave, lane); }
        }
        SEAM(ph); ++ph;
        if (IN(ph)) { FRESH_IDS if (G != 256) ssd_scan_phase(a, l, bx * 512 + tid, G * 512); else if (bx >= 128) ssd_scan_phase(a, l, (bx - 128) * 512 + tid, 128 * 512); }
        if (IN(ph)) { FRESH_IDS
#pragma unroll 1
            for (int it = bx; it < ((G == 256) ? 128 : 0); it += G) { if (ITEM_MASK & 16) conv_item<true>(a, l, it, lds, tid, wave, lane); } }
        SEAM(ph); ++ph;
        if (IN(ph)) {
            if ((vcu & 7) == 0 && G == 256) {
                pg8::Gemm g{(const bf16*)(wsp(a) + WS_ACT), (const bf16*)(wsp(a) + WS_W2T + l * W2T_L), 4096, 4096, 1024 / 64, 1024, 1024};
                pg8::ListOrder S{256 + (vcu >> 3), 0, 1, 4};
                Epi2 E{(const bf16*)(wsp(a) + WS_MG), (const u64*)(wsp(a) + WS_SSQA) + (size_t)l * TT, (bf16*)(wsp(a) + WS_H)};
                if (GEMM_MASK & 2) pg8::gemm_phase<Epi2, pg8::ListOrder>(lds, g, S, E);
            } else {
                FRESH_IDS
                const int q = (G == 256) ? (vcu >> 3) * 7 + (vcu & 7) - 1 : bx, nq = (G == 256) ? 224 : G;
#pragma unroll 1
                for (int it = q; it < 256; it += nq) { if (ITEM_MASK & 64) ssd2_item(a, l, it, lds, tid, wave, lane); }
                if (G == 256 && q >= 32) {
#pragma unroll 1
                    for (int it = q - 32; it < 512; it += 192) { if (ITEM_MASK & 4) conv_item<false>(a, l, it, lds, tid, wave, lane); }
                }
                if (G == 256) {
                    if (q < 32) { if (ITEM_MASK & 2) { attn_item(a, l, q, lds, tid, wave, lane); attn_item(a, l, q + 32, lds, tid, wave, lane); } }
                    else { if (ITEM_MASK & 2) attn_item(a, l, 64 + (q - 32), lds, tid, wave, lane); }
                }
            }
        }
        SEAM(ph); ++ph;
        if (IN(ph)) {
            pg8::Gemm g{(const bf16*)(wsp(a) + WS_ACT), (const bf16*)(wsp(a) + WS_W2T + l * W2T_L), 4096, 4096, 1024 / 64, 1024, 1024};
            Epi2 E{(const bf16*)(wsp(a) + WS_MG), (const u64*)(wsp(a) + WS_SSQA) + (size_t)l * TT, (bf16*)(wsp(a) + WS_H)};
            if (G == 256) { pg8::ListOrder S{vcu, 0, 1, 4}; if (GEMM_MASK & 2) pg8::gemm_phase<Epi2, pg8::ListOrder>(lds, g, S, E); }
            else { pg8::Order S; S.init(TT / 256, DM / 256, G, bx, 4); if (GEMM_MASK & 2) pg8::gemm_phase<Epi2, pg8::Order>(lds, g, S, E); }
        }
        SEAM(ph); ++ph;
        if (IN(ph)) {
            pg8::Gemm g{(const bf16*)(wsp(a) + WS_H), (const bf16*)(wsp(a) + WS_W3T + l * W3T_L), DM, DM, DM / 64, 0, 0};
            const bool splitk = fuse && l == NL - 1;
            pg8::Order S; S.init(splitk ? TP / 256 : TT / 256, DM / 256, G, bx, 1);
            Epi3 E{(bf16*)(wsp(a) + WS_XB), (u64*)(wsp(a) + WS_SSQ) + (size_t)(l + 1) * TT};
            if (GEMM_MASK & 4) pg8::gemm_phase<Epi3, pg8::Order>(lds, g, S, E);
            if (splitk && bx < 128) {
                pg8::Gemm gp{(const bf16*)(wsp(a) + WS_H), (const bf16*)(wsp(a) + WS_W3T + l * W3T_L), DM, DM, (DM / 4) / 64, DM / 4, DM / 4};
                pg8::ListOrder S2{256 + (bx >> 2), 0, 1, 1, bx & 3};
                EpiP EP{(float*)(wsp(a) + WS_MG)};
                if (GEMM_MASK & 4) pg8::gemm_phase<EpiP, pg8::ListOrder>(lds, gp, S2, EP);
            }
            if (l == 0 && G == 256 && bx >= 32) {
                FRESH_IDS (void)gw; (void)ngw;
                phase_prologue(a, lds, (bx - 32) * 8 + wave, 224 * 8, wave, lane, 1, 2, false, XCONV, CONV_I1);
            }
        }
        SEAM(ph); ++ph;
    }
    if (IN(ph)) {
        FRESH_IDS
        for (int mrow = gw; mrow < TT; mrow += ngw) {
            const bool sp = fuse && mrow >= TP;
            const u32x2* x2 = (const u32x2*)((const bf16*)(wsp(a) + WS_XB) + (size_t)mrow * DM) + lane; u32x2 v[8]; f32x4 x[8];
#pragma unroll
            for (int j = 0; j < 8; ++j) v[j] = x2[64 * j];
#pragma unroll
            for (int j = 0; j < 8; ++j) x[j] = (f32x4){bf2f(v[j].x & 0xffffu), bf2f(v[j].x >> 16), bf2f(v[j].y & 0xffffu), bf2f(v[j].y >> 16)};
            float rstd;
            if (sp) {
                const float* P = (const float*)(wsp(a) + WS_MG) + (size_t)(mrow - TP) * DM; float ss = 0.f;
#pragma unroll
                for (int sl = 0; sl < 4; ++sl) { const f32x4* pp = (const f32x4*)(P + (size_t)sl * (TT - TP) * DM) + lane;
#pragma unroll
                    for (int j = 0; j < 8; ++j) x[j] += pp[64 * j]; }
#pragma unroll
                for (int j = 0; j < 8; ++j) ss += (x[j].x * x[j].x + x[j].y * x[j].y) + (x[j].z * x[j].z + x[j].w * x[j].w);
                rstd = rsqrtf(wave_sum(ss) * (1.0f / 2048.0f) + 1e-6f);
            } else rstd = ssq_to_rstd(((const u64*)(wsp(a) + WS_SSQ))[(size_t)NL * TT + mrow], 1.0f / 2048.0f, 1e-6f);
            f32x4* o4 = (f32x4*)(outp(a) + (size_t)mrow * DM) + lane;
#pragma unroll
            for (int j = 0; j < 8; ++j) { const f32x4 w = *((const f32x4*)inp(a, I_FNW) + lane + 64 * j); __builtin_nontemporal_store(x[j] * rstd * w, o4 + 64 * j); }
        }
    }
    STAMP(ph + 1);
#undef IN
#undef SEAM
}

#if PROBE_CHECK
constexpr int NSTAGE = 40;
__device__ __forceinline__ unsigned hash32(unsigned x) { x ^= x >> 16; x *= 0x7feb352du; x ^= x >> 15; x *= 0x846ca68bu; x ^= x >> 16; return x; }
__device__ __forceinline__ void rec_err(float* dbg, int stage, float got, float ref, float floor_) {
    float e = fabsf(got - ref) / (fabsf(ref) + floor_); if (!(e == e)) e = 1e30f;
    atomicMax((unsigned*)dbg + stage, __float_as_uint(e));
}
__device__ void rec_err2(float* dbg, int stage, float got, float ref, float scale) {
    float e = fabsf(got - ref) / scale; if (!(e == e)) e = 1e30f; if (e == 0.f) e = 1e-30f;
    atomicMax((unsigned*)dbg + stage, __float_as_uint(e));
}
__device__ float chk_xbc(const Args& a, int l, int row, int ch) {
    const bf16* XBC = (const bf16*)(a.ws + WS_XBC); float s = a.in[I_SCONVB][l * XBC_W + ch];
    const bool samp = row >= TP; const int t = samp ? (row - TP) % 8 : row % PSEQ, b = samp ? (row - TP) / 8 : 0;
    for (int k = 0; k < 4; ++k) { const int tt = t - 3 + k; float v;
        if (tt >= 0) v = bf2f(XBC[(size_t)(row - 3 + k) * XBC_W + ch]); else v = samp ? a.in[I_CSSM][(((size_t)l * SB + b) * 3 + (3 + tt)) * XBC_W + ch] : 0.f;
        s += a.in[I_SCONVW][(size_t)l * 4 * XBC_W + k * XBC_W + ch] * v; }
    return s / (1.f + expf(-s));
}
__device__ float chk_cfconv(const Args& a, int l, int row, int ch) {
    const bf16* U = (const bf16*)(a.ws + WS_U); float s = a.in[I_CFCB][l * 1024 + ch];
    const bool samp = row >= TP; const int t = samp ? (row - TP) % 8 : row % PSEQ, b = samp ? (row - TP) / 8 : 0;
    for (int k = 0; k < 31; ++k) { const int tt = t - 30 + k; float v;
        if (tt >= 0) v = bf2f(U[(size_t)(row - 30 + k) * 1024 + ch]); else v = samp ? a.in[I_CCF][(((size_t)l * SB + b) * 30 + (30 + tt)) * 1024 + ch] : 0.f;
        s += a.in[I_CFCW][(size_t)l * 31 * 1024 + k * 1024 + ch] * v; }
    return s;
}
__global__ void chk_kernel(Args a, int layer, int part) {
    float* dbg = (float*)(a.ws + WS_DBG); const int l = layer;
    const int s = blockIdx.x * blockDim.x + threadIdx.x; const unsigned h = hash32(s * 2654435761u + 12345u + 977u * layer);
    const bf16* XB = (const bf16*)(a.ws + WS_XB); const bf16* ACT = (const bf16*)(a.ws + WS_ACT); const float* DT = (const float*)(a.ws + WS_DT);
    const bf16* KV = (const bf16*)(a.ws + WS_KV); const bf16* Zb = (const bf16*)(a.ws + WS_Z);
    if (part == 1) {
        const int row = h % TT, col = (h >> 13) % DM;
        if (layer == 0 && s < 4096) { const bf16* hr = (const bf16*)(a.ws + WS_H) + (size_t)row * DM; const bf16* wr = (const bf16*)(a.ws + WS_W3T + l * W3T_L) + (size_t)col * DM; float d = 0.f, da = 0.f;
            for (int k = 0; k < DM; ++k) { const float t = bf2f(hr[k]) * bf2f(wr[k]); d += t; da += fabsf(t); }
            const float xo = row < TP ? a.in[I_XP][(size_t)row * DM + col] : a.in[I_XS][(size_t)(row - TP) * DM + col];
            rec_err2(dbg, 27, a.out[(size_t)row * DM + col], xo + d, da + fabsf(xo) + 1e-3f); }
        rec_err2(dbg, 28, bf2f(XB[(size_t)row * DM + col]), a.out[(size_t)row * DM + col], fabsf(a.out[(size_t)row * DM + col]) + 0.01f);
        if (s < 2048) { float q = 0.f; for (int i = 0; i < DM; ++i) { const float v = a.out[(size_t)row * DM + i]; q += v * v; }
            rec_err2(dbg, 28, (float)((double)((const u64*)(a.ws + WS_SSQ))[(size_t)(l + 1) * TT + row] / 1048576.0), q, q * 0.25f + 1e-3f); }
        return;
    }
    if (part == 2) {
        if (s < 4096) { const int row = h % TT; float q = 0.f; for (int i = 0; i < DM; ++i) { const float v = a.out[(size_t)row * DM + i] / a.in[I_FNW][i]; q += v * v; }
            rec_err2(dbg, 29, q * (1.f / 2048.f), 1.f, 1.f); }
        return;
    }
    if (layer == 0) {
        const int row = h % TT, k = (h >> 14) % DM;
        const float x = row < TP ? a.in[I_XP][(size_t)row * DM + k] : a.in[I_XS][(size_t)(row - TP) * DM + k];
        rec_err(dbg, 0, bf2f(XB[(size_t)row * DM + k]), x, 0.01f);
        if (s < 4096) { const float* xr = row < TP ? a.in[I_XP] + (size_t)row * DM : a.in[I_XS] + (size_t)(row - TP) * DM; float q = 0.f; for (int i = 0; i < DM; ++i) q += xr[i] * xr[i];
            rec_err(dbg, 1, (float)((double)((const u64*)(a.ws + WS_SSQ))[row] / 1048576.0), q, 0.01f); }
    }
    {
        const unsigned h2 = hash32(h + 77u); const int n = h2 % N1, k = (h2 >> 16) % DM; const int pn = n >> 8, c = n & 255; const TileInfo ti = tile_info(pn);
        const int half = c >> 7, cc = c & 127; const int valid = half ? ti.valid1 : ti.valid0; float ref = 0.f;
        if (cc < valid) ref = a.in[I_WIN][(size_t)layer * DM * IN_COLS + (size_t)k * IN_COLS + (half ? ti.src1 : ti.src0) + cc] * a.in[I_NORMW][layer * DM + k];
        rec_err(dbg, 2, bf2f(((const bf16*)(a.ws + WS_W1T + layer * W1T_L))[(size_t)n * DM + k]), ref, 0.002f);
        const int n2 = h2 % DM, k2 = (h2 >> 12) % 4096, br = k2 >> 10, kk = k2 & 1023;
        float r2 = a.in[br == 0 ? I_WOSSM : (br == 1 ? I_WOCF : (br == 2 ? I_WOSC : I_WOATT))][(size_t)layer * 1024 * DM + (size_t)kk * DM + n2]; if (br == 0) r2 *= a.in[I_SNORMW][layer * 1024 + kk];
        rec_err(dbg, 3, bf2f(((const bf16*)(a.ws + WS_W2T + layer * W2T_L))[(size_t)n2 * 4096 + k2]), r2, 0.002f);
        const int k3 = (h2 >> 11) % DM;
        rec_err(dbg, 4, bf2f(((const bf16*)(a.ws + WS_W3T + layer * W3T_L))[(size_t)n2 * DM + k3]), a.in[I_WO][(size_t)layer * DM * DM + (size_t)k3 * DM + n2], 0.002f);
    }
    {
        const unsigned h3 = hash32(h + 991u); const int row = h3 % TT, pn = s % NT1; const TileInfo ti = tile_info(pn);
        const int ncol = ti.mode == M_DT ? 16 : (ti.mode >= M_GLU ? 128 : 256); const int c = (h3 >> 14) % ncol;
        const bf16* W = (const bf16*)(a.ws + WS_W1T + layer * W1T_L) + (size_t)pn * 256 * DM; const bf16* xr = XB + (size_t)row * DM;
        float d0 = 0.f, d1 = 0.f;
        for (int k = 0; k < DM; ++k) { const float x = bf2f(xr[k]); d0 += x * bf2f(W[(size_t)c * DM + k]); if (ti.mode >= M_GLU && ti.mode <= M_ASILUB) d1 += x * bf2f(W[(size_t)(c + 128) * DM + k]); }
        const float r = ssq_to_rstd(((const u64*)(a.ws + WS_SSQ))[(size_t)layer * TT + row], 1.f / 2048.f, 1e-6f); d0 *= r; d1 *= r;
        float ref, got;
        switch (ti.mode) { case M_ID: ref = d0; break; case M_SILU: ref = d0 / (1.f + expf(-d0)); break; case M_SIG: ref = 1.f / (1.f + expf(-d0)); break;
            case M_GLU: ref = d0 / (1.f + expf(-d1)); break; case M_MUL: ref = d0 * d1; break; case M_ASILUB: ref = d0 * d1 / (1.f + expf(-d1)); break;
            default: ref = log1pf(expf(d0 + a.in[I_DTB][layer * 16 + c])); break; }
        if (ti.mode == M_DT) got = ((const float*)(a.ws + ti.dst))[(size_t)row * 16 + c]; else got = bf2f(((const bf16*)(a.ws + ti.dst))[(size_t)row * ti.ld + ti.col0 + c]);
        rec_err(dbg, 5 + ti.mode, got, ref, ti.mode == M_DT ? 1e-4f : 0.03f);
    }
    const unsigned h4 = hash32(h + 31337u);
    if (s < 2048) {
        const int row = (s & 1) ? TP + (h4 % TS) : (h4 % TP), c = (h4 >> 13) & 1023;
        float sm = 0.f; for (int ch = 0; ch < 1024; ++ch) sm += chk_cfconv(a, l, row, ch);
        const float mean = sm / 1024.f; float q = 0.f; for (int ch = 0; ch < 1024; ++ch) { const float d = chk_cfconv(a, l, row, ch) - mean; q += d * d; }
        const float v = (chk_cfconv(a, l, row, c) - mean) * rsqrtf(q / 1024.f + 1e-5f) * a.in[I_CFLNW][l * 1024 + c] + a.in[I_CFLNB][l * 1024 + c];
        const float ref = v / (1.f + expf(-v)) * bf2f(((const bf16*)(a.ws + WS_CFG))[(size_t)row * 1024 + c]);
        rec_err2(dbg, 12, bf2f(ACT[(size_t)row * 4096 + 1024 + c]), ref, fabsf(ref) + 0.02f);
        const bf16* CV = (const bf16*)(a.ws + WS_CV); const bool samp = row >= TP; const int t = samp ? (row - TP) % 8 : row % PSEQ, b = samp ? (row - TP) / 8 : 0; float y = 0.f, ya = 0.f;
        for (int k = 0; k < 3; ++k) { const int tt = t - 2 + k; float xv; if (tt >= 0) xv = bf2f(CV[(size_t)(row - 2 + k) * 1024 + c]); else xv = samp ? a.in[I_CSC][(((size_t)l * SB + b) * 2 + (2 + tt)) * 1024 + c] : 0.f;
            const float tm = a.in[I_SCCW][(size_t)l * 3 * 1024 + k * 1024 + c] * xv; y += tm; ya += fabsf(tm); }
        const float cm = bf2f(((const bf16*)(a.ws + WS_CM))[(size_t)row * 1024 + c]);
        rec_err2(dbg, 13, bf2f(ACT[(size_t)row * 4096 + 2048 + c]), y * cm, ya * fabsf(cm) + 0.01f);
    }
    if (s < 4096) {
        const int b = h4 & 3, c = (h4 >> 2) & 15, hh = (h4 >> 6) & 15, p = (h4 >> 10) & 63, n = (h4 >> 16) & 127, g = hh >> 2; const int r0 = b * PSEQ + c * CHUNK;
        const float A = -expf(a.in[I_ALOG][l * HEADS + hh]); float last = 0.f; for (int i = 0; i < 128; ++i) last += DT[(size_t)(r0 + i) * 16 + hh] * A;
        float cum = 0.f, ref = 0.f, refa = 0.f;
        for (int i = 0; i < 128; ++i) { const float d = DT[(size_t)(r0 + i) * 16 + hh]; cum += d * A;
            const float tm = chk_xbc(a, l, r0 + i, 1024 + g * 128 + n) * d * expf(last - cum) * chk_xbc(a, l, r0 + i, hh * 64 + p); ref += tm; refa += fabsf(tm); }
        const float* CST = (const float*)(a.ws + WS_CST); const float* CDEC = (const float*)(a.ws + WS_CDEC);
        const size_t eo = (size_t)p * NST + n;
        rec_err2(dbg, 14, CST[((size_t)((b * NCH + c) * HEADS + hh)) * 8192 + eo], ref, refa + 1e-5f);
        rec_err2(dbg, 15, CDEC[(b * NCH + c) * HEADS + hh], expf(last), expf(last) + 1e-6f);
        float H = 0.f; for (int cc = 0; cc < c; ++cc) H = H * CDEC[(b * NCH + cc) * HEADS + hh] + CST[((size_t)((b * NCH + cc) * HEADS + hh)) * 8192 + eo];
        rec_err2(dbg, 16, bf2f(((const bf16*)(a.ws + WS_HPREV))[((size_t)((b * NCH + c) * HEADS + hh)) * 8192 + eo]), H, fabsf(H) + 1e-3f);
        for (int cc = c; cc < NCH; ++cc) H = H * CDEC[(b * NCH + cc) * HEADS + hh] + CST[((size_t)((b * NCH + cc) * HEADS + hh)) * 8192 + eo];
        rec_err2(dbg, 17, a.out[O_PSSM + ((size_t)((l * PB + b) * HEADS + hh)) * 8192 + eo], H, fabsf(H) + 1e-4f);
    }
    if (s < 1024) {
        const int row = h4 % TP, hh = (h4 >> 13) & 15, p = (h4 >> 17) & 63, g = hh >> 2; const int b = row / PSEQ, t = row % PSEQ, c = t / CHUNK, tl = t % CHUNK, r0 = b * PSEQ + c * CHUNK;
        const float A = -expf(a.in[I_ALOG][l * HEADS + hh]); float cst = 0.f; for (int i = 0; i <= tl; ++i) cst += DT[(size_t)(r0 + i) * 16 + hh] * A;
        float y = 0.f, ya = 0.f, css = 0.f;
        for (int i = 0; i <= tl; ++i) { const float d = DT[(size_t)(r0 + i) * 16 + hh]; css += d * A; float gsum = 0.f;
            for (int n = 0; n < 128; ++n) gsum += chk_xbc(a, l, row, 1536 + g * 128 + n) * chk_xbc(a, l, r0 + i, 1024 + g * 128 + n);
            const float tm = gsum * expf(cst - css) * d * chk_xbc(a, l, r0 + i, hh * 64 + p); y += tm; ya += fabsf(tm); }
        const bf16* hp = (const bf16*)(a.ws + WS_HPREV) + ((size_t)((b * NCH + c) * HEADS + hh)) * 8192 + (size_t)p * NST; const float ec = expf(cst);
        for (int n = 0; n < 128; ++n) { const float tm = ec * chk_xbc(a, l, row, 1536 + g * 128 + n) * bf2f(hp[n]); y += tm; ya += fabsf(tm); }
        const float dx = a.in[I_DSKIP][l * HEADS + hh] * chk_xbc(a, l, row, hh * 64 + p), z = bf2f(Zb[(size_t)row * 1024 + hh * 64 + p]);
        rec_err2(dbg, 18, bf2f(ACT[(size_t)row * 4096 + hh * 64 + p]), (y + dx) * z, (ya + fabsf(dx)) * fabsf(z) + 1e-3f);
        const int row2 = (h4 >> 3) % TT; float q = 0.f; for (int i = 0; i < 1024; ++i) { const float v = bf2f(ACT[(size_t)row2 * 4096 + i]); q += v * v; }
        rec_err2(dbg, 19, (float)((double)((const u64*)(a.ws + WS_SSQA))[(size_t)l * TT + row2] / 1048576.0), q, q + 1e-4f);
    }
    if (s < 2048) {
        const int b = h4 & 127, hh = (h4 >> 7) & 15, p = (h4 >> 11) & 63, nsel = (h4 >> 17) & 127, g = hh >> 2; const int row0 = TP + 8 * b;
        const float A = -expf(a.in[I_ALOG][l * HEADS + hh]); float y[8] = {0.f, 0.f, 0.f, 0.f, 0.f, 0.f, 0.f, 0.f}, ya[8] = {0.f, 0.f, 0.f, 0.f, 0.f, 0.f, 0.f, 0.f}; float hfin = 0.f;
        for (int n = 0; n < 128; ++n) { float hn = a.in[I_SSM][((size_t)((l * SB + b) * HEADS + hh)) * 8192 + (size_t)p * NST + n];
#pragma unroll
            for (int t = 0; t < 8; ++t) { const float d = DT[(size_t)(row0 + t) * 16 + hh]; hn = hn * expf(d * A) + d * chk_xbc(a, l, row0 + t, hh * 64 + p) * chk_xbc(a, l, row0 + t, 1024 + g * 128 + n);
                const float tm = chk_xbc(a, l, row0 + t, 1536 + g * 128 + n) * hn; y[t] += tm; ya[t] += fabsf(tm); }
            if (n == nsel) hfin = hn; }
#pragma unroll
        for (int t = 0; t < 8; ++t) { const float dx = a.in[I_DSKIP][l * HEADS + hh] * chk_xbc(a, l, row0 + t, hh * 64 + p), z = bf2f(Zb[(size_t)(row0 + t) * 1024 + hh * 64 + p]);
            rec_err2(dbg, 20, bf2f(ACT[(size_t)(row0 + t) * 4096 + hh * 64 + p]), (y[t] + dx) * z, (ya[t] + fabsf(dx)) * fabsf(z) + 1e-3f); }
        rec_err2(dbg, 21, a.out[O_SSSM + ((size_t)((l * SB + b) * HEADS + hh)) * 8192 + (size_t)p * NST + nsel], hfin, fabsf(hfin) + 1e-3f);
    }
    if (s < 4096) {
        const int row = h4 % TP, hh = (h4 >> 13) & 15, d = (h4 >> 17) & 63, g = hh >> 2; const int t = row % PSEQ; const int klo = t - 127 < 0 ? 0 : t - 127;
        const bf16* q = (const bf16*)(a.ws + WS_Q) + (size_t)row * 1024 + hh * 64; const float sink = a.in[I_SINK][l * HEADS + hh];
        float mx = sink;
        for (int kt = klo; kt <= t; ++kt) { const bf16* kr = KV + (size_t)(row - t + kt) * 512 + g * 64; float sc = 0.f; for (int e = 0; e < 64; ++e) sc += bf2f(q[e]) * bf2f(kr[e]); mx = fmaxf(mx, sc * 0.125f); }
        float den = expf(sink - mx), o = 0.f, oa = 0.f;
        for (int kt = klo; kt <= t; ++kt) { const bf16* kr = KV + (size_t)(row - t + kt) * 512 + g * 64; float sc = 0.f; for (int e = 0; e < 64; ++e) sc += bf2f(q[e]) * bf2f(kr[e]);
            const float pp = expf(sc * 0.125f - mx); den += pp; const float tm = pp * bf2f(kr[256 + d]); o += tm; oa += fabsf(tm); }
        const float gt = bf2f(((const bf16*)(a.ws + WS_AG))[(size_t)row * 1024 + hh * 64 + d]);
        rec_err2(dbg, 22, bf2f(ACT[(size_t)row * 4096 + 3072 + hh * 64 + d]), o / den * gt, oa / den * fabsf(gt) + 1e-3f);
    }
    if (s < 4096) {
        const int b = h4 & 127, qi = (h4 >> 7) & 7, hh = (h4 >> 10) & 15, d = (h4 >> 14) & 63, g = hh >> 2; const int row = TP + 8 * b + qi;
        const bf16* q = (const bf16*)(a.ws + WS_Q) + (size_t)row * 1024 + hh * 64; const float sink = a.in[I_SINK][l * HEADS + hh];
        float mx = sink;
        for (int pass = 0; pass < 1; ++pass) for (int j = 0; j < 136; ++j) { if (j < 128 ? (j <= qi) : (j - 128 > qi)) continue; float sc = 0.f;
            for (int e = 0; e < 64; ++e) { const float kv = j < 128 ? a.in[I_CK][(((size_t)l * SB + b) * 128 + j) * 256 + g * 64 + e] : bf2f(KV[(size_t)(TP + 8 * b + j - 128) * 512 + g * 64 + e]); sc += bf2f(q[e]) * kv; }
            mx = fmaxf(mx, sc * 0.125f); }
        float den = expf(sink - mx), o = 0.f, oa = 0.f;
        for (int j = 0; j < 136; ++j) { if (j < 128 ? (j <= qi) : (j - 128 > qi)) continue; float sc = 0.f;
            for (int e = 0; e < 64; ++e) { const float kv = j < 128 ? a.in[I_CK][(((size_t)l * SB + b) * 128 + j) * 256 + g * 64 + e] : bf2f(KV[(size_t)(TP + 8 * b + j - 128) * 512 + g * 64 + e]); sc += bf2f(q[e]) * kv; }
            const float pp = expf(sc * 0.125f - mx); den += pp; const float vv = j < 128 ? a.in[I_CVV][(((size_t)l * SB + b) * 128 + j) * 256 + g * 64 + d] : bf2f(KV[(size_t)(TP + 8 * b + j - 128) * 512 + 256 + g * 64 + d]);
            const float tm = pp * vv; o += tm; oa += fabsf(tm); }
        const float gt = bf2f(((const bf16*)(a.ws + WS_AG))[(size_t)row * 1024 + hh * 64 + d]);
        rec_err2(dbg, 23, bf2f(ACT[(size_t)row * 4096 + 3072 + hh * 64 + d]), o / den * gt, oa / den * fabsf(gt) + 1e-3f);
        const int jj = (h4 >> 20) & 127; const size_t oo = (((size_t)l * SB + b) * 128 + jj) * 256 + g * 64 + d;
        const float rk = jj < 120 ? a.in[I_CK][oo + 8 * 256] : bf2f(KV[(size_t)(TP + 8 * b + jj - 120) * 512 + g * 64 + d]);
        const float rv = jj < 120 ? a.in[I_CVV][oo + 8 * 256] : bf2f(KV[(size_t)(TP + 8 * b + jj - 120) * 512 + 256 + g * 64 + d]);
        rec_err2(dbg, 24, a.out[O_SK + oo], rk, fabsf(rk) + 1e-3f); rec_err2(dbg, 24, a.out[O_SV + oo], rv, fabsf(rv) + 1e-3f);
    }
    if (s < 4096) {
        const bf16* U = (const bf16*)(a.ws + WS_U); const bf16* CV = (const bf16*)(a.ws + WS_CV); const bf16* XBC = (const bf16*)(a.ws + WS_XBC);
        const int b = h4 & 127, pb = b & 3, c = (h4 >> 7) & 1023, c2 = (h4 >> 7) & 2047, r30 = (h4 >> 18) % 30, r3 = (h4 >> 18) % 3, r2 = (h4 >> 18) & 1, jj = (h4 >> 18) & 127, c512 = (h4 >> 7) & 255;
        float ref;
        ref = bf2f(U[(size_t)(pb * PSEQ + 2018 + r30) * 1024 + c]); rec_err2(dbg, 25, a.out[O_PCCF + (((size_t)l * PB + pb) * 30 + r30) * 1024 + c], ref, fabsf(ref) + 1e-3f);
        ref = bf2f(CV[(size_t)(pb * PSEQ + 2046 + r2) * 1024 + c]); rec_err2(dbg, 25, a.out[O_PCSC + (((size_t)l * PB + pb) * 2 + r2) * 1024 + c], ref, fabsf(ref) + 1e-3f);
        ref = bf2f(XBC[(size_t)(pb * PSEQ + 2045 + r3) * 2048 + c2]); rec_err2(dbg, 25, a.out[O_PCSSM + (((size_t)l * PB + pb) * 3 + r3) * 2048 + c2], ref, fabsf(ref) + 1e-3f);
        ref = bf2f(KV[(size_t)(pb * PSEQ + 1920 + jj) * 512 + c512]); rec_err2(dbg, 25, a.out[O_PK + (((size_t)l * PB + pb) * 128 + jj) * 256 + c512], ref, fabsf(ref) + 1e-3f);
        ref = bf2f(KV[(size_t)(pb * PSEQ + 1920 + jj) * 512 + 256 + c512]); rec_err2(dbg, 25, a.out[O_PV + (((size_t)l * PB + pb) * 128 + jj) * 256 + c512], ref, fabsf(ref) + 1e-3f);
        const int row0 = TP + 8 * b;
        ref = r30 < 22 ? a.in[I_CCF][(((size_t)l * SB + b) * 30 + r30 + 8) * 1024 + c] : bf2f(U[(size_t)(row0 + r30 - 22) * 1024 + c]); rec_err2(dbg, 25, a.out[O_SCCF + (((size_t)l * SB + b) * 30 + r30) * 1024 + c], ref, fabsf(ref) + 1e-3f);
        ref = bf2f(CV[(size_t)(row0 + 6 + r2) * 1024 + c]); rec_err2(dbg, 25, a.out[O_SCSC + (((size_t)l * SB + b) * 2 + r2) * 1024 + c], ref, fabsf(ref) + 1e-3f);
        ref = bf2f(XBC[(size_t)(row0 + 5 + r3) * 2048 + c2]); rec_err2(dbg, 25, a.out[O_SCSSM + (((size_t)l * SB + b) * 3 + r3) * 2048 + c2], ref, fabsf(ref) + 1e-3f);
    }
    if (s < 4096) {
        const int row = h4 % TT, col = (h4 >> 14) % DM; float ref = 0.f, refa = 0.f;
        for (int br = 0; br < 4; ++br) { const bf16* ar = ACT + (size_t)row * 4096 + br * 1024; const bf16* wr = (const bf16*)(a.ws + WS_W2T + l * W2T_L) + (size_t)col * 4096 + br * 1024; float d = 0.f, da = 0.f;
            for (int k = 0; k < 1024; ++k) { const float tm = bf2f(ar[k]) * bf2f(wr[k]); d += tm; da += fabsf(tm); }
            const float gt = bf2f(((const bf16*)(a.ws + WS_MG))[(size_t)row * 8192 + br * 2048 + col]) * (br == 0 ? ssq_to_rstd(((const u64*)(a.ws + WS_SSQA))[(size_t)l * TT + row], 1.f / 1024.f, 1e-5f) : 1.f);
            ref += gt * d; refa += fabsf(gt) * da; }
        rec_err2(dbg, 26, bf2f(((const bf16*)(a.ws + WS_H))[(size_t)row * DM + col]), ref, refa + 1e-3f);
    }
}
__global__ void chk_init(Args a) { float* dbg = (float*)(a.ws + WS_DBG); if (threadIdx.x < NSTAGE) dbg[threadIdx.x] = 0.f; }
__global__ void chk_encode(Args a, int out_size) {
    const float* dbg = (const float*)(a.ws + WS_DBG);
    const size_t i0 = (size_t)blockIdx.x * blockDim.x + threadIdx.x, n = (size_t)gridDim.x * blockDim.x;
    for (size_t i = i0; i < (size_t)out_size; i += n) a.out[i] = 0.f;
    if (i0 == 0) {
        const float tol[NSTAGE] = {0.01f, 1e-3f, 0.01f, 0.01f, 0.01f, 0.02f, 0.02f, 0.02f, 0.02f, 0.02f, 0.02f, 0.01f,
                                   0.02f, 0.02f, 0.02f, 1e-3f, 0.01f, 1e-3f, 0.02f, 0.01f, 0.02f, 1e-3f, 0.02f, 0.02f, 0.01f, 0.01f, 0.02f, 0.01f, 0.02f, 2e-3f};
        float code = 9.9e8f;
        for (int st = 0; st < 30; ++st) { const float e = dbg[st]; if (!(e <= tol[st]) || e == 0.f) { const int bucket = e == 0.f ? 5 : (e < 1e-2f ? 0 : (e < 1e-1f ? 1 : (e < 1.f ? 2 : (e < 10.f ? 3 : 4)))); code = (float)(10 + st) * 100.f * powf(10.f, (float)bucket); break; } }
        a.out[0] = code;
    }
}
#endif


#if PROBE_TIMING
__global__ void timing_encode(Args a) {
    const u64* ts = (const u64*)(a.ws + WS_DBG) + 64;
    float sum = 0.f;
    for (int k = 0; k < 14; ++k) { const float d = (float)(ts[k + 1] - ts[k]) * 0.01f; const int j = (k >= 1 && k <= 12) ? (k - 1) % 6 : -1;
        bool take = false;
        if (PROBE_TIMING == 1) take = (j == 0);
        else if (PROBE_TIMING == 2) take = (j == 1);
        else if (PROBE_TIMING == 3) take = (j == 2 || j == 3);
        else if (PROBE_TIMING == 4) take = (k == 0);
        else if (PROBE_TIMING == 5) take = true;
        else if (PROBE_TIMING == 6) take = (j == 4);
        else if (PROBE_TIMING == 7) take = (j == 5);
        else if (PROBE_TIMING == 8) take = (k == 13);
        else if (PROBE_TIMING >= 100) take = (k == PROBE_TIMING - 100);
        if (take) sum += d; }
    a.out[O_SK] = a.in[I_CK][8 * 256] + 8.0f * log2f(sum);
}
#endif
extern "C" void kernel_launch(void* const* d_in, const int* in_sizes, int n_in, void* d_out, int out_size, void* d_ws, size_t ws_size, hipStream_t stream) {
    static int grid = 0;
    if (grid == 0) {
        int dev = 0, cus = 0, per_cu = 0;
        (void)hipGetDevice(&dev);
        (void)hipDeviceGetAttribute(&cus, hipDeviceAttributeMultiprocessorCount, dev);
        (void)hipFuncSetAttribute((const void*)mk_fwd, hipFuncAttributeMaxDynamicSharedMemorySize, LDS_BYTES);
        (void)hipOccupancyMaxActiveBlocksPerMultiprocessor(&per_cu, (const void*)mk_fwd, 512, LDS_BYTES);
        if (per_cu < 1 || n_in != 28 || ws_size < WS_END) { fprintf(stderr, "kernel_launch: unexpected environment (per_cu %d, n_in %d, ws %zu)\n", per_cu, n_in, ws_size); grid = -1; return; }
        grid = cus;
    }
    if (grid < 0) return;
    (void)hipMemsetAsync((char*)d_ws + WS_CTL, 0, CTL_BYTES, stream);
    Args a{};
    for (int i = 0; i < 28; ++i) a.in[i] = (const float*)d_in[i];
    a.out = (float*)d_out; a.ws = (unsigned char*)d_ws;
    const int NPH = 1 + NL * 6 + 1;
#if PROBE_CHECK
    chk_init<<<1, 64, 0, stream>>>(a);
#endif
#if PROBE_CHECK
    for (int p = 0; p < NPH; ++p) {
        a.ph_lo = p; a.ph_hi = p + 1;
        void* args[] = {&a};
        hipError_t e = hipLaunchCooperativeKernel((const void*)mk_fwd, dim3(grid), dim3(512), args, LDS_BYTES, stream);
        if (e != hipSuccess) fprintf(stderr, "cooperative launch failed: %s (grid %d)\n", hipGetErrorString(e), grid);
        if (p >= 1 && p < NPH - 1 && (p - 1) % 6 == 4) chk_kernel<<<64, 256, 0, stream>>>(a, (p - 1) / 6, 0);
        if (p >= 1 && p < NPH - 1 && (p - 1) % 6 == 5) chk_kernel<<<64, 256, 0, stream>>>(a, (p - 1) / 6, 1);
        if (p == NPH - 1) chk_kernel<<<64, 256, 0, stream>>>(a, 0, 2);
    }
#else
    {
        a.ph_lo = 0; a.ph_hi = NPH;
        hipLaunchKernelGGL(mk_fwd, dim3(grid), dim3(512), LDS_BYTES, stream, a);
        const hipError_t e = hipPeekAtLastError();
        if (e != hipSuccess) fprintf(stderr, "launch failed: %s (grid %d)\n", hipGetErrorString(e), grid);
    }
#endif
#if PROBE_CHECK
    chk_encode<<<256, 256, 0, stream>>>(a, out_size);
#endif
#if PROBE_TIMING
    timing_encode<<<1, 1, 0, stream>>>(a);
#endif
}
```

```cpp
#include <hip/hip_runtime.h>
#include <hip/hip_cooperative_groups.h>
#include <cstdio>
#include <cstdint>
namespace cg = cooperative_groups;

#ifndef PROBE_TIMING
#define PROBE_TIMING 0
#endif
#ifndef GEMM_MASK
#define GEMM_MASK 7
#endif
#ifndef ITEM_MASK
#define ITEM_MASK 127
#endif
#ifndef PROBE_CHECK
#define PROBE_CHECK 0
#endif

#define LAS __attribute__((address_space(3)))
typedef unsigned short bf16;
typedef short bf16x8 __attribute__((ext_vector_type(8)));
typedef float f32x4 __attribute__((ext_vector_type(4)));
typedef float f32x2 __attribute__((ext_vector_type(2)));
typedef unsigned u32x4 __attribute__((ext_vector_type(4)));
typedef unsigned u32x2 __attribute__((ext_vector_type(2)));
typedef unsigned long long u64;

constexpr int DM = 2048, TP = 8192, TS = 1024, TT = TP + TS, NL = 2;
constexpr int PB = 4, PSEQ = 2048, SB = 128, SSEQ = 8;
constexpr int IN_COLS = 21008, NT1 = 83, N1 = NT1 * 256;
constexpr int HEADS = 16, HD = 64, GROUPS = 4, NST = 128, CHUNK = 128, NCH = PSEQ / CHUNK;
constexpr int XBC_W = 2048, CFW = 1024, SCW = 1024;
constexpr int C_Z = 0, C_XBC = 1024, C_DT = 3072, C_CFA = 3088, C_CFB = 4112, C_CFG = 5136, C_GB = 6160, C_GC = 7184, C_SV = 8208, C_SCG = 9232,
              C_Q = 10256, C_K = 11280, C_V = 11536, C_AG = 11792, C_MG = 12816;

constexpr size_t MiB = 1u << 20;
constexpr size_t WS_CTL = 0, CTL_BYTES = 1 * MiB;
constexpr size_t WS_SSQ = 1 * MiB;
constexpr size_t WS_SSQA = 2 * MiB;
constexpr size_t WS_W1T = 16 * MiB;
constexpr size_t W1T_L = (size_t)N1 * DM * 2;
constexpr size_t WS_W2T = 192 * MiB;
constexpr size_t W2T_L = (size_t)DM * 4096 * 2;
constexpr size_t WS_W3T = 224 * MiB;
constexpr size_t W3T_L = (size_t)DM * DM * 2;
constexpr size_t WS_XB = 240 * MiB;
constexpr size_t WS_Z = 276 * MiB;
constexpr size_t WS_XBC = 294 * MiB;
constexpr size_t WS_U = 330 * MiB;
constexpr size_t WS_CFG = 348 * MiB;
constexpr size_t WS_CV = 366 * MiB;
constexpr size_t WS_CM = 384 * MiB;
constexpr size_t WS_Q = 402 * MiB;
constexpr size_t WS_KV = 420 * MiB;
constexpr size_t WS_AG = 429 * MiB;
constexpr size_t WS_MG = 447 * MiB;
constexpr size_t WS_DT = 591 * MiB;
constexpr size_t WS_ACT = 592 * MiB;
constexpr size_t WS_H = 664 * MiB;
constexpr size_t WS_CST = 700 * MiB;
constexpr size_t WS_HPREV = 732 * MiB;
constexpr size_t WS_CDEC = 748 * MiB;
constexpr size_t WS_DBG = 813 * MiB;
constexpr size_t WS_END = 814 * MiB;

constexpr int LDS_MISC = 147456, LDS_BYTES = LDS_MISC + 256;

__device__ __forceinline__ float bf2f(unsigned v) { return __uint_as_float(v << 16); }
typedef float f32x2c_t __attribute__((ext_vector_type(2))); typedef __bf16 bf16x2c_t __attribute__((ext_vector_type(2)));
__device__ __forceinline__ unsigned pk2(float lo, float hi) { const f32x2c_t v = {lo, hi}; const bf16x2c_t b = __builtin_convertvector(v, bf16x2c_t); return __builtin_bit_cast(unsigned, b); }
__device__ __forceinline__ unsigned f2bf(float f) { return pk2(f, 0.f) & 0xffffu; }
__device__ __forceinline__ float fsigmoid(float x) { return __builtin_amdgcn_rcpf(1.0f + __expf(-x)); }
__device__ __forceinline__ float fsilu(float x) { return x * fsigmoid(x); }
__device__ __forceinline__ float fsoftplus(float x) { return x > 15.f ? x : log1pf(__expf(x)); }
__device__ __forceinline__ float ssq_to_rstd(u64 s, float inv_n, float eps) { return rsqrtf((float)s * (inv_n * (1.0f / 1048576.0f)) + eps); }
__device__ __forceinline__ u64 ssq_fix(float s) { return (u64)((double)s * 1048576.0 + 0.5); }
#define LDS_WAIT() asm volatile("s_waitcnt lgkmcnt(0)" ::: "memory")
__device__ __forceinline__ int fresh_lane() { int ln = (int)__builtin_amdgcn_mbcnt_hi(~0u, __builtin_amdgcn_mbcnt_lo(~0u, 0u)); asm volatile("" : "+v"(ln)); return ln; }


template <int CTRL> __device__ __forceinline__ float dpp_f(float v) { return __int_as_float(__builtin_amdgcn_update_dpp(0, __float_as_int(v), CTRL, 0xf, 0xf, true)); }
__device__ __forceinline__ float red8_sum(float v) { v += dpp_f<0xB1>(v); v += dpp_f<0x4E>(v); v += dpp_f<0x141>(v); return v; }
__device__ __forceinline__ float red16_sum(float v) { v = red8_sum(v); v += dpp_f<0x140>(v); return v; }
__device__ __forceinline__ float red16_max(float v) { v = fmaxf(v, dpp_f<0xB1>(v)); v = fmaxf(v, dpp_f<0x4E>(v)); v = fmaxf(v, dpp_f<0x141>(v)); v = fmaxf(v, dpp_f<0x140>(v)); return v; }
__device__ __forceinline__ float rl_f(float v, int l) { return __int_as_float(__builtin_amdgcn_readlane(__float_as_int(v), l)); }
__device__ __forceinline__ float xor16_f(float v) { auto r = __builtin_amdgcn_permlane16_swap(__float_as_uint(v), __float_as_uint(v), false, false); return __uint_as_float(r[0] ^ r[1] ^ __float_as_uint(v)); }
__device__ __forceinline__ float xor32_f(float v) { auto r = __builtin_amdgcn_permlane32_swap(__float_as_uint(v), __float_as_uint(v), false, false); return __uint_as_float(r[0] ^ r[1] ^ __float_as_uint(v)); }

struct TileInfo { int mode, src0, src1, valid0, valid1; size_t dst; int ld, col0; };
enum { M_ID = 0, M_SILU = 1, M_SIG = 2, M_GLU = 3, M_MUL = 4, M_ASILUB = 5, M_DT = 6, M_SIGR = 7 };
__host__ __device__ __forceinline__ TileInfo tile_info(int pn) {
    TileInfo t; t.valid0 = 128; t.valid1 = 128;
    if (pn < 4)       { t.mode = M_SILU;   t.src0 = C_Z + 256 * pn;           t.src1 = t.src0 + 128; t.dst = WS_Z;   t.ld = 1024; t.col0 = 256 * pn; }
    else if (pn < 12) { t.mode = M_ID;     t.src0 = C_XBC + 256 * (pn - 4);   t.src1 = t.src0 + 128; t.dst = WS_XBC; t.ld = 2048; t.col0 = 256 * (pn - 4); }
    else if (pn < 20) { t.mode = M_GLU;    t.src0 = C_CFA + 128 * (pn - 12);  t.src1 = C_CFB + 128 * (pn - 12); t.dst = WS_U; t.ld = 1024; t.col0 = 128 * (pn - 12); }
    else if (pn < 24) { t.mode = M_SILU;   t.src0 = C_CFG + 256 * (pn - 20);  t.src1 = t.src0 + 128; t.dst = WS_CFG; t.ld = 1024; t.col0 = 256 * (pn - 20); }
    else if (pn < 32) { t.mode = M_MUL;    t.src0 = C_GC + 128 * (pn - 24);   t.src1 = C_SV + 128 * (pn - 24); t.dst = WS_CV; t.ld = 1024; t.col0 = 128 * (pn - 24); }
    else if (pn < 40) { t.mode = M_ASILUB; t.src0 = C_GB + 128 * (pn - 32);   t.src1 = C_SCG + 128 * (pn - 32); t.dst = WS_CM; t.ld = 1024; t.col0 = 128 * (pn - 32); }
    else if (pn < 44) { t.mode = M_ID;     t.src0 = C_Q + 256 * (pn - 40);    t.src1 = t.src0 + 128; t.dst = WS_Q;   t.ld = 1024; t.col0 = 256 * (pn - 40); }
    else if (pn < 46) { t.mode = M_ID;     t.src0 = C_K + 256 * (pn - 44);    t.src1 = t.src0 + 128; t.dst = WS_KV;  t.ld = 512;  t.col0 = 256 * (pn - 44); }
    else if (pn < 50) { t.mode = M_SILU;   t.src0 = C_AG + 256 * (pn - 46);   t.src1 = t.src0 + 128; t.dst = WS_AG;  t.ld = 1024; t.col0 = 256 * (pn - 46); }
    else if (pn < 82) { t.mode = M_SIGR;   t.src0 = C_MG + 64 * (pn - 50);    t.src1 = t.src0 + 4096; t.dst = WS_MG; t.ld = 8192; t.col0 = 64 * (pn - 50); }
    else              { t.mode = M_DT;     t.src0 = C_DT; t.src1 = 0; t.valid0 = 16; t.valid1 = 0; t.dst = WS_DT; t.ld = 16; t.col0 = 0; }
    return t;
}

namespace pg8 {
constexpr int BM = 256, BK = 64, HALF = 128, HTB = HALF * BK * 2, STAGE_BYTES = 8 * HTB, NXCD = 8, WGM = 4;
__host__ __device__ __forceinline__ int lds_byte(int r, int c) { const int st = (r >> 4) * 2 + (c >> 5), rr = r & 15, cc = c & 31, ob = rr * 64 + cc * 2; return st * 1024 + (ob ^ (((ob >> 9) & 1) << 5)); }
__host__ __device__ __forceinline__ void stage_rc(int b, int& R, int& C) { const int st = b / 1024, sb = b % 1024, swz = sb ^ (((sb >> 9) & 1) << 5); R = (st >> 1) * 16 + swz / 64; C = (st & 1) * 32 + (swz % 64) / 2; }
__host__ __device__ __forceinline__ int perm32(int rho) { const int n = rho >> 4, i = rho & 15; return 8 * (i >> 2) + 4 * n + (i & 3); }

struct Unit { int pm, pn, sub; };
struct Gemm { const bf16* A; const bf16* Bt; int lda, ldb, nt, ksubA, ksubB; };

struct Order {
    int nM, nN, nwg, G, c, nsub, m249;
    __device__ void init(int nM_, int nN_, int G_, int c_, int nsub_) { nM = nM_; nN = nN_; nwg = nM * nN; G = G_; c = c_; nsub = nsub_; m249 = 0; }
    __device__ bool next(int i, Unit& u) const {
        const int gi = i / nsub; u.sub = i - gi * nsub;
        int wgid;
        if (m249) {
            if (gi >= 12) return false;
            const int x = c & 7, j = c >> 3; wgid = (x ? 384 + 372 * (x - 1) : 0) + gi * (x ? 31 : 32) + j;
        } else {
            const long L = (long)gi * G + c; if (L >= nwg) return false;
            wgid = (int)L; { const int q = nwg / NXCD, r = nwg % NXCD, xcd = wgid % NXCD, off = wgid / NXCD; wgid = (xcd < r ? xcd * (q + 1) : r * (q + 1) + (xcd - r) * q) + off; }
        }
        const int nig = WGM * nN, gid = wgid / nig, fm = gid * WGM, gsz = (nM - fm) < WGM ? (nM - fm) : WGM;
        u.pm = fm + ((wgid % nig) % gsz); u.pn = (wgid % nig) / gsz; return true;
    }
};

struct ListOrder {
    int g0, g1, n, nsub, sb;
    __device__ bool next(int i, Unit& u) const {
        const int gi = i / nsub; u.sub = sb + (i - gi * nsub); if (gi >= n) return false;
        const int g = gi == 0 ? g0 : g1; u.pm = g >> 3; u.pn = g & 7; return true;
    }
};
template <class Epi, class Sched>
__device__ __forceinline__ void gemm_phase(LAS unsigned char* lds, const Gemm g, const Sched& S, const Epi& E) {
    int tid = threadIdx.x; asm volatile("" : "+v"(tid));
    const int wid = __builtin_amdgcn_readfirstlane(tid >> 6), lane = tid & 63, wr = wid >> 2, wc = wid & 3, fr = lane & 15, fq = lane >> 4;
    const int nt = g.nt;
    unsigned voffA[2], voffB[2];
#pragma unroll
    for (int i = 0; i < 2; ++i) { int R, C; stage_rc(tid * 16 + i * 8192, R, C); const int Rb = Epi::PERM ? ((R & ~31) + perm32(R & 31)) : R;
        voffA[i] = (unsigned)(R * g.lda + C) * 2u; voffB[i] = (unsigned)(Rb * g.ldb + C) * 2u; }
    const size_t kstep = (size_t)(BK * 2);
    const size_t hstepA = (size_t)HALF * g.lda * 2, hstepB = (size_t)HALF * g.ldb * 2;
    const size_t tstepA = 2 * hstepA, tstepB = 2 * hstepB;
    const unsigned ldsw = (unsigned)wid * 1024u;
    const int aoff = lds_byte(wr * 64 + fr, fq * 8), boff = lds_byte(wc * 32 + fr, fq * 8);
#define PG8_SA(b, h) (((b) * 2 + (h)) * HTB)
#define PG8_SB(b, h) ((4 + (b) * 2 + (h)) * HTB)
#define PG8_STAGE(bufoff, gbase, voff) do { _Pragma("unroll") for (int _i = 0; _i < 2; ++_i) \
        __builtin_amdgcn_global_load_lds((const unsigned*)((const char*)(gbase) + (voff)[_i]), (LAS unsigned*)(lds + (bufoff) + ldsw + _i * 8192), 16, 0, 0); } while (0)
#define PG8_LDA(dst, b, h) do { _Pragma("unroll") for (int m = 0; m < 4; ++m) _Pragma("unroll") for (int k = 0; k < 2; ++k) dst[m][k] = *(const LAS bf16x8*)(lds + PG8_SA(b, h) + aoff + m * 2048 + k * 1024); } while (0)
#define PG8_LDB(dst, b, h) do { _Pragma("unroll") for (int n = 0; n < 2; ++n) _Pragma("unroll") for (int k = 0; k < 2; ++k) dst[n][k] = *(const LAS bf16x8*)(lds + PG8_SB(b, h) + boff + n * 2048 + k * 1024); } while (0)
#define PG8_MMA(ai, bj, At, Bt) do { __builtin_amdgcn_s_setprio(1); _Pragma("unroll") for (int m = 0; m < 4; ++m) _Pragma("unroll") for (int n = 0; n < 2; ++n) _Pragma("unroll") for (int k = 0; k < 2; ++k) \
        acc[ai][bj][m][n] = __builtin_amdgcn_mfma_f32_16x16x32_bf16(Bt[n][k], At[m][k], acc[ai][bj][m][n], 0, 0, 0); __builtin_amdgcn_s_setprio(0); } while (0)
#define PG8_WAIT_V(n) asm volatile("s_waitcnt vmcnt(" #n ")" ::: "memory")
#define PG8_WAIT_L(n) asm volatile("s_waitcnt lgkmcnt(" #n ")" ::: "memory")
#define PG8_BAR __builtin_amdgcn_s_barrier()
#define PG8_SCHED __builtin_amdgcn_sched_barrier(0)
    Unit cur, nxt; int ui = 0;
    if (!S.next(0, cur)) return;
    f32x4 acc[2][2][4][2];
#pragma unroll
    for (int a = 0; a < 2; ++a)
#pragma unroll
        for (int b = 0; b < 2; ++b)
#pragma unroll
            for (int m = 0; m < 4; ++m)
#pragma unroll
                for (int n = 0; n < 2; ++n) acc[a][b][m][n] = (f32x4){0.f, 0.f, 0.f, 0.f};
    bf16x8 At[4][2], B0[2][2], B1[2][2];
    const char* cA = (const char*)g.A + (size_t)cur.pm * tstepA + (size_t)cur.sub * g.ksubA * 2; const char* cB = (const char*)g.Bt + (size_t)cur.pn * tstepB + (size_t)cur.sub * g.ksubB * 2;
    E.prefetch(cur, lds, 0);
    PG8_STAGE(PG8_SB(0, 0), cB, voffB); PG8_STAGE(PG8_SB(0, 1), cB + hstepB, voffB); PG8_STAGE(PG8_SA(0, 0), cA, voffA); PG8_STAGE(PG8_SA(0, 1), cA + hstepA, voffA);
    if (wr == 1) PG8_BAR;
    PG8_WAIT_V(2); PG8_BAR;
    PG8_STAGE(PG8_SB(1, 0), cB + kstep, voffB); PG8_STAGE(PG8_SA(1, 0), cA + kstep, voffA); PG8_STAGE(PG8_SB(1, 1), cB + hstepB + kstep, voffB);
    PG8_WAIT_V(6); PG8_BAR;
    for (;;) {
        const bool has_next = S.next(ui + 1, nxt);
        const char* nA = has_next ? (const char*)g.A + (size_t)nxt.pm * tstepA + (size_t)nxt.sub * g.ksubA * 2 : cA;
        const char* nB = has_next ? (const char*)g.Bt + (size_t)nxt.pn * tstepB + (size_t)nxt.sub * g.ksubB * 2 : cB;
        for (int t = 0; t < nt; t += 2) {
            const bool last = (t == nt - 2);
            const char* a1 = cA + (size_t)(t + 1) * kstep;
            const char* a2 = last ? nA : cA + (size_t)(t + 2) * kstep; const char* b2 = last ? nB : cB + (size_t)(t + 2) * kstep;
            const char* a3 = a2 + kstep; const char* b3 = b2 + kstep;
            PG8_LDB(B0, 0, 0); PG8_LDB(B1, 0, 1); PG8_SCHED; PG8_LDA(At, 0, 0); PG8_STAGE(PG8_SA(1, 1), a1 + hstepA, voffA);
            PG8_WAIT_V(8); PG8_WAIT_L(0); PG8_BAR; PG8_MMA(0, 0, At, B0); PG8_MMA(0, 1, At, B1); PG8_BAR; PG8_SCHED;
            PG8_LDA(At, 0, 1); PG8_STAGE(PG8_SB(0, 0), b2, voffB); PG8_STAGE(PG8_SB(0, 1), b2 + hstepB, voffB); PG8_STAGE(PG8_SA(0, 0), a2, voffA);
            PG8_WAIT_V(8); PG8_WAIT_L(0); PG8_BAR; PG8_MMA(1, 0, At, B0); PG8_MMA(1, 1, At, B1); PG8_BAR; PG8_SCHED;
            PG8_LDB(B0, 1, 0); PG8_LDB(B1, 1, 1); PG8_SCHED; PG8_LDA(At, 1, 0); PG8_STAGE(PG8_SA(0, 1), a2 + hstepA, voffA);
            PG8_WAIT_V(8); PG8_WAIT_L(0); PG8_BAR; PG8_MMA(0, 0, At, B0); PG8_MMA(0, 1, At, B1); PG8_BAR; PG8_SCHED;
            PG8_LDA(At, 1, 1); PG8_STAGE(PG8_SB(1, 0), b3, voffB); PG8_STAGE(PG8_SB(1, 1), b3 + hstepB, voffB); PG8_STAGE(PG8_SA(1, 0), a3, voffA);
            PG8_WAIT_V(8); PG8_WAIT_L(0); PG8_BAR; PG8_MMA(1, 0, At, B0); PG8_MMA(1, 1, At, B1); PG8_BAR; PG8_SCHED;
        }
        if (wr == 0) PG8_BAR;
        E(acc, cur, wr, wc, fr, fq, lds, ui & 1);
        if (!has_next) break;
        E.prefetch(nxt, lds, (ui + 1) & 1);
        if (!Epi::ACCUM || nxt.sub == 0) {
#pragma unroll
        for (int a = 0; a < 2; ++a)
#pragma unroll
            for (int b = 0; b < 2; ++b)
#pragma unroll
                for (int m = 0; m < 4; ++m)
#pragma unroll
                    for (int n = 0; n < 2; ++n) acc[a][b][m][n] = (f32x4){0.f, 0.f, 0.f, 0.f};
        }
        cur = nxt; cA = nA; cB = nB; ++ui;
        if (wr == 1) PG8_BAR;
    }
    PG8_WAIT_V(0);
    PG8_BAR;
#undef PG8_SA
#undef PG8_SB
#undef PG8_STAGE
#undef PG8_LDA
#undef PG8_LDB
#undef PG8_MMA
#undef PG8_WAIT_V
#undef PG8_WAIT_L
#undef PG8_BAR
#undef PG8_SCHED
}
}

struct Epi1 {
    static constexpr bool PERM = true, ACCUM = false;
    unsigned char* ws; const u64* ssq; const float* dt_bias;
    __device__ __forceinline__ void prefetch(const pg8::Unit& u, LAS unsigned char* lds, int slot) const {
        int t = threadIdx.x; asm volatile("" : "+v"(t));
        if (t < 256) ((LAS float*)(lds + 131072))[slot * 256 + t] = ssq_to_rstd(ssq[u.pm * 256 + t], 1.0f / 2048.0f, 1e-6f);
    }
    __device__ __forceinline__ void operator()(f32x4 (&acc)[2][2][4][2], const pg8::Unit& u, int wr, int wc, int fr, int fq, LAS unsigned char* lds, int slot) const {
        const TileInfo ti = tile_info(u.pn);
        { const int ln = fresh_lane(); fr = ln & 15; fq = ln >> 4; }
        const int row0 = u.pm * 256 + wr * 64 + fr;
        float rs[2][4];
#pragma unroll
        for (int ai = 0; ai < 2; ++ai)
#pragma unroll
            for (int m = 0; m < 4; ++m) rs[ai][m] = ((const LAS float*)(lds + 131072))[slot * 256 + wr * 64 + fr + ai * 128 + m * 16];
        const int cl = wc * 32 + 8 * fq;
        if (ti.mode == M_SIGR) {
            bf16* base = (bf16*)(ws + ti.dst) + ti.col0 + wc * 16 + 4 * fq;
#pragma unroll
            for (int ai = 0; ai < 2; ++ai)
#pragma unroll
                for (int m = 0; m < 4; ++m) { bf16* rowp = base + (size_t)(row0 + ai * 128 + m * 16) * 8192; const float r = rs[ai][m];
                    float e1[4][4];
#pragma unroll
                    for (int b = 0; b < 4; ++b)
#pragma unroll
                        for (int j = 0; j < 4; ++j) e1[b][j] = 1.0f + fminf(__expf(-(acc[ai][b >> 1][m][b & 1][j] * r)), 1e12f);
#pragma unroll
                    for (int b = 0; b < 4; ++b) { float v[4];
#pragma unroll
                        for (int j = 0; j < 4; ++j) { const float gb = __builtin_amdgcn_rcpf(e1[b][j]); v[j] = b < 3 ? gb * e1[b < 3 ? b + 1 : 3][j] : gb; }
                        u32x2 w; w.x = pk2(v[0], v[1]); w.y = pk2(v[2], v[3]);
                        *(u32x2*)(rowp + b * 2048) = w; } }
        } else if (ti.mode <= M_SIG) {
            bf16* base = (bf16*)(ws + ti.dst) + ti.col0 + cl;
#pragma unroll
            for (int ai = 0; ai < 2; ++ai)
#pragma unroll
                for (int m = 0; m < 4; ++m) { bf16* rowp = base + (size_t)(row0 + ai * 128 + m * 16) * ti.ld; const float r = rs[ai][m];
#pragma unroll
                    for (int bj = 0; bj < 2; ++bj) { float v[8];
#pragma unroll
                        for (int j = 0; j < 4; ++j) { v[j] = acc[ai][bj][m][0][j] * r; v[4 + j] = acc[ai][bj][m][1][j] * r; }
                        if (ti.mode == M_SILU) {
#pragma unroll
                            for (int j = 0; j < 8; ++j) v[j] = fsilu(v[j]); }
                        else if (ti.mode == M_SIG) {
#pragma unroll
                            for (int j = 0; j < 8; ++j) v[j] = fsigmoid(v[j]); }
                        u32x4 w; w.x = pk2(v[0], v[1]); w.y = pk2(v[2], v[3]); w.z = pk2(v[4], v[5]); w.w = pk2(v[6], v[7]);
                        *(u32x4*)(rowp + bj * 128) = w; } }
        } else if (ti.mode != M_DT) {
            bf16* base = (bf16*)(ws + ti.dst) + ti.col0 + cl;
#pragma unroll
            for (int ai = 0; ai < 2; ++ai)
#pragma unroll
                for (int m = 0; m < 4; ++m) { bf16* rowp = base + (size_t)(row0 + ai * 128 + m * 16) * ti.ld; const float r = rs[ai][m]; float v[8];
#pragma unroll
                    for (int j = 0; j < 8; ++j) { const float a = acc[ai][0][m][j >> 2][j & 3] * r, b = acc[ai][1][m][j >> 2][j & 3] * r;
                        v[j] = ti.mode == M_GLU ? a * fsigmoid(b) : (ti.mode == M_MUL ? a * b : a * fsilu(b)); }
                    u32x4 w; w.x = pk2(v[0], v[1]); w.y = pk2(v[2], v[3]); w.z = pk2(v[4], v[5]); w.w = pk2(v[6], v[7]);
                    *(u32x4*)rowp = w; }
        } else {
            if (wc == 0 && fq < 2) {
                float* base = (float*)(ws + ti.dst) + 8 * fq;
                const f32x4 b0 = *(const f32x4*)(dt_bias + 8 * fq), b1 = *(const f32x4*)(dt_bias + 8 * fq + 4);
#pragma unroll
                for (int ai = 0; ai < 2; ++ai)
#pragma unroll
                    for (int m = 0; m < 4; ++m) { float* rowp = base + (size_t)(row0 + ai * 128 + m * 16) * 16; const float r = rs[ai][m]; f32x4 o0, o1;
#pragma unroll
                        for (int j = 0; j < 4; ++j) { o0[j] = fsoftplus(acc[ai][0][m][0][j] * r + b0[j]); o1[j] = fsoftplus(acc[ai][0][m][1][j] * r + b1[j]); }
                        *(f32x4*)rowp = o0; *(f32x4*)(rowp + 4) = o1; }
            }
        }
    }
};

struct Args { const float* in[28]; float* out; unsigned char* ws; int ph_lo, ph_hi; };
enum { I_XP = 0, I_XS, I_SSM, I_CSSM, I_CCF, I_CSC, I_CK, I_CVV, I_NORMW, I_WIN, I_SCONVW, I_SCONVB, I_DTB, I_ALOG, I_DSKIP, I_SNORMW, I_WOSSM,
       I_CFCW, I_CFCB, I_CFLNW, I_CFLNB, I_WOCF, I_SCCW, I_WOSC, I_SINK, I_WOATT, I_WO, I_FNW };
#define GAS __attribute__((address_space(1)))
__device__ __forceinline__ const float* inp(const Args& a, int i) { asm volatile("" : "+s"(i)); const GAS float* q = (const GAS float*)a.in[i]; asm volatile("" : "+s"(q)); return (const float*)q; }
__device__ __forceinline__ unsigned char* wsp(const Args& a) { GAS unsigned char* w = (GAS unsigned char*)a.ws; asm volatile("" : "+s"(w)); return (unsigned char*)w; }
__device__ __forceinline__ float* outp(const Args& a) { GAS float* w = (GAS float*)a.out; asm volatile("" : "+s"(w)); return (float*)w; }

struct TrP { const float* W; size_t ldw; int src, valid; const float* ks; int k0; bf16* dst; size_t ldk; int dk0; int gm; };
__device__ __forceinline__ void tr_load(const TrP& P, int lane, f32x4 (&v)[16]) {
    const int q = lane & 15, n4 = q * 4, kq = lane >> 4;
    const int scol = P.src + (P.gm ? (q & 1) * 2048 + (q >> 3) * 16 + ((q >> 1) & 3) * 4 : n4);
#pragma unroll
    for (int i = 0; i < 16; ++i) v[i] = (n4 < P.valid) ? __builtin_nontemporal_load((const f32x4*)(P.W + (size_t)(P.k0 + 4 * i + kq) * P.ldw + scol)) : (f32x4){0.f, 0.f, 0.f, 0.f};
}
__device__ __forceinline__ void tr_finish(const TrP& P, const f32x4 (&v)[16], LAS float* scr, int lane) {
    const int n4 = (lane & 15) * 4, kq = lane >> 4;
#pragma unroll
    for (int i = 0; i < 16; ++i) { const int kk = 4 * i + kq; const float sc = P.ks ? P.ks[P.k0 + kk] : 1.f; LAS float* d = scr + kk * 65 + n4;
        d[0] = v[i].x * sc; d[1] = v[i].y * sc; d[2] = v[i].z * sc; d[3] = v[i].w * sc; }
    LDS_WAIT(); asm volatile("" ::: "memory");
    const int c = lane & 7;
#pragma unroll
    for (int j = 0; j < 8; ++j) { const int n = (lane >> 3) + 8 * j; const LAS float* sp = scr + (8 * c) * 65 + n;
        u32x4 o; o.x = pk2(sp[0 * 65], sp[1 * 65]); o.y = pk2(sp[2 * 65], sp[3 * 65]); o.z = pk2(sp[4 * 65], sp[5 * 65]); o.w = pk2(sp[6 * 65], sp[7 * 65]);
        *(u32x4*)(P.dst + (size_t)n * P.ldk + P.dk0 + P.k0 + 8 * c) = o; }
    LDS_WAIT(); asm volatile("" ::: "memory");
}
__device__ __forceinline__ float wave_sum(float v) {
    v = red16_sum(v);
    return (rl_f(v, 0) + rl_f(v, 16)) + (rl_f(v, 32) + rl_f(v, 48));
}
__device__ __forceinline__ float wave_max(float v) { v = red16_max(v); return fmaxf(fmaxf(rl_f(v, 0), rl_f(v, 16)), fmaxf(rl_f(v, 32), rl_f(v, 48))); }

__device__ __forceinline__ void phase_prologue(const Args& a, LAS unsigned char* lds, int gw, int ngw, int wave, int lane, int l_lo, int l_hi, bool do_x, int i0, int i1) {
    LAS float* scr = (LAS float*)(lds + wave * 16640);
    constexpr int I1 = (DM / 64) * (N1 / 64), I2 = 4 * (1024 / 64) * (DM / 64), I3 = (DM / 64) * (DM / 64), IL = I1 + I2 + I3;
    auto decode = [&](int it) -> TrP {
        const int l = l_lo + it / IL; int r = it % IL; TrP P;
        if (r < I1) {
            const int nb = r % (N1 / 64), kb = r / (N1 / 64), pn = nb >> 2, sb = nb & 3, half = sb >> 1;
            const TileInfo ti = tile_info(pn);
            int valid = (half ? ti.valid1 : ti.valid0) - (sb & 1) * 64; valid = valid < 0 ? 0 : (valid > 64 ? 64 : valid);
            P.W = inp(a, I_WIN) + (size_t)l * DM * IN_COLS; P.ldw = IN_COLS; P.gm = ti.mode == M_SIGR; P.src = (half ? ti.src1 : ti.src0) + (sb & 1) * (P.gm ? 32 : 64); P.valid = valid; P.ks = inp(a, I_NORMW) + l * DM; P.k0 = kb * 64;
            P.dst = (bf16*)(wsp(a) + WS_W1T + l * W1T_L) + (size_t)(nb * 64) * DM; P.ldk = DM; P.dk0 = 0; return P; }
        r -= I1;
        if (r < I2) {
            const int br = r / (I2 / 4), rr = r % (I2 / 4), nb = rr % (DM / 64), kb = rr / (DM / 64);
            P.W = inp(a, br == 0 ? I_WOSSM : (br == 1 ? I_WOCF : (br == 2 ? I_WOSC : I_WOATT))) + (size_t)l * 1024 * DM; P.ldw = DM; P.src = nb * 64; P.valid = 64; P.gm = 0;
            P.ks = br == 0 ? inp(a, I_SNORMW) + l * 1024 : nullptr; P.k0 = kb * 64;
            P.dst = (bf16*)(wsp(a) + WS_W2T + l * W2T_L) + (size_t)(nb * 64) * 4096; P.ldk = 4096; P.dk0 = br * 1024; return P; }
        r -= I2;
        { const int nb = r % (DM / 64), kb = r / (DM / 64);
          P.W = inp(a, I_WO) + (size_t)l * DM * DM; P.ldw = DM; P.src = nb * 64; P.valid = 64; P.gm = 0; P.ks = nullptr; P.k0 = kb * 64;
          P.dst = (bf16*)(wsp(a) + WS_W3T + l * W3T_L) + (size_t)(nb * 64) * DM; P.ldk = DM; P.dk0 = 0; return P; }
    };
    {
        const int nit = i1 < 0 ? (l_hi - l_lo) * IL : i1;
        if (i0 + gw < nit) {
            TrP cur = decode(i0 + gw); f32x4 v[16]; tr_load(cur, lane, v);
#pragma unroll 1
            for (int it = i0 + gw; ; ) {
                const int nx = it + ngw; const bool more = nx < nit;
                TrP nxt = cur; f32x4 vn[16];
                if (more) { nxt = decode(nx); tr_load(nxt, lane, vn); }
                tr_finish(cur, v, scr, lane);
                if (!more) break;
                cur = nxt; it = nx;
#pragma unroll
                for (int i = 0; i < 16; ++i) v[i] = vn[i];
            }
        }
    }
    if (!do_x) return;
    for (int m = gw; m < TT; m += ngw) {
        const float* xr = (m < TP) ? inp(a, I_XP) + (size_t)m * DM : inp(a, I_XS) + (size_t)(m - TP) * DM;
        const f32x4* x4 = (const f32x4*)xr + lane; u64* o8 = (u64*)((bf16*)(wsp(a) + WS_XB) + (size_t)m * DM) + lane; float s = 0.f;
#pragma unroll
        for (int j = 0; j < 8; ++j) { const f32x4 v = __builtin_nontemporal_load(x4 + 64 * j); s += (v.x * v.x + v.y * v.y) + (v.z * v.z + v.w * v.w); o8[64 * j] = (u64)pk2(v.x, v.y) | ((u64)pk2(v.z, v.w) << 32); }
        s = wave_sum(s);
        if (lane == 0) ((u64*)(wsp(a) + WS_SSQ))[m] = ssq_fix(s);
    }
    for (int i = gw * 64 + lane; i < 2 * TT; i += ngw * 64) { ((u64*)(wsp(a) + WS_SSQ))[TT + i] = 0ull; ((u64*)(wsp(a) + WS_SSQA))[i] = 0ull; }
}


constexpr size_t O_YP = 0, O_YS = 16777216, O_PSSM = 18874368, O_PCSSM = 19922944, O_PCCF = 19972096, O_PCSC = 20217856, O_PK = 20234240, O_PV = 20496384,
                 O_SSSM = 20758528, O_SCSSM = 54312960, O_SCCF = 55885824, O_SCSC = 63750144, O_SK = 64274432, O_SV = 72663040, O_TOTAL = 81051648;

template <bool SAMPLE>
__device__ __forceinline__ void conv_item(const Args& a, int l, int item, LAS unsigned char* lds, int tid, int wave, int lane) {
    asm volatile("" : "+v"(tid), "+v"(lane), "+s"(wave), "+s"(item));
    constexpr int NT = SAMPLE ? 8 : 16;
    int b, row0, t0;
    if (SAMPLE) { b = item; t0 = 0; row0 = TP + 8 * b; } else { b = item >> 7; t0 = (item & 127) * 16; row0 = b * PSEQ + t0; }
    const bf16* U = (const bf16*)(wsp(a) + WS_U); const bf16* CV = (const bf16*)(wsp(a) + WS_CV); const bf16* CM = (const bf16*)(wsp(a) + WS_CM);
    const bf16* CFG = (const bf16*)(wsp(a) + WS_CFG); const bf16* XBC = (const bf16*)(wsp(a) + WS_XBC); bf16* ACT = (bf16*)(wsp(a) + WS_ACT);
    const int c0 = 2 * tid;
    __syncthreads();
    {
        f32x2 wk[31];
        const float* cw = inp(a, I_CFCW) + (size_t)l * 31 * 1024 + c0;
#pragma unroll
        for (int k = 0; k < 31; ++k) wk[k] = *(const f32x2*)(cw + k * 1024);
        const f32x2 bias = *(const f32x2*)(inp(a, I_CFCB) + l * 1024 + c0);
        float acc0[NT], acc1[NT];
#pragma unroll
        for (int t = 0; t < NT; ++t) { acc0[t] = bias.x; acc1[t] = bias.y; }
        unsigned inw[NT + 30]; f32x2 pre[SAMPLE ? 30 : 1];
        if (SAMPLE) {
#pragma unroll
            for (int r = 0; r < 30; ++r) pre[r] = __builtin_nontemporal_load((const f32x2*)(inp(a, I_CCF) + (((size_t)l * SB + b) * 30 + r) * 1024 + c0));
#pragma unroll
            for (int r = 0; r < NT; ++r) inw[30 + r] = *(const unsigned*)(U + (size_t)(row0 + r) * 1024 + c0);
            float* o_cf = outp(a) + O_SCCF + ((size_t)l * SB + b) * 30 * 1024 + c0;
#pragma unroll
            for (int rr = 0; rr < 22; ++rr) __builtin_nontemporal_store(pre[rr + 8], (f32x2*)(o_cf + (size_t)rr * 1024));
#pragma unroll
            for (int rr = 0; rr < 8; ++rr) __builtin_nontemporal_store((f32x2){bf2f(inw[30 + rr] & 0xffffu), bf2f(inw[30 + rr] >> 16)}, (f32x2*)(o_cf + (size_t)(22 + rr) * 1024));
        } else {
#pragma unroll
            for (int i = 0; i < 12; ++i) { const int p = wave + 8 * i; if (p < 92) { const int rowi = p >> 1, half = p & 1;
                if (t0 + rowi - 30 >= 0) __builtin_amdgcn_global_load_lds((const unsigned*)(U + (size_t)(row0 + rowi - 30) * 1024 + half * 512 + lane * 8), (LAS unsigned*)(lds + rowi * 2048 + half * 1024), 16, 0, 0); } }
            asm volatile("s_waitcnt vmcnt(0)" ::: "memory"); __syncthreads(); asm volatile("" ::: "memory");
#pragma unroll
            for (int r = 0; r < NT + 30; ++r) { const unsigned w = *(const LAS unsigned*)(lds + r * 2048 + c0 * 2); inw[r] = (t0 + r - 30 < 0) ? 0u : w; }
        }
#pragma unroll
        for (int r = -30; r < NT; ++r) {
            float v0, v1;
            if (SAMPLE && r < 0) { v0 = pre[r + 30].x; v1 = pre[r + 30].y; }
            else { const unsigned w = inw[r + 30]; v0 = bf2f(w & 0xffffu); v1 = bf2f(w >> 16); }
#pragma unroll
            for (int t = 0; t < NT; ++t) { const int k = r - t + 30; if (k >= 0 && k <= 30) { acc0[t] += wk[k].x * v0; acc1[t] += wk[k].y * v1; } }
        }
        if (!SAMPLE) __syncthreads();
        LAS float* tile = (LAS float*)lds;
#pragma unroll
        for (int t = 0; t < NT; ++t) *(LAS f32x2*)(tile + t * 1024 + c0) = (f32x2){acc0[t], acc1[t]};
    }
    f32x4 lw[4], lb[4]; u32x2 gwv[NT / 8][4];
#pragma unroll
    for (int j = 0; j < 4; ++j) { const int c = 256 * j + 4 * lane; lw[j] = *(const f32x4*)(inp(a, I_CFLNW) + l * 1024 + c); lb[j] = *(const f32x4*)(inp(a, I_CFLNB) + l * 1024 + c);
#pragma unroll
        for (int tt = 0; tt < NT / 8; ++tt) gwv[tt][j] = *(const u32x2*)(CFG + (size_t)(row0 + wave + 8 * tt) * 1024 + c); }
    f32x2 w3[3]; f32x2 in[NT + 2]; unsigned inr[NT + 2], mwv[NT];
#pragma unroll
    for (int k = 0; k < 3; ++k) w3[k] = *(const f32x2*)(inp(a, I_SCCW) + (size_t)l * 3 * 1024 + k * 1024 + c0);
#pragma unroll
    for (int r = -2; r < NT; ++r) {
        if (SAMPLE && r < 0) in[r + 2] = *(const f32x2*)(inp(a, I_CSC) + (((size_t)l * SB + b) * 2 + (2 + r)) * 1024 + c0);
        else { const int rr = (!SAMPLE && t0 + r < 0) ? 0 : r; inr[r + 2] = *(const unsigned*)(CV + (size_t)(row0 + rr) * 1024 + c0); } }
#pragma unroll
    for (int t = 0; t < NT; ++t) mwv[t] = *(const unsigned*)(CM + (size_t)(row0 + t) * 1024 + c0);
    __syncthreads();
    {
        LAS float* tile = (LAS float*)lds;
#pragma unroll
        for (int tt = 0; tt < NT / 8; ++tt) {
            const int t = wave + 8 * tt; const int row = row0 + t;
            f32x4 x[4]; float s = 0.f;
#pragma unroll
            for (int j = 0; j < 4; ++j) { x[j] = *(LAS f32x4*)(tile + t * 1024 + 256 * j + 4 * lane); s += (x[j].x + x[j].y) + (x[j].z + x[j].w); }
            const float mean = wave_sum(s) * (1.f / 1024.f); float q = 0.f;
#pragma unroll
            for (int j = 0; j < 4; ++j) { x[j] = x[j] - mean; q += (x[j].x * x[j].x + x[j].y * x[j].y) + (x[j].z * x[j].z + x[j].w * x[j].w); }
            const float rstd = rsqrtf(wave_sum(q) * (1.f / 1024.f) + 1e-5f);
#pragma unroll
            for (int j = 0; j < 4; ++j) { const int c = 256 * j + 4 * lane; const u32x2 gw = gwv[tt][j];
                float y[4];
#pragma unroll
                for (int e = 0; e < 4; ++e) y[e] = fsilu(x[j][e] * rstd * lw[j][e] + lb[j][e]);
                y[0] *= bf2f(gw.x & 0xffffu); y[1] *= bf2f(gw.x >> 16); y[2] *= bf2f(gw.y & 0xffffu); y[3] *= bf2f(gw.y >> 16);
                u32x2 o; o.x = pk2(y[0], y[1]); o.y = pk2(y[2], y[3]);
                *(u32x2*)(ACT + (size_t)row * 4096 + 1024 + c) = o; }
        }
    }
    {
#pragma unroll
        for (int r = -2; r < NT; ++r) if (!(SAMPLE && r < 0)) { const unsigned w = inr[r + 2]; in[r + 2] = (!SAMPLE && t0 + r < 0) ? (f32x2){0.f, 0.f} : (f32x2){bf2f(w & 0xffffu), bf2f(w >> 16)}; }
#pragma unroll
        for (int t = 0; t < NT; ++t) {
            const unsigned mw = mwv[t];
            const float y0 = (w3[0].x * in[t].x + w3[1].x * in[t + 1].x + w3[2].x * in[t + 2].x) * bf2f(mw & 0xffffu);
            const float y1 = (w3[0].y * in[t].y + w3[1].y * in[t + 1].y + w3[2].y * in[t + 2].y) * bf2f(mw >> 16);
            *(unsigned*)(ACT + (size_t)(row0 + t) * 4096 + 2048 + c0) = pk2(y0, y1);
        }
    }
    if (SAMPLE) {
        float* o_sc = outp(a) + O_SCSC + ((size_t)l * SB + b) * 2 * 1024 + c0;
        float* o_ss = outp(a) + O_SCSSM + ((size_t)l * SB + b) * 3 * 2048 + 4 * tid;
        {   unsigned w[2]; u32x2 x[3];
#pragma unroll
            for (int rr = 0; rr < 2; ++rr) w[rr] = *(const unsigned*)(CV + (size_t)(row0 + 6 + rr) * 1024 + c0);
#pragma unroll
            for (int rr = 0; rr < 3; ++rr) x[rr] = *(const u32x2*)(XBC + (size_t)(row0 + 5 + rr) * 2048 + 4 * tid);
#pragma unroll
            for (int rr = 0; rr < 2; ++rr) *(f32x2*)(o_sc + rr * 1024) = (f32x2){bf2f(w[rr] & 0xffffu), bf2f(w[rr] >> 16)};
#pragma unroll
            for (int rr = 0; rr < 3; ++rr) *(f32x4*)(o_ss + rr * 2048) = (f32x4){bf2f(x[rr].x & 0xffffu), bf2f(x[rr].x >> 16), bf2f(x[rr].y & 0xffffu), bf2f(x[rr].y >> 16)}; }
    } else if ((item & 127) == 127) {
        const int rb = b * PSEQ;
        float* o_cf = outp(a) + O_PCCF + ((size_t)l * PB + b) * 30 * 1024 + c0;
        {   unsigned w[30];
#pragma unroll
            for (int rr = 0; rr < 30; ++rr) w[rr] = *(const unsigned*)(U + (size_t)(rb + 2018 + rr) * 1024 + c0);
#pragma unroll
            for (int rr = 0; rr < 30; ++rr) *(f32x2*)(o_cf + (size_t)rr * 1024) = (f32x2){bf2f(w[rr] & 0xffffu), bf2f(w[rr] >> 16)}; }
        float* o_sc = outp(a) + O_PCSC + ((size_t)l * PB + b) * 2 * 1024 + c0;
        float* o_ss = outp(a) + O_PCSSM + ((size_t)l * PB + b) * 3 * 2048 + 4 * tid;
        {   unsigned w[2]; u32x2 x[3];
#pragma unroll
            for (int rr = 0; rr < 2; ++rr) w[rr] = *(const unsigned*)(CV + (size_t)(rb + 2046 + rr) * 1024 + c0);
#pragma unroll
            for (int rr = 0; rr < 3; ++rr) x[rr] = *(const u32x2*)(XBC + (size_t)(rb + 2045 + rr) * 2048 + 4 * tid);
#pragma unroll
            for (int rr = 0; rr < 2; ++rr) *(f32x2*)(o_sc + rr * 1024) = (f32x2){bf2f(w[rr] & 0xffffu), bf2f(w[rr] >> 16)};
#pragma unroll
            for (int rr = 0; rr < 3; ++rr) *(f32x4*)(o_ss + rr * 2048) = (f32x4){bf2f(x[rr].x & 0xffffu), bf2f(x[rr].x >> 16), bf2f(x[rr].y & 0xffffu), bf2f(x[rr].y >> 16)}; }
        const bf16* KV = (const bf16*)(wsp(a) + WS_KV);
        {   u32x4 w[16];
#pragma unroll
            for (int i = 0; i < 16; ++i) { const int id = tid + 512 * i, jj = id >> 6, c8 = (id & 63) * 8; w[i] = *(const u32x4*)(KV + (size_t)(rb + 1920 + jj) * 512 + c8); }
#pragma unroll
            for (int i = 0; i < 16; ++i) { const int id = tid + 512 * i, jj = id >> 6, c8 = (id & 63) * 8;
                float* o = outp(a) + (c8 < 256 ? O_PK : O_PV) + (((size_t)l * PB + b) * 128 + jj) * 256 + (c8 & 255);
                *(f32x4*)o = (f32x4){bf2f(w[i].x & 0xffffu), bf2f(w[i].x >> 16), bf2f(w[i].y & 0xffffu), bf2f(w[i].y >> 16)};
                *(f32x4*)(o + 4) = (f32x4){bf2f(w[i].z & 0xffffu), bf2f(w[i].z >> 16), bf2f(w[i].w & 0xffffu), bf2f(w[i].w >> 16)}; } }
    }
}

__device__ __forceinline__ float incl_scan64(float v, int lane) {
    v += dpp_f<0x111>(v); v += dpp_f<0x112>(v); v += dpp_f<0x114>(v); v += dpp_f<0x118>(v);
    const float t0 = rl_f(v, 15), t1 = rl_f(v, 31), t2 = rl_f(v, 47); const int row = lane >> 4;
    return v + (row == 0 ? 0.f : (row == 1 ? t0 : (row == 2 ? t0 + t1 : t0 + t1 + t2)));
}
template <int MODE>
__device__ __forceinline__ void ssd_cs(const Args& a, int l, int g, int r0, LAS float* csb, LAS float* dtb, LAS float* auxb, float* cdec, int wave, int lane) {
    if (wave < 4) {
        const int h = 4 * g + wave; const float A = -__expf(inp(a, I_ALOG)[l * HEADS + h]);
        const float* DT = (const float*)(wsp(a) + WS_DT);
        const float d0 = DT[(size_t)(r0 + lane) * 16 + h], d1 = DT[(size_t)(r0 + 64 + lane) * 16 + h];
        const float s0 = incl_scan64(d0 * A, lane); const float tot0 = __shfl(s0, 63);
        const float s1 = incl_scan64(d1 * A, lane) + tot0; const float last = __shfl(s1, 63);
        csb[wave * 128 + lane] = s0; csb[wave * 128 + 64 + lane] = s1; dtb[wave * 128 + lane] = d0; dtb[wave * 128 + 64 + lane] = d1;
        if (MODE == 0) { auxb[wave * 128 + lane] = d0 * __expf(last - s0); auxb[wave * 128 + 64 + lane] = d1 * __expf(last - s1); if (lane == 0) cdec[h] = __expf(last); }
        else { auxb[wave * 128 + lane] = __expf(s0); auxb[wave * 128 + 64 + lane] = __expf(s1); }
    }
}
struct ConvIn { u32x2 raw[11]; f32x4 w[4]; f32x4 bias; };
__device__ __forceinline__ void xbc_conv_load(const Args& a, int l, int r0, bool first_chunk, int l0, int col, ConvIn& ci) {
    const bf16* XBC = (const bf16*)(wsp(a) + WS_XBC);
#pragma unroll
    for (int rr = 0; rr < 11; ++rr) { const int tok = l0 - 3 + rr; const int tk = (first_chunk && tok < 0) ? 0 : tok; ci.raw[rr] = *(const u32x2*)(XBC + (size_t)(r0 + tk) * XBC_W + col); }
#pragma unroll
    for (int k = 0; k < 4; ++k) ci.w[k] = *(const f32x4*)(inp(a, I_SCONVW) + (size_t)l * 4 * XBC_W + k * XBC_W + col);
    ci.bias = *(const f32x4*)(inp(a, I_SCONVB) + l * XBC_W + col);
}
__device__ __forceinline__ void xbc_conv_compute(const ConvIn& ci, bool first_chunk, int l0, float (&o)[8][4]) {
    float in[11][4];
#pragma unroll
    for (int rr = 0; rr < 11; ++rr) { const bool z = first_chunk && (l0 - 3 + rr < 0); const u32x2 v = ci.raw[rr];
        in[rr][0] = z ? 0.f : bf2f(v.x & 0xffffu); in[rr][1] = z ? 0.f : bf2f(v.x >> 16); in[rr][2] = z ? 0.f : bf2f(v.y & 0xffffu); in[rr][3] = z ? 0.f : bf2f(v.y >> 16); }
#pragma unroll
    for (int i = 0; i < 8; ++i)
#pragma unroll
        for (int j = 0; j < 4; ++j) { float sacc = ci.bias[j];
#pragma unroll
            for (int k = 0; k < 4; ++k) sacc += ci.w[k][j] * in[i + k][j];
            o[i][j] = fsilu(sacc); }
}
constexpr int LP = 136;

__device__ __forceinline__ void ssd1_item(const Args& a, int l, int item, LAS unsigned char* lds, int tid, int wave, int lane) {
    asm volatile("" : "+v"(tid), "+v"(lane), "+s"(wave), "+s"(item));
    const int b = item >> 6, c = (item >> 2) & 15, g = item & 3; const int r0 = b * PSEQ + c * CHUNK;
    LAS float* csb = (LAS float*)lds; LAS float* w1b = csb + 512; LAS float* dtb = csb + 1024;
    LAS bf16* xwT = (LAS bf16*)(lds + 8192); LAS bf16* BT = xwT + 4 * 64 * LP;
    __syncthreads();
    {
        ConvIn c0_, c1_, c2_;
        const int tgA = tid >> 6, qA = tid & 63, tgB = (tid + 512) >> 6, qB = (tid + 512) & 63, tgC = tid >> 5, qC = tid & 31;
        xbc_conv_load(a, l, r0, c == 0, 8 * tgA, g * 256 + 4 * qA, c0_);
        xbc_conv_load(a, l, r0, c == 0, 8 * tgB, g * 256 + 4 * qB, c1_);
        xbc_conv_load(a, l, r0, c == 0, 8 * tgC, 1024 + g * 128 + 4 * qC, c2_);
        ssd_cs<0>(a, l, g, r0, csb, dtb, w1b, (float*)(wsp(a) + WS_CDEC) + (b * NCH + c) * HEADS, wave, lane);
        __syncthreads();
#pragma unroll
        for (int ti = 0; ti < 2; ++ti) { float o[8][4]; const int tg = ti ? tgB : tgA, q = ti ? qB : qA, hh = q >> 4, l0 = 8 * tg;
            xbc_conv_compute(ti ? c1_ : c0_, c == 0, l0, o);
#pragma unroll
            for (int j = 0; j < 4; ++j) { float v[8];
#pragma unroll
                for (int i = 0; i < 8; ++i) v[i] = o[i][j] * w1b[hh * 128 + l0 + i];
                u32x4 w; w.x = pk2(v[0], v[1]); w.y = pk2(v[2], v[3]); w.z = pk2(v[4], v[5]); w.w = pk2(v[6], v[7]);
                *(LAS u32x4*)(xwT + (hh * 64 + 4 * (q & 15) + j) * LP + l0) = w; } }
        { float o[8][4]; const int l0 = 8 * tgC;
            xbc_conv_compute(c2_, c == 0, l0, o);
#pragma unroll
            for (int j = 0; j < 4; ++j) { u32x4 w; w.x = pk2(o[0][j], o[1][j]); w.y = pk2(o[2][j], o[3][j]); w.z = pk2(o[4][j], o[5][j]); w.w = pk2(o[6][j], o[7][j]);
                *(LAS u32x4*)(BT + (4 * qC + j) * LP + l0) = w; } }
    }
    __syncthreads();
    {
        const int hh = wave >> 1, ph = wave & 1, fr = lane & 15, fq = lane >> 4;
        f32x4 acc[2][8];
#pragma unroll
        for (int i = 0; i < 2; ++i)
#pragma unroll
            for (int n = 0; n < 8; ++n) acc[i][n] = (f32x4){0.f, 0.f, 0.f, 0.f};
#pragma unroll
        for (int kk = 0; kk < 4; ++kk) {
            bf16x8 af[2];
#pragma unroll
            for (int i = 0; i < 2; ++i) af[i] = *(const LAS bf16x8*)(xwT + (hh * 64 + ph * 32 + i * 16 + fr) * LP + kk * 32 + 8 * fq);
#pragma unroll
            for (int n = 0; n < 8; ++n) { const bf16x8 bfr = *(const LAS bf16x8*)(BT + (n * 16 + fr) * LP + kk * 32 + 8 * fq);
#pragma unroll
                for (int i = 0; i < 2; ++i) acc[i][n] = __builtin_amdgcn_mfma_f32_16x16x32_bf16(af[i], bfr, acc[i][n], 0, 0, 0); }
        }
        float* cst = (float*)(wsp(a) + WS_CST) + ((size_t)((b * NCH + c) * HEADS + 4 * g + hh)) * (HD * NST);
#pragma unroll
        for (int i = 0; i < 2; ++i)
#pragma unroll
            for (int n = 0; n < 8; ++n)
#pragma unroll
                for (int r = 0; r < 4; ++r) cst[(size_t)(ph * 32 + i * 16 + 4 * fq + r) * NST + n * 16 + fr] = acc[i][n][r];
    }
}

__device__ __forceinline__ void ssd_scan_phase(const Args& a, int l, int gthread, int nthreads) {
    const float* CST = (const float*)(wsp(a) + WS_CST); const float* CDEC = (const float*)(wsp(a) + WS_CDEC); bf16* HP = (bf16*)(wsp(a) + WS_HPREV);
    for (int idx = gthread; idx < PB * HEADS * 2048; idx += nthreads) {
        const int b = idx / (HEADS * 2048), h = (idx / 2048) % HEADS, e4 = idx % 2048;
        f32x4 H = (f32x4){0.f, 0.f, 0.f, 0.f};
#pragma unroll 1
        for (int c0 = 0; c0 < NCH; c0 += 8) {
            f32x4 sv[8]; float dv[8];
#pragma unroll
            for (int c = 0; c < 8; ++c) { sv[c] = *(const f32x4*)(CST + ((size_t)((b * NCH + c0 + c) * HEADS + h)) * (HD * NST) + 4 * e4); dv[c] = CDEC[(b * NCH + c0 + c) * HEADS + h]; }
#pragma unroll
            for (int c = 0; c < 8; ++c) { const size_t o = ((size_t)((b * NCH + c0 + c) * HEADS + h)) * (HD * NST) + 4 * e4;
                u32x2 w; w.x = pk2(H.x, H.y); w.y = pk2(H.z, H.w); *(u32x2*)(HP + o) = w;
                H = H * dv[c] + sv[c]; }
        }
        *(f32x4*)(outp(a) + O_PSSM + ((size_t)((l * PB + b) * HEADS + h)) * (HD * NST) + 4 * e4) = H;
    }
}

__device__ __forceinline__ void ssd2_item(const Args& a, int l, int item, LAS unsigned char* lds, int tid, int wave, int lane) {
    asm volatile("" : "+v"(tid), "+v"(lane), "+s"(wave), "+s"(item));
    const int b = item >> 6, c = (item >> 2) & 15, g = item & 3; const int r0 = b * PSEQ + c * CHUNK;
    LAS float* csb = (LAS float*)lds; LAS float* ecs = csb + 512; LAS float* dtb = csb + 1024;
    LAS bf16* Cimg = (LAS bf16*)(lds + 8192); LAS bf16* Bimg = Cimg + 128 * LP; LAS bf16* xT = Bimg + 128 * LP;
    const int fr = lane & 15, fq = lane >> 4;
    __syncthreads();
    {
        const int tgA = tid >> 6, qA = tid & 63, tgB = (tid + 512) >> 6, qB = (tid + 512) & 63, tgC = tid >> 5, qC = tid & 31;
        {   ConvIn c0_, c1_;
            xbc_conv_load(a, l, r0, c == 0, 8 * tgA, g * 256 + 4 * qA, c0_);
            xbc_conv_load(a, l, r0, c == 0, 8 * tgB, g * 256 + 4 * qB, c1_);
            ssd_cs<1>(a, l, g, r0, csb, dtb, ecs, nullptr, wave, lane);
#pragma unroll
            for (int ti = 0; ti < 2; ++ti) { float o[8][4]; const int tg = ti ? tgB : tgA, q = ti ? qB : qA, hh = q >> 4, l0 = 8 * tg;
                xbc_conv_compute(ti ? c1_ : c0_, c == 0, l0, o);
#pragma unroll
                for (int j = 0; j < 4; ++j) { u32x4 w; w.x = pk2(o[0][j], o[1][j]); w.y = pk2(o[2][j], o[3][j]); w.z = pk2(o[4][j], o[5][j]); w.w = pk2(o[6][j], o[7][j]);
                    *(LAS u32x4*)(xT + (hh * 64 + 4 * (q & 15) + j) * LP + l0) = w; } } }
        {   ConvIn c2_, c3_;
            xbc_conv_load(a, l, r0, c == 0, 8 * tgC, 1024 + g * 128 + 4 * qC, c2_);
            xbc_conv_load(a, l, r0, c == 0, 8 * tgC, 1536 + g * 128 + 4 * qC, c3_);
#pragma unroll
            for (int ti = 0; ti < 2; ++ti) { float o[8][4]; const int l0 = 8 * tgC; LAS bf16* img = ti == 0 ? Bimg : Cimg;
                xbc_conv_compute(ti ? c3_ : c2_, c == 0, l0, o);
#pragma unroll
                for (int i = 0; i < 8; ++i) { u32x2 w; w.x = pk2(o[i][0], o[i][1]); w.y = pk2(o[i][2], o[i][3]); *(LAS u32x2*)(img + (l0 + i) * LP + 4 * qC) = w; } } }
    }
    __syncthreads();
    bf16x8 cf[4];
#pragma unroll
    for (int kk = 0; kk < 4; ++kk) cf[kk] = *(const LAS bf16x8*)(Cimg + (16 * wave + fr) * LP + kk * 32 + 8 * fq);
    f32x4 cb[8];
#pragma unroll
    for (int st = 0; st < 8; ++st) { cb[st] = (f32x4){0.f, 0.f, 0.f, 0.f};
        if (st <= wave) {
#pragma unroll
            for (int kk = 0; kk < 4; ++kk) { const bf16x8 bfr = *(const LAS bf16x8*)(Bimg + (st * 16 + fr) * LP + kk * 32 + 8 * fq);
                cb[st] = __builtin_amdgcn_mfma_f32_16x16x32_bf16(cf[kk], bfr, cb[st], 0, 0, 0); } } }
    __syncthreads();
    LAS bf16* Mst = Bimg + wave * 16 * LP;
    const bf16* Zb = (const bf16*)(wsp(a) + WS_Z); bf16* ACT = (bf16*)(wsp(a) + WS_ACT);
    float ssq[4] = {0.f, 0.f, 0.f, 0.f};
#pragma unroll 1
    for (int hh = 0; hh < 4; ++hh) {
        const int h = 4 * g + hh;
        float csl[4];
#pragma unroll
        for (int r = 0; r < 4; ++r) csl[r] = csb[hh * 128 + 16 * wave + 4 * fq + r];
        const bf16* hp = (const bf16*)(wsp(a) + WS_HPREV) + ((size_t)((b * NCH + c) * HEADS + h)) * (HD * NST);
        bf16x8 hf[4][4]; u32x4 zw[2];
#pragma unroll
        for (int pt = 0; pt < 4; ++pt)
#pragma unroll
            for (int kk = 0; kk < 4; ++kk) hf[pt][kk] = *(const bf16x8*)(hp + (size_t)(pt * 16 + fr) * NST + kk * 32 + 8 * fq);
        {   const bf16* zp = Zb + (size_t)(r0 + 16 * wave + (lane >> 2)) * 1024 + h * 64 + 16 * (lane & 3);
            zw[0] = *(const u32x4*)zp; zw[1] = *(const u32x4*)(zp + 8); }
#pragma unroll
        for (int st = 0; st < 8; ++st) if (st <= (wave | 1)) {
            const int s = st * 16 + fr; const float css = csb[hh * 128 + s], dts = dtb[hh * 128 + s];
#pragma unroll
            for (int r = 0; r < 4; ++r) { const int lr = 16 * wave + 4 * fq + r; const float v = (s <= lr) ? cb[st][r] * __expf(csl[r] - css) * dts : 0.f;
                Mst[(4 * fq + r) * LP + s] = (bf16)f2bf(v); } }
        asm volatile("s_waitcnt lgkmcnt(0)" ::: "memory");
        f32x4 y[4];
#pragma unroll
        for (int pt = 0; pt < 4; ++pt) { y[pt] = (f32x4){0.f, 0.f, 0.f, 0.f};
#pragma unroll
            for (int kk = 0; kk < 4; ++kk) y[pt] = __builtin_amdgcn_mfma_f32_16x16x32_bf16(cf[kk], hf[pt][kk], y[pt], 0, 0, 0); }
#pragma unroll
        for (int r = 0; r < 4; ++r) { const float e = ecs[hh * 128 + 16 * wave + 4 * fq + r];
#pragma unroll
            for (int pt = 0; pt < 4; ++pt) y[pt][r] *= e; }
#pragma unroll
        for (int kk = 0; kk < 4; ++kk) if (kk <= (wave >> 1)) {
            const bf16x8 mf = *(const LAS bf16x8*)(Mst + fr * LP + kk * 32 + 8 * fq);
#pragma unroll
            for (int pt = 0; pt < 4; ++pt) { const bf16x8 xf = *(const LAS bf16x8*)(xT + (hh * 64 + pt * 16 + fr) * LP + kk * 32 + 8 * fq);
                y[pt] = __builtin_amdgcn_mfma_f32_16x16x32_bf16(mf, xf, y[pt], 0, 0, 0); } }
        asm volatile("s_waitcnt lgkmcnt(0)" ::: "memory");
        const float Dh = inp(a, I_DSKIP)[l * HEADS + h];
        LAS float* Ost = (LAS float*)Mst;
#pragma unroll
        for (int pt = 0; pt < 4; ++pt) { const int p = pt * 16 + fr;
            const u32x2 xw = *(const LAS u32x2*)(xT + (hh * 64 + p) * LP + 16 * wave + 4 * fq);
            const float xv[4] = {bf2f(xw.x & 0xffffu), bf2f(xw.x >> 16), bf2f(xw.y & 0xffffu), bf2f(xw.y >> 16)};
#pragma unroll
            for (int r = 0; r < 4; ++r) Ost[(4 * fq + r) * 68 + p] = y[pt][r] + Dh * xv[r]; }
        asm volatile("s_waitcnt lgkmcnt(0)" ::: "memory");
        {   const int lr = lane >> 2, ch = lane & 3; const size_t row = (size_t)(r0 + 16 * wave + lr);
            float v[16];
#pragma unroll
            for (int q4 = 0; q4 < 4; ++q4) { const f32x4 t4 = *(const LAS f32x4*)(Ost + lr * 68 + 16 * ch + 4 * q4); v[4 * q4] = t4.x; v[4 * q4 + 1] = t4.y; v[4 * q4 + 2] = t4.z; v[4 * q4 + 3] = t4.w; }
            const unsigned zz[8] = {zw[0].x, zw[0].y, zw[0].z, zw[0].w, zw[1].x, zw[1].y, zw[1].z, zw[1].w};
#pragma unroll
            for (int e = 0; e < 8; ++e) { v[2 * e] *= bf2f(zz[e] & 0xffffu); v[2 * e + 1] *= bf2f(zz[e] >> 16); ssq[0] += v[2 * e] * v[2 * e] + v[2 * e + 1] * v[2 * e + 1]; }
            u32x4 o0, o1; o0.x = pk2(v[0], v[1]); o0.y = pk2(v[2], v[3]); o0.z = pk2(v[4], v[5]); o0.w = pk2(v[6], v[7]); o1.x = pk2(v[8], v[9]); o1.y = pk2(v[10], v[11]); o1.z = pk2(v[12], v[13]); o1.w = pk2(v[14], v[15]);
            bf16* op = ACT + row * 4096 + h * 64 + 16 * ch; *(u32x4*)op = o0; *(u32x4*)(op + 8) = o1; }
        asm volatile("s_waitcnt lgkmcnt(0)" ::: "memory");
    }
    {   float s_ = ssq[0]; s_ += dpp_f<0xB1>(s_); s_ += dpp_f<0x4E>(s_);
        if ((lane & 3) == 0) atomicAdd((u64*)(wsp(a) + WS_SSQA) + (size_t)l * TT + r0 + 16 * wave + (lane >> 2), ssq_fix(s_)); }
}

__device__ __forceinline__ void ssds_item(const Args& a, int l, int item, LAS unsigned char* lds, int tid, int wave, int lane) {
    asm volatile("" : "+v"(tid), "+v"(lane), "+s"(wave), "+s"(item));
    const int b = item >> 2, g = item & 3; const int row0 = TP + 8 * b;
    LAS float* xs = (LAS float*)lds; LAS float* Bs = xs + 8 * 256; LAS float* Cs = Bs + 1024; LAS float* dtv = Cs + 1024; LAS float* dA = dtv + 32;
    const bf16* XBC = (const bf16*)(wsp(a) + WS_XBC);
    const int p = tid >> 3, nq = tid & 7;
    f32x4 hv[4][4];
#pragma unroll
    for (int hh = 0; hh < 4; ++hh) { const float* sp = inp(a, I_SSM) + ((size_t)((l * SB + b) * HEADS + 4 * g + hh)) * (HD * NST) + (size_t)p * NST;
#pragma unroll
        for (int j = 0; j < 4; ++j) hv[hh][j] = *(const f32x4*)(sp + (8 * j + nq) * 4); }
    unsigned short zq[4]; float dq[4];
#pragma unroll
    for (int hh = 0; hh < 4; ++hh) { zq[hh] = ((const bf16*)(wsp(a) + WS_Z))[(size_t)(row0 + nq) * 1024 + (4 * g + hh) * 64 + p]; dq[hh] = inp(a, I_DSKIP)[l * HEADS + 4 * g + hh]; }
    __syncthreads();
    {
        const int ch = tid < 256 ? g * 256 + tid : (tid < 384 ? 1024 + g * 128 + (tid - 256) : 1536 + g * 128 + (tid - 384));
        float w[4], in[11];
#pragma unroll
        for (int k = 0; k < 4; ++k) w[k] = inp(a, I_SCONVW)[(size_t)l * 4 * XBC_W + k * XBC_W + ch];
        const float bias = inp(a, I_SCONVB)[l * XBC_W + ch];
#pragma unroll
        for (int rr = 0; rr < 3; ++rr) in[rr] = inp(a, I_CSSM)[(((size_t)l * SB + b) * 3 + rr) * XBC_W + ch];
#pragma unroll
        for (int rr = 0; rr < 8; ++rr) in[3 + rr] = bf2f(XBC[(size_t)(row0 + rr) * XBC_W + ch]);
        float dval = 0.f, aval = 0.f;
        if (tid < 32) { dval = ((const float*)(wsp(a) + WS_DT))[(size_t)(row0 + (tid & 7)) * 16 + 4 * g + (tid >> 3)]; aval = -__expf(inp(a, I_ALOG)[l * HEADS + 4 * g + (tid >> 3)]); }
#pragma unroll
        for (int t = 0; t < 8; ++t) { const float v = fsilu(bias + w[0] * in[t] + w[1] * in[t + 1] + w[2] * in[t + 2] + w[3] * in[t + 3]);
            if (tid < 256) xs[t * 256 + tid] = v; else if (tid < 384) Bs[t * 128 + tid - 256] = v; else Cs[t * 128 + tid - 384] = v; }
        if (tid < 32) { dtv[tid] = dval; dA[tid] = __expf(aval * dval); }
    }
    __syncthreads();
    bf16* ACT = (bf16*)(wsp(a) + WS_ACT);
    const size_t row = (size_t)(row0 + nq);
    float ssq = 0.f;
#pragma unroll
    for (int hh = 0; hh < 4; ++hh) {
        const int h = 4 * g + hh;
        float hr[16];
#pragma unroll
        for (int j = 0; j < 4; ++j) { hr[4 * j] = hv[hh][j].x; hr[4 * j + 1] = hv[hh][j].y; hr[4 * j + 2] = hv[hh][j].z; hr[4 * j + 3] = hv[hh][j].w; }
        float yk = 0.f;
#pragma unroll 1
        for (int t = 0; t < 8; ++t) {
            const float xv = dtv[hh * 8 + t] * xs[t * 256 + hh * 64 + p], da = dA[hh * 8 + t]; float part = 0.f;
#pragma unroll
            for (int j4 = 0; j4 < 4; ++j4) { const f32x4 bv = *(const LAS f32x4*)(Bs + t * 128 + (8 * j4 + nq) * 4), cv = *(const LAS f32x4*)(Cs + t * 128 + (8 * j4 + nq) * 4);
#pragma unroll
                for (int e = 0; e < 4; ++e) { hr[4 * j4 + e] = hr[4 * j4 + e] * da + xv * bv[e]; part += cv[e] * hr[4 * j4 + e]; } }
            part = red8_sum(part);
            yk = (nq == t) ? part : yk;
        }
        float* so = outp(a) + O_SSSM + ((size_t)((l * SB + b) * HEADS + h)) * (HD * NST) + (size_t)p * NST;
#pragma unroll
        for (int j = 0; j < 4; ++j) __builtin_nontemporal_store((f32x4){hr[4 * j], hr[4 * j + 1], hr[4 * j + 2], hr[4 * j + 3]}, (f32x4*)(so + (8 * j + nq) * 4));
        const float v = (yk + dq[hh] * xs[nq * 256 + hh * 64 + p]) * bf2f(zq[hh]);
        ACT[row * 4096 + h * 64 + p] = (bf16)f2bf(v);
        ssq += v * v;
    }
    ssq += dpp_f<0x128>(ssq); ssq += xor16_f(ssq); ssq += xor32_f(ssq);
    if ((lane >> 3) == 0) atomicAdd((u64*)(wsp(a) + WS_SSQA) + (size_t)l * TT + row, ssq_fix(ssq));
}

struct SsdsIn { f32x4 hv[4][4]; unsigned short zq[4]; float dq[4]; float w[4], pre[3], bias, dval, alog; unsigned short raw[8]; };
__device__ __forceinline__ void ssds_load(const Args& a, int l, int item, int tid, SsdsIn& S) {
    const int b = item >> 2, g = item & 3, row0 = TP + 8 * b, p = tid >> 3, nq = tid & 7;
    const bf16* XBC = (const bf16*)(wsp(a) + WS_XBC);
#pragma unroll
    for (int hh = 0; hh < 4; ++hh) { const float* sp = inp(a, I_SSM) + ((size_t)((l * SB + b) * HEADS + 4 * g + hh)) * (HD * NST) + (size_t)p * NST;
#pragma unroll
        for (int j = 0; j < 4; ++j) S.hv[hh][j] = __builtin_nontemporal_load((const f32x4*)(sp + (8 * j + nq) * 4)); }
#pragma unroll
    for (int hh = 0; hh < 4; ++hh) { S.zq[hh] = ((const bf16*)(wsp(a) + WS_Z))[(size_t)(row0 + nq) * 1024 + (4 * g + hh) * 64 + p]; S.dq[hh] = inp(a, I_DSKIP)[l * HEADS + 4 * g + hh]; }
    const int ch = tid < 256 ? g * 256 + tid : (tid < 384 ? 1024 + g * 128 + (tid - 256) : 1536 + g * 128 + (tid - 384));
#pragma unroll
    for (int k = 0; k < 4; ++k) S.w[k] = inp(a, I_SCONVW)[(size_t)l * 4 * XBC_W + k * XBC_W + ch];
    S.bias = inp(a, I_SCONVB)[l * XBC_W + ch];
#pragma unroll
    for (int rr = 0; rr < 3; ++rr) S.pre[rr] = inp(a, I_CSSM)[(((size_t)l * SB + b) * 3 + rr) * XBC_W + ch];
#pragma unroll
    for (int rr = 0; rr < 8; ++rr) S.raw[rr] = XBC[(size_t)(row0 + rr) * XBC_W + ch];
    S.dval = 0.f; S.alog = 0.f;
    if (tid < 32) { S.dval = ((const float*)(wsp(a) + WS_DT))[(size_t)(row0 + (tid & 7)) * 16 + 4 * g + (tid >> 3)]; S.alog = inp(a, I_ALOG)[l * HEADS + 4 * g + (tid >> 3)]; }
}
__device__ __forceinline__ void ssds_conv(const SsdsIn& S, LAS unsigned char* lds, int tid) {
    LAS float* xs = (LAS float*)lds; LAS float* Bs = xs + 8 * 256; LAS float* Cs = Bs + 1024; LAS float* dtv = Cs + 1024; LAS float* dA = dtv + 32;
    float in[11];
#pragma unroll
    for (int rr = 0; rr < 3; ++rr) in[rr] = S.pre[rr];
#pragma unroll
    for (int rr = 0; rr < 8; ++rr) in[3 + rr] = bf2f(S.raw[rr]);
#pragma unroll
    for (int t = 0; t < 8; ++t) { const float v = fsilu(S.bias + S.w[0] * in[t] + S.w[1] * in[t + 1] + S.w[2] * in[t + 2] + S.w[3] * in[t + 3]);
        if (tid < 256) xs[t * 256 + tid] = v; else if (tid < 384) Bs[t * 128 + tid - 256] = v; else Cs[t * 128 + tid - 384] = v; }
    if (tid < 32) { dtv[tid] = S.dval; dA[tid] = __expf(-__expf(S.alog) * S.dval); }
}
__device__ __forceinline__ void ssds_rec(const Args& a, int l, int item, const SsdsIn& S, LAS unsigned char* lds, int tid, int lane) {
    const int b = item >> 2, g = item & 3, row0 = TP + 8 * b, p = tid >> 3, nq = tid & 7;
    LAS float* xs = (LAS float*)lds; LAS float* Bs = xs + 8 * 256; LAS float* Cs = Bs + 1024; LAS float* dtv = Cs + 1024; LAS float* dA = dtv + 32;
    bf16* ACT = (bf16*)(wsp(a) + WS_ACT);
    const size_t row = (size_t)(row0 + nq);
    float ssq = 0.f;
#pragma unroll
    for (int hh = 0; hh < 4; ++hh) {
        const int h = 4 * g + hh;
        float hr[16];
#pragma unroll
        for (int j = 0; j < 4; ++j) { hr[4 * j] = S.hv[hh][j].x; hr[4 * j + 1] = S.hv[hh][j].y; hr[4 * j + 2] = S.hv[hh][j].z; hr[4 * j + 3] = S.hv[hh][j].w; }
        float yk = 0.f;
#pragma unroll 1
        for (int t = 0; t < 8; ++t) {
            const float xv = dtv[hh * 8 + t] * xs[t * 256 + hh * 64 + p], da = dA[hh * 8 + t]; float part = 0.f;
#pragma unroll
            for (int j4 = 0; j4 < 4; ++j4) { const f32x4 bv = *(const LAS f32x4*)(Bs + t * 128 + (8 * j4 + nq) * 4), cv = *(const LAS f32x4*)(Cs + t * 128 + (8 * j4 + nq) * 4);
#pragma unroll
                for (int e = 0; e < 4; ++e) { hr[4 * j4 + e] = hr[4 * j4 + e] * da + xv * bv[e]; part += cv[e] * hr[4 * j4 + e]; } }
            part = red8_sum(part);
            yk = (nq == t) ? part : yk;
        }
        float* so = outp(a) + O_SSSM + ((size_t)((l * SB + b) * HEADS + h)) * (HD * NST) + (size_t)p * NST;
#pragma unroll
        for (int j = 0; j < 4; ++j) __builtin_nontemporal_store((f32x4){hr[4 * j], hr[4 * j + 1], hr[4 * j + 2], hr[4 * j + 3]}, (f32x4*)(so + (8 * j + nq) * 4));
        const float v = (yk + S.dq[hh] * xs[nq * 256 + hh * 64 + p]) * bf2f(S.zq[hh]);
        ACT[row * 4096 + h * 64 + p] = (bf16)f2bf(v);
        ssq += v * v;
    }
    ssq += dpp_f<0x128>(ssq); ssq += xor16_f(ssq); ssq += xor32_f(ssq);
    if ((lane >> 3) == 0) atomicAdd((u64*)(wsp(a) + WS_SSQA) + (size_t)l * TT + row, ssq_fix(ssq));
}
__device__ __forceinline__ void ssds_pair(const Args& a, int l, int itA, int itB, LAS unsigned char* lds, int tid, int wave, int lane) {
    asm volatile("" : "+v"(tid), "+v"(lane), "+s"(wave), "+s"(itA), "+s"(itB));
    SsdsIn SA, SB;
    __syncthreads();
    ssds_load(a, l, itA, tid, SA);
    ssds_conv(SA, lds, tid);
    __syncthreads();
    ssds_load(a, l, itB, tid, SB);
    ssds_rec(a, l, itA, SA, lds, tid, lane);
    __syncthreads();
    ssds_conv(SB, lds, tid);
    __syncthreads();
    ssds_rec(a, l, itB, SB, lds, tid, lane);
}

constexpr int KP = 72, VP = 264;
__device__ __forceinline__ void attn_item(const Args& a, int l, int item, LAS unsigned char* lds, int tid, int wave, int lane) {
    asm volatile("" : "+v"(tid), "+v"(lane), "+s"(wave), "+s"(item));
    const int b = item >> 6, qb = (item >> 2) & 15, g = item & 3; const int r0 = b * PSEQ + qb * 128;
    LAS bf16* Kimg = (LAS bf16*)lds; LAS bf16* VT = Kimg + 256 * KP;
    const bf16* KV = (const bf16*)(wsp(a) + WS_KV); const bf16* Qb = (const bf16*)(wsp(a) + WS_Q); const bf16* AG = (const bf16*)(wsp(a) + WS_AG); bf16* ACT = (bf16*)(wsp(a) + WS_ACT);
    const int fr = lane & 15, fq = lane >> 4;
    const int hq = wave >> 1, half = wave & 1, h = 4 * g + hq;
    bf16x8 qf[4][2];
#pragma unroll
    for (int qt = 0; qt < 4; ++qt)
#pragma unroll
        for (int kk = 0; kk < 2; ++kk) qf[qt][kk] = *(const bf16x8*)(Qb + (size_t)(r0 + 64 * half + 16 * qt + fr) * 1024 + h * 64 + kk * 32 + 8 * fq);
    __syncthreads();
#pragma unroll
    for (int i = 0; i < 4; ++i) { const int id = tid + 512 * i, j = id >> 3, ch = id & 7; const int t = qb * 128 - 128 + j;
        u32x4 kw = (u32x4){0u, 0u, 0u, 0u}, vw = (u32x4){0u, 0u, 0u, 0u};
        if (t >= 0) { const bf16* rp = KV + (size_t)(b * PSEQ + t) * 512 + g * 64 + 8 * ch; kw = *(const u32x4*)rp; vw = *(const u32x4*)(rp + 256); }
        *(LAS u32x4*)(Kimg + j * KP + 8 * ch) = kw;
        const int slot = (j & ~31) + 8 * ((j & 15) >> 2) + 4 * ((j >> 4) & 1) + (j & 3);
        const unsigned vv[4] = {vw.x, vw.y, vw.z, vw.w};
#pragma unroll
        for (int e = 0; e < 8; ++e) VT[(8 * ch + e) * VP + slot] = (bf16)((vv[e >> 1] >> (16 * (e & 1))) & 0xffffu); }
    __syncthreads();

    const float L2E = 1.4426950408889634f, SC = 0.125f * L2E;
    float m[4], lsum[4]; f32x4 o[4][4];
    const float sinkv = inp(a, I_SINK)[l * HEADS + h] * L2E;
#pragma unroll
    for (int qt = 0; qt < 4; ++qt) { m[qt] = sinkv; lsum[qt] = (fq == 0) ? 1.f : 0.f;
#pragma unroll
        for (int dt = 0; dt < 4; ++dt) o[dt][qt] = (f32x4){0.f, 0.f, 0.f, 0.f}; }
#pragma unroll 1
    for (int kb = 2 * half; kb < 2 * half + 6; ++kb) {
        const int j0 = 32 * kb;
        f32x4 s[2][4];
#pragma unroll
        for (int tk = 0; tk < 2; ++tk) {
            bf16x8 kf[2];
#pragma unroll
            for (int kk = 0; kk < 2; ++kk) kf[kk] = *(const LAS bf16x8*)(Kimg + (j0 + 16 * tk + fr) * KP + kk * 32 + 8 * fq);
#pragma unroll
            for (int qt = 0; qt < 4; ++qt) { s[tk][qt] = (f32x4){0.f, 0.f, 0.f, 0.f};
#pragma unroll
                for (int kk = 0; kk < 2; ++kk) s[tk][qt] = __builtin_amdgcn_mfma_f32_16x16x32_bf16(kf[kk], qf[qt][kk], s[tk][qt], 0, 0, 0); } }
        bf16x8 pf[4];
#pragma unroll
        for (int qt = 0; qt < 4; ++qt) {
            const int qi = 64 * half + 16 * qt + fr; float bm = -INFINITY;
#pragma unroll
            for (int tk = 0; tk < 2; ++tk)
#pragma unroll
                for (int r = 0; r < 4; ++r) { const int j = j0 + 16 * tk + 4 * fq + r; const bool ok = (j > qi) && (j <= qi + 128) && (qb * 128 - 128 + j >= 0);
                    const float v = ok ? s[tk][qt][r] * SC : -INFINITY; s[tk][qt][r] = v; bm = fmaxf(bm, v); }
            bm = fmaxf(bm, xor16_f(bm)); bm = fmaxf(bm, xor32_f(bm));
            const float mn = fmaxf(m[qt], bm), al = __builtin_amdgcn_exp2f(m[qt] - mn); m[qt] = mn;
            float ps = 0.f; float pv[8];
#pragma unroll
            for (int tk = 0; tk < 2; ++tk)
#pragma unroll
                for (int r = 0; r < 4; ++r) { const float p = __builtin_amdgcn_exp2f(s[tk][qt][r] - mn); pv[4 * tk + r] = p; ps += p; }
            lsum[qt] = lsum[qt] * al + ps;
#pragma unroll
            for (int dt = 0; dt < 4; ++dt) o[dt][qt] = o[dt][qt] * al;
            u32x4 w; w.x = pk2(pv[0], pv[1]); w.y = pk2(pv[2], pv[3]); w.z = pk2(pv[4], pv[5]); w.w = pk2(pv[6], pv[7]);
            pf[qt] = __builtin_bit_cast(bf16x8, w);
        }
#pragma unroll
        for (int dt = 0; dt < 4; ++dt) { const bf16x8 vf = *(const LAS bf16x8*)(VT + (dt * 16 + fr) * VP + j0 + 8 * fq);
#pragma unroll
            for (int qt = 0; qt < 4; ++qt) o[dt][qt] = __builtin_amdgcn_mfma_f32_16x16x32_bf16(vf, pf[qt], o[dt][qt], 0, 0, 0); }
    }
    {
        LAS float* Ost = (LAS float*)(lds + 256 * KP * 2 + 64 * VP * 2) + wave * (16 * 68);
        const int oq = lane >> 2, och = lane & 3;
        u32x4 gq[4][2];
#pragma unroll
        for (int qt = 0; qt < 4; ++qt) { const bf16* gp = AG + (size_t)(r0 + 64 * half + 16 * qt + oq) * 1024 + h * 64 + 16 * och; gq[qt][0] = *(const u32x4*)gp; gq[qt][1] = *(const u32x4*)(gp + 8); }
#pragma unroll
        for (int qt = 0; qt < 4; ++qt) { float lt = lsum[qt]; lt += xor16_f(lt); lt += xor32_f(lt); const float inv = 1.f / lt;
#pragma unroll
            for (int dt = 0; dt < 4; ++dt) *(LAS f32x4*)(Ost + fr * 68 + dt * 16 + 4 * fq) = o[dt][qt] * inv;
            asm volatile("s_waitcnt lgkmcnt(0)" ::: "memory");
            float v[16];
#pragma unroll
            for (int k4 = 0; k4 < 4; ++k4) { const f32x4 t4 = *(const LAS f32x4*)(Ost + oq * 68 + 16 * och + 4 * k4); v[4 * k4] = t4.x; v[4 * k4 + 1] = t4.y; v[4 * k4 + 2] = t4.z; v[4 * k4 + 3] = t4.w; }
            asm volatile("s_waitcnt lgkmcnt(0)" ::: "memory");
            const unsigned zz[8] = {gq[qt][0].x, gq[qt][0].y, gq[qt][0].z, gq[qt][0].w, gq[qt][1].x, gq[qt][1].y, gq[qt][1].z, gq[qt][1].w};
            u32x4 o0, o1;
            o0.x = pk2(v[0] * bf2f(zz[0] & 0xffffu), v[1] * bf2f(zz[0] >> 16)); o0.y = pk2(v[2] * bf2f(zz[1] & 0xffffu), v[3] * bf2f(zz[1] >> 16));
            o0.z = pk2(v[4] * bf2f(zz[2] & 0xffffu), v[5] * bf2f(zz[2] >> 16)); o0.w = pk2(v[6] * bf2f(zz[3] & 0xffffu), v[7] * bf2f(zz[3] >> 16));
            o1.x = pk2(v[8] * bf2f(zz[4] & 0xffffu), v[9] * bf2f(zz[4] >> 16)); o1.y = pk2(v[10] * bf2f(zz[5] & 0xffffu), v[11] * bf2f(zz[5] >> 16));
            o1.z = pk2(v[12] * bf2f(zz[6] & 0xffffu), v[13] * bf2f(zz[6] >> 16)); o1.w = pk2(v[14] * bf2f(zz[7] & 0xffffu), v[15] * bf2f(zz[7] >> 16));
            bf16* op = ACT + (size_t)(r0 + 64 * half + 16 * qt + oq) * 4096 + 3072 + h * 64 + 16 * och; *(u32x4*)op = o0; *(u32x4*)(op + 8) = o1; }
    }
}

__device__ __forceinline__ void attns_item(const Args& a, int l, int item, LAS unsigned char* lds, int tid, int wave, int lane) {
    asm volatile("" : "+v"(tid), "+v"(lane), "+s"(wave), "+s"(item));
    const int b = item >> 2, g = item & 3; const int row0 = TP + 8 * b;
    LAS float* Qs = (LAS float*)lds; LAS float* Ks = Qs + 32 * 64; LAS float* Vs = Ks + 136 * 65; LAS float* Sc = Vs + 136 * 64;
    const bf16* KV = (const bf16*)(wsp(a) + WS_KV); const bf16* Qb = (const bf16*)(wsp(a) + WS_Q);
    __syncthreads();
    {
        const int qr = tid >> 4, qd = (tid & 15) * 4;
        const u32x2 qw = *(const u32x2*)(Qb + (size_t)(row0 + (qr & 7)) * 1024 + (4 * g + (qr >> 3)) * 64 + qd);
        f32x4 kc[4], vc[4];
#pragma unroll
        for (int i = 0; i < 4; ++i) { const int id = tid + 512 * i, j = id >> 4, d4 = (id & 15) * 4; const size_t o = (((size_t)l * SB + b) * 128 + j) * 256 + g * 64 + d4;
            kc[i] = *(const f32x4*)(inp(a, I_CK) + o); vc[i] = *(const f32x4*)(inp(a, I_CVV) + o); }
        u32x2 nk = (u32x2){0u, 0u}, nv = (u32x2){0u, 0u};
        if (tid < 128) { const bf16* rp = KV + (size_t)(row0 + (tid >> 4)) * 512 + g * 64 + (tid & 15) * 4; nk = *(const u32x2*)rp; nv = *(const u32x2*)(rp + 256); }
        LAS float* qd_ = Qs + qr * 64 + qd; qd_[0] = bf2f(qw.x & 0xffffu); qd_[1] = bf2f(qw.x >> 16); qd_[2] = bf2f(qw.y & 0xffffu); qd_[3] = bf2f(qw.y >> 16);
#pragma unroll
        for (int i = 0; i < 4; ++i) { const int id = tid + 512 * i, j = id >> 4, d4 = (id & 15) * 4; LAS float* kd = Ks + j * 65 + d4; kd[0] = kc[i].x; kd[1] = kc[i].y; kd[2] = kc[i].z; kd[3] = kc[i].w;
            *(LAS f32x4*)(Vs + j * 64 + d4) = vc[i]; }
        if (tid < 128) { const int j = 128 + (tid >> 4), d4 = (tid & 15) * 4; LAS float* kd = Ks + j * 65 + d4;
            kd[0] = bf2f(nk.x & 0xffffu); kd[1] = bf2f(nk.x >> 16); kd[2] = bf2f(nk.y & 0xffffu); kd[3] = bf2f(nk.y >> 16);
            *(LAS f32x4*)(Vs + j * 64 + d4) = (f32x4){bf2f(nv.x & 0xffffu), bf2f(nv.x >> 16), bf2f(nv.y & 0xffffu), bf2f(nv.y >> 16)}; }
    }
    __syncthreads();
    for (int e = tid; e < 32 * 136; e += 512) { const int r = e / 136, j = e - r * 136, qi = r & 7; float s = 0.f;
#pragma unroll 16
        for (int d = 0; d < 64; ++d) s += Qs[r * 64 + d] * Ks[j * 65 + d];
        const bool ok = j < 128 ? (j > qi) : (j - 128 <= qi);
        Sc[r * 140 + j] = ok ? s * 0.125f : -INFINITY; }
    __syncthreads();
#pragma unroll
    for (int rr = 0; rr < 4; ++rr) { const int r = 4 * wave + rr, hq = r >> 3; const float sink = inp(a, I_SINK)[l * HEADS + 4 * g + hq];
        const float s0 = Sc[r * 140 + lane], s1 = Sc[r * 140 + 64 + lane], s2 = lane < 8 ? Sc[r * 140 + 128 + lane] : -INFINITY;
        float mx = wave_max(fmaxf(fmaxf(s0, s1), s2));
        mx = fmaxf(mx, sink);
        const float p0 = __expf(s0 - mx), p1 = __expf(s1 - mx), p2 = lane < 8 ? __expf(s2 - mx) : 0.f;
        const float den = wave_sum(p0 + p1 + p2) + __expf(sink - mx), inv = 1.f / den;
        Sc[r * 140 + lane] = p0 * inv; Sc[r * 140 + 64 + lane] = p1 * inv; if (lane < 8) Sc[r * 140 + 128 + lane] = p2 * inv; }
    __syncthreads();
    {   const int r = tid >> 4, d4 = (tid & 15) * 4, hq = r >> 3, qi = r & 7; f32x4 o = (f32x4){0.f, 0.f, 0.f, 0.f};
        const size_t row = (size_t)(row0 + qi); const int col = (4 * g + hq) * 64 + d4;
        const u32x2 gw = *(const u32x2*)((const bf16*)(wsp(a) + WS_AG) + row * 1024 + col);
#pragma unroll 8
        for (int j = 0; j < 136; ++j) { const float p = Sc[r * 140 + j]; const f32x4 v = *(const LAS f32x4*)(Vs + j * 64 + d4); o = o + v * p; }
        u32x2 w; w.x = pk2(o.x * bf2f(gw.x & 0xffffu), o.y * bf2f(gw.x >> 16)); w.y = pk2(o.z * bf2f(gw.y & 0xffffu), o.w * bf2f(gw.y >> 16));
        *(u32x2*)((bf16*)(wsp(a) + WS_ACT) + row * 4096 + 3072 + col) = w; }
#pragma unroll
    for (int i = 0; i < 4; ++i) { const int id = tid + 512 * i, jj = id >> 4, d4 = (id & 15) * 4; const size_t o = (((size_t)l * SB + b) * 128 + jj) * 256 + g * 64 + d4;
        const LAS float* kd = Ks + (jj + 8) * 65 + d4;
        *(f32x4*)(outp(a) + O_SK + o) = (f32x4){kd[0], kd[1], kd[2], kd[3]}; *(f32x4*)(outp(a) + O_SV + o) = *(const LAS f32x4*)(Vs + (jj + 8) * 64 + d4); }
}

struct AttnsIn { u32x2 qw; f32x4 kc[4], vc[4]; u32x2 nk, nv; };
__device__ __forceinline__ void attns_load(const Args& a, int l, int item, int tid, AttnsIn& S) {
    const int b = item >> 2, g = item & 3, row0 = TP + 8 * b;
    const bf16* KV = (const bf16*)(wsp(a) + WS_KV); const bf16* Qb = (const bf16*)(wsp(a) + WS_Q);
    const int qr = tid >> 4, qd = (tid & 15) * 4;
    S.qw = *(const u32x2*)(Qb + (size_t)(row0 + (qr & 7)) * 1024 + (4 * g + (qr >> 3)) * 64 + qd);
#pragma unroll
    for (int i = 0; i < 4; ++i) { const int id = tid + 512 * i, j = id >> 4, d4 = (id & 15) * 4; const size_t o = (((size_t)l * SB + b) * 128 + j) * 256 + g * 64 + d4;
        S.kc[i] = __builtin_nontemporal_load((const f32x4*)(inp(a, I_CK) + o)); S.vc[i] = __builtin_nontemporal_load((const f32x4*)(inp(a, I_CVV) + o)); }
    S.nk = (u32x2){0u, 0u}; S.nv = (u32x2){0u, 0u};
    if (tid < 128) { const bf16* rp = KV + (size_t)(row0 + (tid >> 4)) * 512 + g * 64 + (tid & 15) * 4; S.nk = *(const u32x2*)rp; S.nv = *(const u32x2*)(rp + 256); }
}
__device__ __forceinline__ void attns_stage(const Args& a, int l, int item, const AttnsIn& S, LAS unsigned char* lds, int tid) {
    const int b = item >> 2, g = item & 3;
    LAS float* Qs = (LAS float*)lds; LAS float* Ks = Qs + 32 * 64; LAS float* Vs = Ks + 136 * 68;
    const int qr = tid >> 4, qd = (tid & 15) * 4;
    *(LAS f32x4*)(Qs + qr * 64 + qd) = (f32x4){bf2f(S.qw.x & 0xffffu), bf2f(S.qw.x >> 16), bf2f(S.qw.y & 0xffffu), bf2f(S.qw.y >> 16)};
#pragma unroll
    for (int i = 0; i < 4; ++i) { const int id = tid + 512 * i, j = id >> 4, d4 = (id & 15) * 4;
        *(LAS f32x4*)(Ks + j * 68 + d4) = S.kc[i]; *(LAS f32x4*)(Vs + j * 64 + d4) = S.vc[i];
        if (j >= 8) { const size_t o = (((size_t)l * SB + b) * 128 + (j - 8)) * 256 + g * 64 + d4; __builtin_nontemporal_store(S.kc[i], (f32x4*)(outp(a) + O_SK + o)); __builtin_nontemporal_store(S.vc[i], (f32x4*)(outp(a) + O_SV + o)); } }
    if (tid < 128) { const int jn = tid >> 4, d4 = (tid & 15) * 4;
        const f32x4 kf = (f32x4){bf2f(S.nk.x & 0xffffu), bf2f(S.nk.x >> 16), bf2f(S.nk.y & 0xffffu), bf2f(S.nk.y >> 16)}, vf = (f32x4){bf2f(S.nv.x & 0xffffu), bf2f(S.nv.x >> 16), bf2f(S.nv.y & 0xffffu), bf2f(S.nv.y >> 16)};
        *(LAS f32x4*)(Ks + (128 + jn) * 68 + d4) = kf; *(LAS f32x4*)(Vs + (128 + jn) * 64 + d4) = vf;
        const size_t o = (((size_t)l * SB + b) * 128 + (120 + jn)) * 256 + g * 64 + d4; *(f32x4*)(outp(a) + O_SK + o) = kf; *(f32x4*)(outp(a) + O_SV + o) = vf; }
}
__device__ __forceinline__ void attns_compute(const Args& a, int l, int item, LAS unsigned char* lds, int tid, int wave, int lane) {
    const int b = item >> 2, g = item & 3, row0 = TP + 8 * b;
    LAS float* Qs = (LAS float*)lds; LAS float* Ks = Qs + 32 * 64; LAS float* Vs = Ks + 136 * 68; LAS float* Sc = Vs + 136 * 64;
    const int r_ = tid >> 4, d4_ = (tid & 15) * 4;
    const u32x2 gw = *(const u32x2*)((const bf16*)(wsp(a) + WS_AG) + (size_t)(row0 + (r_ & 7)) * 1024 + (4 * g + (r_ >> 3)) * 64 + d4_);
    for (int e = tid; e < 32 * 136; e += 512) { const int r = e / 136, j = e - r * 136, qi = r & 7; float sacc = 0.f;
#pragma unroll
        for (int d4 = 0; d4 < 16; ++d4) { const f32x4 qv = *(const LAS f32x4*)(Qs + r * 64 + 4 * d4), kv = *(const LAS f32x4*)(Ks + j * 68 + 4 * d4); sacc += (qv.x * kv.x + qv.y * kv.y) + (qv.z * kv.z + qv.w * kv.w); }
        const bool ok = j < 128 ? (j > qi) : (j - 128 <= qi);
        Sc[r * 140 + j] = ok ? sacc * 0.125f : -INFINITY; }
    __syncthreads();
#pragma unroll
    for (int rr = 0; rr < 4; ++rr) { const int r = 4 * wave + rr, hq = r >> 3; const float sink = inp(a, I_SINK)[l * HEADS + 4 * g + hq];
        const float s0 = Sc[r * 140 + lane], s1 = Sc[r * 140 + 64 + lane], s2 = lane < 8 ? Sc[r * 140 + 128 + lane] : -INFINITY;
        float mx = wave_max(fmaxf(fmaxf(s0, s1), s2));
        mx = fmaxf(mx, sink);
        const float p0 = __expf(s0 - mx), p1 = __expf(s1 - mx), p2 = lane < 8 ? __expf(s2 - mx) : 0.f;
        const float den = wave_sum(p0 + p1 + p2) + __expf(sink - mx), inv = 1.f / den;
        Sc[r * 140 + lane] = p0 * inv; Sc[r * 140 + 64 + lane] = p1 * inv; if (lane < 8) Sc[r * 140 + 128 + lane] = p2 * inv; }
    __syncthreads();
    {   const int hq = r_ >> 3, qi = r_ & 7; f32x4 o = (f32x4){0.f, 0.f, 0.f, 0.f};
#pragma unroll 8
        for (int j = 0; j < 136; ++j) { const float pw = Sc[r_ * 140 + j]; const f32x4 v = *(const LAS f32x4*)(Vs + j * 64 + d4_); o = o + v * pw; }
        u32x2 w; w.x = pk2(o.x * bf2f(gw.x & 0xffffu), o.y * bf2f(gw.x >> 16)); w.y = pk2(o.z * bf2f(gw.y & 0xffffu), o.w * bf2f(gw.y >> 16));
        *(u32x2*)((bf16*)(wsp(a) + WS_ACT) + (size_t)(row0 + qi) * 4096 + 3072 + (4 * g + hq) * 64 + d4_) = w; }
}
__device__ __forceinline__ void attns_pair(const Args& a, int l, int itA, int itB, LAS unsigned char* lds, int tid, int wave, int lane) {
    asm volatile("" : "+v"(tid), "+v"(lane), "+s"(wave), "+s"(itA), "+s"(itB));
    AttnsIn SA, SB;
    __syncthreads();
    attns_load(a, l, itA, tid, SA);
    attns_stage(a, l, itA, SA, lds, tid);
    __syncthreads();
    attns_load(a, l, itB, tid, SB);
    attns_compute(a, l, itA, lds, tid, wave, lane);
    __syncthreads();
    attns_stage(a, l, itB, SB, lds, tid);
    __syncthreads();
    attns_compute(a, l, itB, lds, tid, wave, lane);
}

struct Epi2 {
    static constexpr bool PERM = true, ACCUM = true;
    const bf16* MG; const u64* ssqa; bf16* H;
    __device__ __forceinline__ void prefetch(const pg8::Unit&, LAS unsigned char*, int) const {}
    __device__ __forceinline__ void operator()(f32x4 (&acc)[2][2][4][2], const pg8::Unit& u, int wr, int wc, int fr, int fq, LAS unsigned char* lds, int slot) const {
        const int ln = fresh_lane(); const int frv = ln & 15, fqv = ln >> 4;
        const int row0 = u.pm * 256 + wr * 64 + frv, colb = u.pn * 256 + wc * 32 + 8 * fqv;
        u32x4 gw[3][2]; float rsa[3];
#define EPI2_LOAD(k, buf) do { const size_t row_ = (size_t)(row0 + ((k) >> 2) * 128 + ((k) & 3) * 16); \
            rsa[buf] = (u.sub == 0) ? ssq_to_rstd(ssqa[row_], 1.0f / 1024.0f, 1e-5f) : 1.0f; \
            _Pragma("unroll") for (int bj = 0; bj < 2; ++bj) gw[buf][bj] = *(const u32x4*)(MG + row_ * 8192 + colb + bj * 128 + u.sub * 2048); } while (0)
        EPI2_LOAD(0, 0); EPI2_LOAD(1, 1);
#pragma unroll
        for (int k = 0; k < 8; ++k) {
            const int ai = k >> 2, m = k & 3, buf = k % 3;
            if (k + 2 < 8) { if ((k + 2) % 3 == 0) EPI2_LOAD(k + 2, 0); else if ((k + 2) % 3 == 1) EPI2_LOAD(k + 2, 1); else EPI2_LOAD(k + 2, 2); }
            asm volatile("" ::: "memory");
            const size_t row = (size_t)(row0 + ai * 128 + m * 16);
#pragma unroll
            for (int bj = 0; bj < 2; ++bj) {
                const u32x4 a4 = gw[buf][bj];
                float g[8] = {bf2f(a4.x & 0xffffu), bf2f(a4.x >> 16), bf2f(a4.y & 0xffffu), bf2f(a4.y >> 16), bf2f(a4.z & 0xffffu), bf2f(a4.z >> 16), bf2f(a4.w & 0xffffu), bf2f(a4.w >> 16)};
#pragma unroll
                for (int j = 0; j < 8; ++j) g[j] *= rsa[buf];
                if (u.sub < 3) {
#pragma unroll
                    for (int j = 0; j < 8; ++j) acc[ai][bj][m][j >> 2][j & 3] *= g[j];
                } else {
                    float v[8];
#pragma unroll
                    for (int j = 0; j < 8; ++j) v[j] = acc[ai][bj][m][j >> 2][j & 3] * g[j];
                    u32x4 w; w.x = pk2(v[0], v[1]); w.y = pk2(v[2], v[3]); w.z = pk2(v[4], v[5]); w.w = pk2(v[6], v[7]);
                    *(u32x4*)(H + row * 2048 + colb + bj * 128) = w; } }
        }
#undef EPI2_LOAD
    }
};
struct Epi3 {
    static constexpr bool PERM = false, ACCUM = false;
    bf16* XB; u64* ssq;
    __device__ __forceinline__ void prefetch(const pg8::Unit&, LAS unsigned char*, int) const {}
    __device__ __forceinline__ void operator()(f32x4 (&acc)[2][2][4][2], const pg8::Unit& u, int wr, int wc, int fr, int fq, LAS unsigned char* lds, int slot) const {
        { const int ln = fresh_lane(); fr = ln & 15; fq = ln >> 4; }
        const int row0 = u.pm * 256 + wr * 64 + fr, col0 = u.pn * 256 + wc * 32 + 4 * fq;
        u32x2 xo[4][2][2];
#define EPI3_LOAD(k, buf) do { const int row_ = row0 + ((k) >> 2) * 128 + ((k) & 3) * 16; \
            _Pragma("unroll") for (int bj = 0; bj < 2; ++bj) _Pragma("unroll") for (int n = 0; n < 2; ++n) xo[buf][bj][n] = *(const u32x2*)(XB + (size_t)row_ * DM + col0 + bj * 128 + n * 16); } while (0)
        EPI3_LOAD(0, 0); EPI3_LOAD(1, 1); EPI3_LOAD(2, 2); EPI3_LOAD(3, 3);
#pragma unroll
        for (int k = 0; k < 8; ++k) {
            const int ai = k >> 2, m = k & 3, buf = k & 3;
            const int row = row0 + ai * 128 + m * 16; float s = 0.f;
            u32x2 cur[2][2];
#pragma unroll
            for (int bj = 0; bj < 2; ++bj)
#pragma unroll
                for (int n = 0; n < 2; ++n) cur[bj][n] = xo[buf][bj][n];
            asm volatile("" ::: "memory");
            if (k + 4 < 8) { if (buf == 0) EPI3_LOAD(k + 4, 0); else if (buf == 1) EPI3_LOAD(k + 4, 1); else if (buf == 2) EPI3_LOAD(k + 4, 2); else EPI3_LOAD(k + 4, 3); }
#pragma unroll
            for (int bj = 0; bj < 2; ++bj)
#pragma unroll
                for (int n = 0; n < 2; ++n) { const int col = col0 + bj * 128 + n * 16;
                    const u32x2 xw = cur[bj][n];
                    const f32x4 xn = (f32x4){bf2f(xw.x & 0xffffu), bf2f(xw.x >> 16), bf2f(xw.y & 0xffffu), bf2f(xw.y >> 16)} + acc[ai][bj][m][n];
                    u32x2 w; w.x = pk2(xn[0], xn[1]); w.y = pk2(xn[2], xn[3]); *(u32x2*)(XB + (size_t)row * DM + col) = w;
                    s += (xn[0] * xn[0] + xn[1] * xn[1]) + (xn[2] * xn[2] + xn[3] * xn[3]); }
            s += xor16_f(s); s += xor32_f(s);
            if (fq == 0) atomicAdd(ssq + row, ssq_fix(s));
        }
#undef EPI3_LOAD
    }
};


struct EpiP {
    static constexpr bool PERM = false, ACCUM = false;
    float* P;
    __device__ __forceinline__ void after(int, LAS unsigned char*) const {}
    __device__ __forceinline__ void prefetch(const pg8::Unit&, LAS unsigned char*, int) const {}
    __device__ __forceinline__ void operator()(f32x4 (&acc)[2][2][4][2], const pg8::Unit& u, int wr, int wc, int fr, int fq, LAS unsigned char* lds, int slot) const {
        { const int ln = fresh_lane(); fr = ln & 15; fq = ln >> 4; }
        const int row0 = (u.pm - TP / 256) * 256 + wr * 64 + fr, col0 = u.pn * 256 + wc * 32 + 4 * fq;
        float* base = P + ((size_t)u.sub * (TT - TP) + row0) * DM + col0;
#pragma unroll
        for (int ai = 0; ai < 2; ++ai)
#pragma unroll
            for (int m = 0; m < 4; ++m)
#pragma unroll
                for (int bj = 0; bj < 2; ++bj)
#pragma unroll
                    for (int n = 0; n < 2; ++n) *(f32x4*)(base + (size_t)(ai * 128 + m * 16) * DM + bj * 128 + n * 16) = acc[ai][bj][m][n];
    }
};

constexpr int CONV_I1 = (DM / 64) * (N1 / 64), CONV_IL = CONV_I1 + 4 * (1024 / 64) * (DM / 64) + (DM / 64) * (DM / 64);
constexpr int XCONV = 512;
#define XB_TMO      128
#define XB_XCNT(j)  (256  + 64 * (j))
#define XB_XSUB(j)  (1280 + 64 * (j))
#define XB_XGEN(j)  (2304 + 64 * (j))
#define XB_TOP      3328
#define XB_TOPGEN   3392
#define XCD_BAR_WORDS 3456
#define XB_SPIN_CAP (1u << 18)
__device__ __forceinline__ unsigned xb_ld(unsigned* p)              { return __hip_atomic_load(p, __ATOMIC_RELAXED, __HIP_MEMORY_SCOPE_AGENT); }
__device__ __forceinline__ unsigned xb_add(unsigned* p, unsigned v) { return __hip_atomic_fetch_add(p, v, __ATOMIC_RELAXED, __HIP_MEMORY_SCOPE_AGENT); }
__device__ __forceinline__ unsigned xb_xcc_id() { return (unsigned)__builtin_amdgcn_s_getreg((3 << 11) | 20) & 0xFu; }
#define XB_SPIN(cond, bar) do { unsigned _sp = 0; while (cond) { __builtin_amdgcn_s_sleep(1); \
    if ((++_sp & 255u) == 0u) { if (xb_ld(&(bar)[XB_TMO])) break; if (_sp > XB_SPIN_CAP) { atomicAdd(&(bar)[XB_TMO], 1u); break; } } } } while (0)
__device__ __forceinline__ void xcd_barrier_complete(unsigned* bar, unsigned x, unsigned& nloc, unsigned& nx) {
    const unsigned G = gridDim.x * gridDim.y * gridDim.z;
    unsigned sum, cnt, mine, sp = 0u;
    for (;;) {
        sum = 0u; cnt = 0u; mine = 0u;
#pragma unroll
        for (unsigned j = 0; j < 16; ++j) { const unsigned c = xb_ld(&bar[XB_XCNT(j)]); sum += c; cnt += (c > 0u) ? 1u : 0u; mine = (j == x) ? c : mine; }
        if (sum == G) break;
        __builtin_amdgcn_s_sleep(1);
        if ((++sp & 255u) == 0u) { if (xb_ld(&bar[XB_TMO])) break; if (sp > XB_SPIN_CAP) { atomicAdd(&bar[XB_TMO], 1u); break; } }
    }
    nloc = mine > 0u ? mine : 1u; nx = cnt > 0u ? cnt : 1u;
}
__device__ __forceinline__ void xcd_barrier(unsigned* bar, volatile LAS unsigned* st) {
    asm volatile("s_waitcnt vmcnt(0)" ::: "memory");
    __syncthreads();
    if (threadIdx.x == 0) {
        const unsigned x = xb_xcc_id();
        __builtin_amdgcn_s_waitcnt(0);
        unsigned nloc = st[0], nx = st[1];
        if (nloc == 0u) { xcd_barrier_complete(bar, x, nloc, nx); st[0] = nloc; st[1] = nx; }
        const unsigned old = xb_add(&bar[XB_XSUB(x)], 1u);
        const unsigned gen = old / nloc;
        if (old + 1u == (gen + 1u) * nloc) {
            __builtin_amdgcn_fence(__ATOMIC_RELEASE, "agent");
            asm volatile("s_waitcnt vmcnt(0)" ::: "memory");
            const unsigned og = xb_add(&bar[XB_TOP], 1u);
            const unsigned tg = og / nx;
            if (og + 1u == (tg + 1u) * nx) xb_add(&bar[XB_TOPGEN], 1u);
            else XB_SPIN(xb_ld(&bar[XB_TOPGEN]) == tg, bar);
            __builtin_amdgcn_fence(__ATOMIC_ACQUIRE, "agent");
            xb_add(&bar[XB_XGEN(x)], 1u);
            asm volatile("s_waitcnt vmcnt(0)" ::: "memory");
        } else {
            XB_SPIN(xb_ld(&bar[XB_XGEN(x)]) == gen, bar);
            __builtin_amdgcn_fence(__ATOMIC_ACQUIRE, "agent");
            asm volatile("s_waitcnt vmcnt(0)" ::: "memory");
        }
    }
    __syncthreads();
}

__global__ void __launch_bounds__(512, 2) mk_fwd(Args a) {
    extern __shared__ __attribute__((aligned(16))) unsigned char lds_raw[];
    LAS unsigned char* lds = (LAS unsigned char*)lds_raw;
    const int G = gridDim.x, bx = blockIdx.x;
    const int vcu = (G % 8 == 0) ? (bx % 8) * (G / 8) + bx / 8 : bx;
    const int lo = a.ph_lo, hi = a.ph_hi;
    const bool fuse = (G == 256) && (hi - lo > 1);
#define IN(k) (lo <= (k) && (k) < hi)
#define STAMP(idx) do { if (PROBE_TIMING && bx == 0) { u64* tsp = (u64*)(wsp(a) + WS_DBG) + 64 + (idx); const u64 tv = __builtin_amdgcn_s_memrealtime(); if (threadIdx.x == 0) *tsp = tv; } } while (0)
#define SEAM(k) do { if (IN(k) && IN((k) + 1)) xcd_barrier((unsigned*)(wsp(a) + WS_CTL) + 4096, (volatile LAS unsigned*)(lds + LDS_MISC)); STAMP((k) + 1); } while (0)
#define FRESH_IDS int tid = threadIdx.x; asm volatile("" : "+v"(tid)); const int lane = tid & 63; const int wave = __builtin_amdgcn_readfirstlane(tid >> 6); const int gw = vcu * 8 + wave, ngw = G * 8; (void)lane; (void)gw; (void)ngw;
    if (threadIdx.x < 64) ((LAS unsigned*)(lds + LDS_MISC))[threadIdx.x] = 0u;
    __syncthreads();
    if (hi - lo > 1 && threadIdx.x == 0) (void)xb_add((unsigned*)(wsp(a) + WS_CTL) + 4096 + XB_XCNT(xb_xcc_id()), 1u);
    STAMP(0);
    int ph = 0;
    if (IN(ph)) { FRESH_IDS phase_prologue(a, lds, gw, ngw, wave, lane, 0, (G == 256) ? 1 : NL, true, 0, (G == 256) ? CONV_I1 : -1); }
    SEAM(ph); ++ph;
#pragma unroll 1
    for (int l = 0; l < NL; ++l) {
        if (IN(ph)) {
            pg8::Gemm g{(const bf16*)(wsp(a) + WS_XB), (const bf16*)(wsp(a) + WS_W1T + l * W1T_L), DM, DM, DM / 64, 0, 0};
            pg8::Order S; S.init(TT / 256, NT1, G, bx, 1);
            const bool side = (G == 256);
            S.m249 = side ? 1 : 0;
            Epi1 E{wsp(a), (const u64*)(wsp(a) + WS_SSQ) + (size_t)l * TT, inp(a, I_DTB) + l * 16};
            if (side && bx >= 249) {
                FRESH_IDS (void)gw; (void)ngw;
                phase_prologue(a, lds, (bx - 249) * 8 + wave, 7 * 8, wave, lane, l, (l + 2 < NL) ? l + 2 : NL, false, CONV_I1, (l + 1 < NL) ? CONV_IL + XCONV : CONV_IL);
            } else
            if (GEMM_MASK & 1) pg8::gemm_phase<Epi1, pg8::Order>(lds, g, S, E);
        }
        SEAM(ph); ++ph;
        if (IN(ph)) {
            FRESH_IDS
            const int NCP = (G == 256) ? 0 : 512;
            const int NAT = (G == 256) ? 0 : 256;
            const int N0 = 256, N1_ = N0 + NAT, N2 = N1_ + NCP, N3 = N2 + 512, N4 = N3 + 128, N5 = N4 + 512;
#pragma unroll 1
            for (int it = bx; it < N5; it += G) {
                if (it < N0) { if (ITEM_MASK & 1) ssd1_item(a, l, it, lds, tid, wave, lane); }
                else if (it < N1_) { if (ITEM_MASK & 2) attn_item(a, l, it - N0, lds, tid, wave, lane); }
                else if (it < N2) { if (ITEM_MASK & 4) conv_item<false>(a, l, it - N1_, lds, tid, wave, lane); }
                else if (it < N3) { if (G != 256) { if (ITEM_MASK & 8) attns_item(a, l, it - N2, lds, tid, wave, lane); } }
                else if (it < N4) { if (G != 256) { if (ITEM_MASK & 16) conv_item<true>(a, l, it - N3, lds, tid, wave, lane); } }
                else if (G != 256) { if (ITEM_MASK & 32) ssds_item(a, l, it - N4, lds, tid, wave, lane); }
            }
            if (G == 256) { if (ITEM_MASK & 8) attns_pair(a, l, bx, bx + 256, lds, tid, wave, lane); }
            if (G == 256) { if (ITEM_MASK & 32) ssds_pair(a, l, bx, bx + 256, lds, tid, wave, lane); }
        }
        SEAM(ph); ++ph;
        if (IN(ph)) { FRESH_IDS if (G != 256) ssd_scan_phase(a, l, bx * 512 + tid, G * 512); else if (bx >= 128) ssd_scan_phase(a, l, (bx - 128) * 512 + tid, 128 * 512); }
        if (IN(ph)) { FRESH_IDS
#pragma unroll 1
            for (int it = bx; it < ((G == 256) ? 128 : 0); it += G) { if (ITEM_MASK & 16) conv_item<true>(a, l, it, lds, tid, wave, lane); } }
        SEAM(ph); ++ph;
        if (IN(ph)) {
            if ((vcu & 7) == 0 && G == 256) {
                pg8::Gemm g{(const bf16*)(wsp(a) + WS_ACT), (const bf16*)(wsp(a) + WS_W2T + l * W2T_L), 4096, 4096, 1024 / 64, 1024, 1024};
                pg8::ListOrder S{256 + (vcu >> 3), 0, 1, 4};
                Epi2 E{(const bf16*)(wsp(a) + WS_MG), (const u64*)(wsp(a) + WS_SSQA) + (size_t)l * TT, (bf16*)(wsp(a) + WS_H)};
                if (GEMM_MASK & 2) pg8::gemm_phase<Epi2, pg8::ListOrder>(lds, g, S, E);
            } else {
                FRESH_IDS
                const int q = (G == 256) ? (vcu >> 3) * 7 + (vcu & 7) - 1 : bx, nq = (G == 256) ? 224 : G;
#pragma unroll 1
                for (int it = q; it < 256; it += nq) { if (ITEM_MASK & 64) ssd2_item(a, l, it, lds, tid, wave, lane); }
                if (G == 256 && q >= 32) {
#pragma unroll 1
                    for (int it = q - 32; it < 512; it += 192) { if (ITEM_MASK & 4) conv_item<false>(a, l, it, lds, tid, wave, lane); }
                }
                if (G == 256) {
                    if (q < 32) { if (ITEM_MASK & 2) { attn_item(a, l, q, lds, tid, wave, lane); attn_item(a, l, q + 32, lds, tid, wave, lane); } }
                    else { if (ITEM_MASK & 2) attn_item(a, l, 64 + (q - 32), lds, tid, wave, lane); }
                }
            }
        }
        SEAM(ph); ++ph;
        if (IN(ph)) {
            pg8::Gemm g{(const bf16*)(wsp(a) + WS_ACT), (const bf16*)(wsp(a) + WS_W2T + l * W2T_L), 4096, 4096, 1024 / 64, 1024, 1024};
            Epi2 E{(const bf16*)(wsp(a) + WS_MG), (const u64*)(wsp(a) + WS_SSQA) + (size_t)l * TT, (bf16*)(wsp(a) + WS_H)};
            if (G == 256) { pg8::ListOrder S{vcu, 0, 1, 4}; if (GEMM_MASK & 2) pg8::gemm_phase<Epi2, pg8::ListOrder>(lds, g, S, E); }
            else { pg8::Order S; S.init(TT / 256, DM / 256, G, bx, 4); if (GEMM_MASK & 2) pg8::gemm_phase<Epi2, pg8::Order>(lds, g, S, E); }
        }
        SEAM(ph); ++ph;
        if (IN(ph)) {
            pg8::Gemm g{(const bf16*)(wsp(a) + WS_H), (const bf16*)(wsp(a) + WS_W3T + l * W3T_L), DM, DM, DM / 64, 0, 0};
            const bool splitk = fuse && l == NL - 1;
            pg8::Order S; S.init(splitk ? TP / 256 : TT / 256, DM / 256, G, bx, 1);
            Epi3 E{(bf16*)(wsp(a) + WS_XB), (u64*)(wsp(a) + WS_SSQ) + (size_t)(l + 1) * TT};
            if (GEMM_MASK & 4) pg8::gemm_phase<Epi3, pg8::Order>(lds, g, S, E);
            if (splitk && bx < 128) {
                pg8::Gemm gp{(const bf16*)(wsp(a) + WS_H), (const bf16*)(wsp(a) + WS_W3T + l * W3T_L), DM, DM, (DM / 4) / 64, DM / 4, DM / 4};
                pg8::ListOrder S2{256 + (bx >> 2), 0, 1, 1, bx & 3};
                EpiP EP{(float*)(wsp(a) + WS_MG)};
                if (GEMM_MASK & 4) pg8::gemm_phase<EpiP, pg8::ListOrder>(lds, gp, S2, EP);
            }
            if (l == 0 && G == 256 && bx >= 32) {
                FRESH_IDS (void)gw; (void)ngw;
                phase_prologue(a, lds, (bx - 32) * 8 + wave, 224 * 8, wave, lane, 1, 2, false, XCONV, CONV_I1);
            }
        }
        SEAM(ph); ++ph;
    }
    if (IN(ph)) {
        FRESH_IDS
        const int nrows = __builtin_amdgcn_readfirstlane(fuse ? TP / 2048 + (((gw & 1) == 0) ? 1 : 0) : (gw < TT ? (TT - gw + ngw - 1) / ngw : 0));
#pragma unroll 1
        for (int k = 0; k < nrows; ++k) {
            const int mrow = __builtin_amdgcn_readfirstlane(!fuse ? gw + k * ngw : (k < TP / 2048 ? gw + k * 2048 : TP + (gw >> 1)));
            const bool sp = fuse && mrow >= TP;
            const u32x2* x2 = (const u32x2*)((const bf16*)(wsp(a) + WS_XB) + (size_t)mrow * DM) + lane; u32x2 v[8]; f32x4 x[8];
#pragma unroll
            for (int j = 0; j < 8; ++j) v[j] = x2[64 * j];
#pragma unroll
            for (int j = 0; j < 8; ++j) x[j] = (f32x4){bf2f(v[j].x & 0xffffu), bf2f(v[j].x >> 16), bf2f(v[j].y & 0xffffu), bf2f(v[j].y >> 16)};
            float rstd;
            if (sp) {
                const float* P = (const float*)(wsp(a) + WS_MG) + (size_t)(mrow - TP) * DM; float ss = 0.f;
#pragma unroll
                for (int sl = 0; sl < 4; ++sl) { const f32x4* pp = (const f32x4*)(P + (size_t)sl * (TT - TP) * DM) + lane;
#pragma unroll
                    for (int j = 0; j < 8; ++j) x[j] += pp[64 * j]; }
#pragma unroll
                for (int j = 0; j < 8; ++j) ss += (x[j].x * x[j].x + x[j].y * x[j].y) + (x[j].z * x[j].z + x[j].w * x[j].w);
                rstd = rsqrtf(wave_sum(ss) * (1.0f / 2048.0f) + 1e-6f);
            } else rstd = ssq_to_rstd(((const u64*)(wsp(a) + WS_SSQ))[(size_t)NL * TT + mrow], 1.0f / 2048.0f, 1e-6f);
            f32x4* o4 = (f32x4*)(outp(a) + (size_t)mrow * DM) + lane;
#pragma unroll
            for (int j = 0; j < 8; ++j) { const f32x4 w = *((const f32x4*)inp(a, I_FNW) + lane + 64 * j); __builtin_nontemporal_store(x[j] * rstd * w, o4 + 64 * j); }
        }
    }
    STAMP(ph + 1);
#undef IN
#undef SEAM
}

#if PROBE_CHECK
constexpr int NSTAGE = 40;
__device__ __forceinline__ unsigned hash32(unsigned x) { x ^= x >> 16; x *= 0x7feb352du; x ^= x >> 15; x *= 0x846ca68bu; x ^= x >> 16; return x; }
__device__ __forceinline__ void rec_err(float* dbg, int stage, float got, float ref, float floor_) {
    float e = fabsf(got - ref) / (fabsf(ref) + floor_); if (!(e == e)) e = 1e30f;
    atomicMax((unsigned*)dbg + stage, __float_as_uint(e));
}
__device__ void rec_err2(float* dbg, int stage, float got, float ref, float scale) {
    float e = fabsf(got - ref) / scale; if (!(e == e)) e = 1e30f; if (e == 0.f) e = 1e-30f;
    atomicMax((unsigned*)dbg + stage, __float_as_uint(e));
}
__device__ float chk_xbc(const Args& a, int l, int row, int ch) {
    const bf16* XBC = (const bf16*)(a.ws + WS_XBC); float s = a.in[I_SCONVB][l * XBC_W + ch];
    const bool samp = row >= TP; const int t = samp ? (row - TP) % 8 : row % PSEQ, b = samp ? (row - TP) / 8 : 0;
    for (int k = 0; k < 4; ++k) { const int tt = t - 3 + k; float v;
        if (tt >= 0) v = bf2f(XBC[(size_t)(row - 3 + k) * XBC_W + ch]); else v = samp ? a.in[I_CSSM][(((size_t)l * SB + b) * 3 + (3 + tt)) * XBC_W + ch] : 0.f;
        s += a.in[I_SCONVW][(size_t)l * 4 * XBC_W + k * XBC_W + ch] * v; }
    return s / (1.f + expf(-s));
}
__device__ float chk_cfconv(const Args& a, int l, int row, int ch) {
    const bf16* U = (const bf16*)(a.ws + WS_U); float s = a.in[I_CFCB][l * 1024 + ch];
    const bool samp = row >= TP; const int t = samp ? (row - TP) % 8 : row % PSEQ, b = samp ? (row - TP) / 8 : 0;
    for (int k = 0; k < 31; ++k) { const int tt = t - 30 + k; float v;
        if (tt >= 0) v = bf2f(U[(size_t)(row - 30 + k) * 1024 + ch]); else v = samp ? a.in[I_CCF][(((size_t)l * SB + b) * 30 + (30 + tt)) * 1024 + ch] : 0.f;
        s += a.in[I_CFCW][(size_t)l * 31 * 1024 + k * 1024 + ch] * v; }
    return s;
}
__global__ void chk_kernel(Args a, int layer, int part) {
    float* dbg = (float*)(a.ws + WS_DBG); const int l = layer;
    const int s = blockIdx.x * blockDim.x + threadIdx.x; const unsigned h = hash32(s * 2654435761u + 12345u + 977u * layer);
    const bf16* XB = (const bf16*)(a.ws + WS_XB); const bf16* ACT = (const bf16*)(a.ws + WS_ACT); const float* DT = (const float*)(a.ws + WS_DT);
    const bf16* KV = (const bf16*)(a.ws + WS_KV); const bf16* Zb = (const bf16*)(a.ws + WS_Z);
    if (part == 1) {
        const int row = h % TT, col = (h >> 13) % DM;
        if (layer == 0 && s < 4096) { const bf16* hr = (const bf16*)(a.ws + WS_H) + (size_t)row * DM; const bf16* wr = (const bf16*)(a.ws + WS_W3T + l * W3T_L) + (size_t)col * DM; float d = 0.f, da = 0.f;
            for (int k = 0; k < DM; ++k) { const float t = bf2f(hr[k]) * bf2f(wr[k]); d += t; da += fabsf(t); }
            const float xo = row < TP ? a.in[I_XP][(size_t)row * DM + col] : a.in[I_XS][(size_t)(row - TP) * DM + col];
            rec_err2(dbg, 27, a.out[(size_t)row * DM + col], xo + d, da + fabsf(xo) + 1e-3f); }
        rec_err2(dbg, 28, bf2f(XB[(size_t)row * DM + col]), a.out[(size_t)row * DM + col], fabsf(a.out[(size_t)row * DM + col]) + 0.01f);
        if (s < 2048) { float q = 0.f; for (int i = 0; i < DM; ++i) { const float v = a.out[(size_t)row * DM + i]; q += v * v; }
            rec_err2(dbg, 28, (float)((double)((const u64*)(a.ws + WS_SSQ))[(size_t)(l + 1) * TT + row] / 1048576.0), q, q * 0.25f + 1e-3f); }
        return;
    }
    if (part == 2) {
        if (s < 4096) { const int row = h % TT; float q = 0.f; for (int i = 0; i < DM; ++i) { const float v = a.out[(size_t)row * DM + i] / a.in[I_FNW][i]; q += v * v; }
            rec_err2(dbg, 29, q * (1.f / 2048.f), 1.f, 1.f); }
        return;
    }
    if (layer == 0) {
        const int row = h % TT, k = (h >> 14) % DM;
        const float x = row < TP ? a.in[I_XP][(size_t)row * DM + k] : a.in[I_XS][(size_t)(row - TP) * DM + k];
        rec_err(dbg, 0, bf2f(XB[(size_t)row * DM + k]), x, 0.01f);
        if (s < 4096) { const float* xr = row < TP ? a.in[I_XP] + (size_t)row * DM : a.in[I_XS] + (size_t)(row - TP) * DM; float q = 0.f; for (int i = 0; i < DM; ++i) q += xr[i] * xr[i];
            rec_err(dbg, 1, (float)((double)((const u64*)(a.ws + WS_SSQ))[row] / 1048576.0), q, 0.01f); }
    }
    {
        const unsigned h2 = hash32(h + 77u); const int n = h2 % N1, k = (h2 >> 16) % DM; const int pn = n >> 8, c = n & 255; const TileInfo ti = tile_info(pn);
        const int half = c >> 7, cc = c & 127; const int valid = half ? ti.valid1 : ti.valid0; float ref = 0.f;
        if (cc < valid) ref = a.in[I_WIN][(size_t)layer * DM * IN_COLS + (size_t)k * IN_COLS + (half ? ti.src1 : ti.src0) + cc] * a.in[I_NORMW][layer * DM + k];
        rec_err(dbg, 2, bf2f(((const bf16*)(a.ws + WS_W1T + layer * W1T_L))[(size_t)n * DM + k]), ref, 0.002f);
        const int n2 = h2 % DM, k2 = (h2 >> 12) % 4096, br = k2 >> 10, kk = k2 & 1023;
        float r2 = a.in[br == 0 ? I_WOSSM : (br == 1 ? I_WOCF : (br == 2 ? I_WOSC : I_WOATT))][(size_t)layer * 1024 * DM + (size_t)kk * DM + n2]; if (br == 0) r2 *= a.in[I_SNORMW][layer * 1024 + kk];
        rec_err(dbg, 3, bf2f(((const bf16*)(a.ws + WS_W2T + layer * W2T_L))[(size_t)n2 * 4096 + k2]), r2, 0.002f);
        const int k3 = (h2 >> 11) % DM;
        rec_err(dbg, 4, bf2f(((const bf16*)(a.ws + WS_W3T + layer * W3T_L))[(size_t)n2 * DM + k3]), a.in[I_WO][(size_t)layer * DM * DM + (size_t)k3 * DM + n2], 0.002f);
    }
    {
        const unsigned h3 = hash32(h + 991u); const int row = h3 % TT, pn = s % NT1; const TileInfo ti = tile_info(pn);
        const int ncol = ti.mode == M_DT ? 16 : (ti.mode >= M_GLU ? 128 : 256); const int c = (h3 >> 14) % ncol;
        const bf16* W = (const bf16*)(a.ws + WS_W1T + layer * W1T_L) + (size_t)pn * 256 * DM; const bf16* xr = XB + (size_t)row * DM;
        float d0 = 0.f, d1 = 0.f;
        for (int k = 0; k < DM; ++k) { const float x = bf2f(xr[k]); d0 += x * bf2f(W[(size_t)c * DM + k]); if (ti.mode >= M_GLU && ti.mode <= M_ASILUB) d1 += x * bf2f(W[(size_t)(c + 128) * DM + k]); }
        const float r = ssq_to_rstd(((const u64*)(a.ws + WS_SSQ))[(size_t)layer * TT + row], 1.f / 2048.f, 1e-6f); d0 *= r; d1 *= r;
        float ref, got;
        switch (ti.mode) { case M_ID: ref = d0; break; case M_SILU: ref = d0 / (1.f + expf(-d0)); break; case M_SIG: ref = 1.f / (1.f + expf(-d0)); break;
            case M_GLU: ref = d0 / (1.f + expf(-d1)); break; case M_MUL: ref = d0 * d1; break; case M_ASILUB: ref = d0 * d1 / (1.f + expf(-d1)); break;
            default: ref = log1pf(expf(d0 + a.in[I_DTB][layer * 16 + c])); break; }
        if (ti.mode == M_DT) got = ((const float*)(a.ws + ti.dst))[(size_t)row * 16 + c]; else got = bf2f(((const bf16*)(a.ws + ti.dst))[(size_t)row * ti.ld + ti.col0 + c]);
        rec_err(dbg, 5 + ti.mode, got, ref, ti.mode == M_DT ? 1e-4f : 0.03f);
    }
    const unsigned h4 = hash32(h + 31337u);
    if (s < 2048) {
        const int row = (s & 1) ? TP + (h4 % TS) : (h4 % TP), c = (h4 >> 13) & 1023;
        float sm = 0.f; for (int ch = 0; ch < 1024; ++ch) sm += chk_cfconv(a, l, row, ch);
        const float mean = sm / 1024.f; float q = 0.f; for (int ch = 0; ch < 1024; ++ch) { const float d = chk_cfconv(a, l, row, ch) - mean; q += d * d; }
        const float v = (chk_cfconv(a, l, row, c) - mean) * rsqrtf(q / 1024.f + 1e-5f) * a.in[I_CFLNW][l * 1024 + c] + a.in[I_CFLNB][l * 1024 + c];
        const float ref = v / (1.f + expf(-v)) * bf2f(((const bf16*)(a.ws + WS_CFG))[(size_t)row * 1024 + c]);
        rec_err2(dbg, 12, bf2f(ACT[(size_t)row * 4096 + 1024 + c]), ref, fabsf(ref) + 0.02f);
        const bf16* CV = (const bf16*)(a.ws + WS_CV); const bool samp = row >= TP; const int t = samp ? (row - TP) % 8 : row % PSEQ, b = samp ? (row - TP) / 8 : 0; float y = 0.f, ya = 0.f;
        for (int k = 0; k < 3; ++k) { const int tt = t - 2 + k; float xv; if (tt >= 0) xv = bf2f(CV[(size_t)(row - 2 + k) * 1024 + c]); else xv = samp ? a.in[I_CSC][(((size_t)l * SB + b) * 2 + (2 + tt)) * 1024 + c] : 0.f;
            const float tm = a.in[I_SCCW][(size_t)l * 3 * 1024 + k * 1024 + c] * xv; y += tm; ya += fabsf(tm); }
        const float cm = bf2f(((const bf16*)(a.ws + WS_CM))[(size_t)row * 1024 + c]);
        rec_err2(dbg, 13, bf2f(ACT[(size_t)row * 4096 + 2048 + c]), y * cm, ya * fabsf(cm) + 0.01f);
    }
    if (s < 4096) {
        const int b = h4 & 3, c = (h4 >> 2) & 15, hh = (h4 >> 6) & 15, p = (h4 >> 10) & 63, n = (h4 >> 16) & 127, g = hh >> 2; const int r0 = b * PSEQ + c * CHUNK;
        const float A = -expf(a.in[I_ALOG][l * HEADS + hh]); float last = 0.f; for (int i = 0; i < 128; ++i) last += DT[(size_t)(r0 + i) * 16 + hh] * A;
        float cum = 0.f, ref = 0.f, refa = 0.f;
        for (int i = 0; i < 128; ++i) { const float d = DT[(size_t)(r0 + i) * 16 + hh]; cum += d * A;
            const float tm = chk_xbc(a, l, r0 + i, 1024 + g * 128 + n) * d * expf(last - cum) * chk_xbc(a, l, r0 + i, hh * 64 + p); ref += tm; refa += fabsf(tm); }
        const float* CST = (const float*)(a.ws + WS_CST); const float* CDEC = (const float*)(a.ws + WS_CDEC);
        const size_t eo = (size_t)p * NST + n;
        rec_err2(dbg, 14, CST[((size_t)((b * NCH + c) * HEADS + hh)) * 8192 + eo], ref, refa + 1e-5f);
        rec_err2(dbg, 15, CDEC[(b * NCH + c) * HEADS + hh], expf(last), expf(last) + 1e-6f);
        float H = 0.f; for (int cc = 0; cc < c; ++cc) H = H * CDEC[(b * NCH + cc) * HEADS + hh] + CST[((size_t)((b * NCH + cc) * HEADS + hh)) * 8192 + eo];
        rec_err2(dbg, 16, bf2f(((const bf16*)(a.ws + WS_HPREV))[((size_t)((b * NCH + c) * HEADS + hh)) * 8192 + eo]), H, fabsf(H) + 1e-3f);
        for (int cc = c; cc < NCH; ++cc) H = H * CDEC[(b * NCH + cc) * HEADS + hh] + CST[((size_t)((b * NCH + cc) * HEADS + hh)) * 8192 + eo];
        rec_err2(dbg, 17, a.out[O_PSSM + ((size_t)((l * PB + b) * HEADS + hh)) * 8192 + eo], H, fabsf(H) + 1e-4f);
    }
    if (s < 1024) {
        const int row = h4 % TP, hh = (h4 >> 13) & 15, p = (h4 >> 17) & 63, g = hh >> 2; const int b = row / PSEQ, t = row % PSEQ, c = t / CHUNK, tl = t % CHUNK, r0 = b * PSEQ + c * CHUNK;
        const float A = -expf(a.in[I_ALOG][l * HEADS + hh]); float cst = 0.f; for (int i = 0; i <= tl; ++i) cst += DT[(size_t)(r0 + i) * 16 + hh] * A;
        float y = 0.f, ya = 0.f, css = 0.f;
        for (int i = 0; i <= tl; ++i) { const float d = DT[(size_t)(r0 + i) * 16 + hh]; css += d * A; float gsum = 0.f;
            for (int n = 0; n < 128; ++n) gsum += chk_xbc(a, l, row, 1536 + g * 128 + n) * chk_xbc(a, l, r0 + i, 1024 + g * 128 + n);
            const float tm = gsum * expf(cst - css) * d * chk_xbc(a, l, r0 + i, hh * 64 + p); y += tm; ya += fabsf(tm); }
        const bf16* hp = (const bf16*)(a.ws + WS_HPREV) + ((size_t)((b * NCH + c) * HEADS + hh)) * 8192 + (size_t)p * NST; const float ec = expf(cst);
        for (int n = 0; n < 128; ++n) { const float tm = ec * chk_xbc(a, l, row, 1536 + g * 128 + n) * bf2f(hp[n]); y += tm; ya += fabsf(tm); }
        const float dx = a.in[I_DSKIP][l * HEADS + hh] * chk_xbc(a, l, row, hh * 64 + p), z = bf2f(Zb[(size_t)row * 1024 + hh * 64 + p]);
        rec_err2(dbg, 18, bf2f(ACT[(size_t)row * 4096 + hh * 64 + p]), (y + dx) * z, (ya + fabsf(dx)) * fabsf(z) + 1e-3f);
        const int row2 = (h4 >> 3) % TT; float q = 0.f; for (int i = 0; i < 1024; ++i) { const float v = bf2f(ACT[(size_t)row2 * 4096 + i]); q += v * v; }
        rec_err2(dbg, 19, (float)((double)((const u64*)(a.ws + WS_SSQA))[(size_t)l * TT + row2] / 1048576.0), q, q + 1e-4f);
    }
    if (s < 2048) {
        const int b = h4 & 127, hh = (h4 >> 7) & 15, p = (h4 >> 11) & 63, nsel = (h4 >> 17) & 127, g = hh >> 2; const int row0 = TP + 8 * b;
        const float A = -expf(a.in[I_ALOG][l * HEADS + hh]); float y[8] = {0.f, 0.f, 0.f, 0.f, 0.f, 0.f, 0.f, 0.f}, ya[8] = {0.f, 0.f, 0.f, 0.f, 0.f, 0.f, 0.f, 0.f}; float hfin = 0.f;
        for (int n = 0; n < 128; ++n) { float hn = a.in[I_SSM][((size_t)((l * SB + b) * HEADS + hh)) * 8192 + (size_t)p * NST + n];
#pragma unroll
            for (int t = 0; t < 8; ++t) { const float d = DT[(size_t)(row0 + t) * 16 + hh]; hn = hn * expf(d * A) + d * chk_xbc(a, l, row0 + t, hh * 64 + p) * chk_xbc(a, l, row0 + t, 1024 + g * 128 + n);
                const float tm = chk_xbc(a, l, row0 + t, 1536 + g * 128 + n) * hn; y[t] += tm; ya[t] += fabsf(tm); }
            if (n == nsel) hfin = hn; }
#pragma unroll
        for (int t = 0; t < 8; ++t) { const float dx = a.in[I_DSKIP][l * HEADS + hh] * chk_xbc(a, l, row0 + t, hh * 64 + p), z = bf2f(Zb[(size_t)(row0 + t) * 1024 + hh * 64 + p]);
            rec_err2(dbg, 20, bf2f(ACT[(size_t)(row0 + t) * 4096 + hh * 64 + p]), (y[t] + dx) * z, (ya[t] + fabsf(dx)) * fabsf(z) + 1e-3f); }
        rec_err2(dbg, 21, a.out[O_SSSM + ((size_t)((l * SB + b) * HEADS + hh)) * 8192 + (size_t)p * NST + nsel], hfin, fabsf(hfin) + 1e-3f);
    }
    if (s < 4096) {
        const int row = h4 % TP, hh = (h4 >> 13) & 15, d = (h4 >> 17) & 63, g = hh >> 2; const int t = row % PSEQ; const int klo = t - 127 < 0 ? 0 : t - 127;
        const bf16* q = (const bf16*)(a.ws + WS_Q) + (size_t)row * 1024 + hh * 64; const float sink = a.in[I_SINK][l * HEADS + hh];
        float mx = sink;
        for (int kt = klo; kt <= t; ++kt) { const bf16* kr = KV + (size_t)(row - t + kt) * 512 + g * 64; float sc = 0.f; for (int e = 0; e < 64; ++e) sc += bf2f(q[e]) * bf2f(kr[e]); mx = fmaxf(mx, sc * 0.125f); }
        float den = expf(sink - mx), o = 0.f, oa = 0.f;
        for (int kt = klo; kt <= t; ++kt) { const bf16* kr = KV + (size_t)(row - t + kt) * 512 + g * 64; float sc = 0.f; for (int e = 0; e < 64; ++e) sc += bf2f(q[e]) * bf2f(kr[e]);
            const float pp = expf(sc * 0.125f - mx); den += pp; const float tm = pp * bf2f(kr[256 + d]); o += tm; oa += fabsf(tm); }
        const float gt = bf2f(((const bf16*)(a.ws + WS_AG))[(size_t)row * 1024 + hh * 64 + d]);
        rec_err2(dbg, 22, bf2f(ACT[(size_t)row * 4096 + 3072 + hh * 64 + d]), o / den * gt, oa / den * fabsf(gt) + 1e-3f);
    }
    if (s < 4096) {
        const int b = h4 & 127, qi = (h4 >> 7) & 7, hh = (h4 >> 10) & 15, d = (h4 >> 14) & 63, g = hh >> 2; const int row = TP + 8 * b + qi;
        const bf16* q = (const bf16*)(a.ws + WS_Q) + (size_t)row * 1024 + hh * 64; const float sink = a.in[I_SINK][l * HEADS + hh];
        float mx = sink;
        for (int pass = 0; pass < 1; ++pass) for (int j = 0; j < 136; ++j) { if (j < 128 ? (j <= qi) : (j - 128 > qi)) continue; float sc = 0.f;
            for (int e = 0; e < 64; ++e) { const float kv = j < 128 ? a.in[I_CK][(((size_t)l * SB + b) * 128 + j) * 256 + g * 64 + e] : bf2f(KV[(size_t)(TP + 8 * b + j - 128) * 512 + g * 64 + e]); sc += bf2f(q[e]) * kv; }
            mx = fmaxf(mx, sc * 0.125f); }
        float den = expf(sink - mx), o = 0.f, oa = 0.f;
        for (int j = 0; j < 136; ++j) { if (j < 128 ? (j <= qi) : (j - 128 > qi)) continue; float sc = 0.f;
            for (int e = 0; e < 64; ++e) { const float kv = j < 128 ? a.in[I_CK][(((size_t)l * SB + b) * 128 + j) * 256 + g * 64 + e] : bf2f(KV[(size_t)(TP + 8 * b + j - 128) * 512 + g * 64 + e]); sc += bf2f(q[e]) * kv; }
            const float pp = expf(sc * 0.125f - mx); den += pp; const float vv = j < 128 ? a.in[I_CVV][(((size_t)l * SB + b) * 128 + j) * 256 + g * 64 + d] : bf2f(KV[(size_t)(TP + 8 * b + j - 128) * 512 + 256 + g * 64 + d]);
            const float tm = pp * vv; o += tm; oa += fabsf(tm); }
        const float gt = bf2f(((const bf16*)(a.ws + WS_AG))[(size_t)row * 1024 + hh * 64 + d]);
        rec_err2(dbg, 23, bf2f(ACT[(size_t)row * 4096 + 3072 + hh * 64 + d]), o / den * gt, oa / den * fabsf(gt) + 1e-3f);
        const int jj = (h4 >> 20) & 127; const size_t oo = (((size_t)l * SB + b) * 128 + jj) * 256 + g * 64 + d;
        const float rk = jj < 120 ? a.in[I_CK][oo + 8 * 256] : bf2f(KV[(size_t)(TP + 8 * b + jj - 120) * 512 + g * 64 + d]);
        const float rv = jj < 120 ? a.in[I_CVV][oo + 8 * 256] : bf2f(KV[(size_t)(TP + 8 * b + jj - 120) * 512 + 256 + g * 64 + d]);
        rec_err2(dbg, 24, a.out[O_SK + oo], rk, fabsf(rk) + 1e-3f); rec_err2(dbg, 24, a.out[O_SV + oo], rv, fabsf(rv) + 1e-3f);
    }
    if (s < 4096) {
        const bf16* U = (const bf16*)(a.ws + WS_U); const bf16* CV = (const bf16*)(a.ws + WS_CV); const bf16* XBC = (const bf16*)(a.ws + WS_XBC);
        const int b = h4 & 127, pb = b & 3, c = (h4 >> 7) & 1023, c2 = (h4 >> 7) & 2047, r30 = (h4 >> 18) % 30, r3 = (h4 >> 18) % 3, r2 = (h4 >> 18) & 1, jj = (h4 >> 18) & 127, c512 = (h4 >> 7) & 255;
        float ref;
        ref = bf2f(U[(size_t)(pb * PSEQ + 2018 + r30) * 1024 + c]); rec_err2(dbg, 25, a.out[O_PCCF + (((size_t)l * PB + pb) * 30 + r30) * 1024 + c], ref, fabsf(ref) + 1e-3f);
        ref = bf2f(CV[(size_t)(pb * PSEQ + 2046 + r2) * 1024 + c]); rec_err2(dbg, 25, a.out[O_PCSC + (((size_t)l * PB + pb) * 2 + r2) * 1024 + c], ref, fabsf(ref) + 1e-3f);
        ref = bf2f(XBC[(size_t)(pb * PSEQ + 2045 + r3) * 2048 + c2]); rec_err2(dbg, 25, a.out[O_PCSSM + (((size_t)l * PB + pb) * 3 + r3) * 2048 + c2], ref, fabsf(ref) + 1e-3f);
        ref = bf2f(KV[(size_t)(pb * PSEQ + 1920 + jj) * 512 + c512]); rec_err2(dbg, 25, a.out[O_PK + (((size_t)l * PB + pb) * 128 + jj) * 256 + c512], ref, fabsf(ref) + 1e-3f);
        ref = bf2f(KV[(size_t)(pb * PSEQ + 1920 + jj) * 512 + 256 + c512]); rec_err2(dbg, 25, a.out[O_PV + (((size_t)l * PB + pb) * 128 + jj) * 256 + c512], ref, fabsf(ref) + 1e-3f);
        const int row0 = TP + 8 * b;
        ref = r30 < 22 ? a.in[I_CCF][(((size_t)l * SB + b) * 30 + r30 + 8) * 1024 + c] : bf2f(U[(size_t)(row0 + r30 - 22) * 1024 + c]); rec_err2(dbg, 25, a.out[O_SCCF + (((size_t)l * SB + b) * 30 + r30) * 1024 + c], ref, fabsf(ref) + 1e-3f);
        ref = bf2f(CV[(size_t)(row0 + 6 + r2) * 1024 + c]); rec_err2(dbg, 25, a.out[O_SCSC + (((size_t)l * SB + b) * 2 + r2) * 1024 + c], ref, fabsf(ref) + 1e-3f);
        ref = bf2f(XBC[(size_t)(row0 + 5 + r3) * 2048 + c2]); rec_err2(dbg, 25, a.out[O_SCSSM + (((size_t)l * SB + b) * 3 + r3) * 2048 + c2], ref, fabsf(ref) + 1e-3f);
    }
    if (s < 4096) {
        const int row = h4 % TT, col = (h4 >> 14) % DM; float ref = 0.f, refa = 0.f;
        for (int br = 0; br < 4; ++br) { const bf16* ar = ACT + (size_t)row * 4096 + br * 1024; const bf16* wr = (const bf16*)(a.ws + WS_W2T + l * W2T_L) + (size_t)col * 4096 + br * 1024; float d = 0.f, da = 0.f;
            for (int k = 0; k < 1024; ++k) { const float tm = bf2f(ar[k]) * bf2f(wr[k]); d += tm; da += fabsf(tm); }
            const float gt = bf2f(((const bf16*)(a.ws + WS_MG))[(size_t)row * 8192 + br * 2048 + col]) * (br == 0 ? ssq_to_rstd(((const u64*)(a.ws + WS_SSQA))[(size_t)l * TT + row], 1.f / 1024.f, 1e-5f) : 1.f);
            ref += gt * d; refa += fabsf(gt) * da; }
        rec_err2(dbg, 26, bf2f(((const bf16*)(a.ws + WS_H))[(size_t)row * DM + col]), ref, refa + 1e-3f);
    }
}
__global__ void chk_init(Args a) { float* dbg = (float*)(a.ws + WS_DBG); if (threadIdx.x < NSTAGE) dbg[threadIdx.x] = 0.f; }
__global__ void chk_encode(Args a, int out_size) {
    const float* dbg = (const float*)(a.ws + WS_DBG);
    const size_t i0 = (size_t)blockIdx.x * blockDim.x + threadIdx.x, n = (size_t)gridDim.x * blockDim.x;
    for (size_t i = i0; i < (size_t)out_size; i += n) a.out[i] = 0.f;
    if (i0 == 0) {
        const float tol[NSTAGE] = {0.01f, 1e-3f, 0.01f, 0.01f, 0.01f, 0.02f, 0.02f, 0.02f, 0.02f, 0.02f, 0.02f, 0.01f,
                                   0.02f, 0.02f, 0.02f, 1e-3f, 0.01f, 1e-3f, 0.02f, 0.01f, 0.02f, 1e-3f, 0.02f, 0.02f, 0.01f, 0.01f, 0.02f, 0.01f, 0.02f, 2e-3f};
        float code = 9.9e8f;
        for (int st = 0; st < 30; ++st) { const float e = dbg[st]; if (!(e <= tol[st]) || e == 0.f) { const int bucket = e == 0.f ? 5 : (e < 1e-2f ? 0 : (e < 1e-1f ? 1 : (e < 1.f ? 2 : (e < 10.f ? 3 : 4)))); code = (float)(10 + st) * 100.f * powf(10.f, (float)bucket); break; } }
        a.out[0] = code;
    }
}
#endif


#if PROBE_TIMING
__global__ void timing_encode(Args a) {
    const u64* ts = (const u64*)(a.ws + WS_DBG) + 64;
    float sum = 0.f;
    for (int k = 0; k < 14; ++k) { const float d = (float)(ts[k + 1] - ts[k]) * 0.01f; const int j = (k >= 1 && k <= 12) ? (k - 1) % 6 : -1;
        bool take = false;
        if (PROBE_TIMING == 1) take = (j == 0);
        else if (PROBE_TIMING == 2) take = (j == 1);
        else if (PROBE_TIMING == 3) take = (j == 2 || j == 3);
        else if (PROBE_TIMING == 4) take = (k == 0);
        else if (PROBE_TIMING == 5) take = true;
        else if (PROBE_TIMING == 6) take = (j == 4);
        else if (PROBE_TIMING == 7) take = (j == 5);
        else if (PROBE_TIMING == 8) take = (k == 13);
        else if (PROBE_TIMING >= 100) take = (k == PROBE_TIMING - 100);
        if (take) sum += d; }
    a.out[O_SK] = a.in[I_CK][8 * 256] + 8.0f * log2f(sum);
}
#endif
extern "C" void kernel_launch(void* const* d_in, const int* in_sizes, int n_in, void* d_out, int out_size, void* d_ws, size_t ws_size, hipStream_t stream) {
    static int grid = 0;
    if (grid == 0) {
        int dev = 0, cus = 0, per_cu = 0;
        (void)hipGetDevice(&dev);
        (void)hipDeviceGetAttribute(&cus, hipDeviceAttributeMultiprocessorCount, dev);
        (void)hipFuncSetAttribute((const void*)mk_fwd, hipFuncAttributeMaxDynamicSharedMemorySize, LDS_BYTES);
        (void)hipOccupancyMaxActiveBlocksPerMultiprocessor(&per_cu, (const void*)mk_fwd, 512, LDS_BYTES);
        if (per_cu < 1 || n_in != 28 || ws_size < WS_END) { fprintf(stderr, "kernel_launch: unexpected environment (per_cu %d, n_in %d, ws %zu)\n", per_cu, n_in, ws_size); grid = -1; return; }
        grid = cus;
    }
    if (grid < 0) return;
    (void)hipMemsetAsync((char*)d_ws + WS_CTL, 0, CTL_BYTES, stream);
    Args a{};
    for (int i = 0; i < 28; ++i) a.in[i] = (const float*)d_in[i];
    a.out = (float*)d_out; a.ws = (unsigned char*)d_ws;
    const int NPH = 1 + NL * 6 + 1;
#if PROBE_CHECK
    chk_init<<<1, 64, 0, stream>>>(a);
#endif
#if PROBE_CHECK
    for (int p = 0; p < NPH; ++p) {
        a.ph_lo = p; a.ph_hi = p + 1;
        void* args[] = {&a};
        hipError_t e = hipLaunchCooperativeKernel((const void*)mk_fwd, dim3(grid), dim3(512), args, LDS_BYTES, stream);
        if (e != hipSuccess) fprintf(stderr, "cooperative launch failed: %s (grid %d)\n", hipGetErrorString(e), grid);
        if (p >= 1 && p < NPH - 1 && (p - 1) % 6 == 4) chk_kernel<<<64, 256, 0, stream>>>(a, (p - 1) / 6, 0);
        if (p >= 1 && p < NPH - 1 && (p - 1) % 6 == 5) chk_kernel<<<64, 256, 0, stream>>>(a, (p - 1) / 6, 1);
        if (p == NPH - 1) chk_kernel<<<64, 256, 0, stream>>>(a, 0, 2);
    }
#else
    {
        a.ph_lo = 0; a.ph_hi = NPH;
        hipLaunchKernelGGL(mk_fwd, dim3(grid), dim3(512), LDS_BYTES, stream, a);
        const hipError_t e = hipPeekAtLastError();
        if (e != hipSuccess) fprintf(stderr, "launch failed: %s (grid %d)\n", hipGetErrorString(e), grid);
    }
#endif
#if PROBE_CHECK
    chk_encode<<<256, 256, 0, stream>>>(a, out_size);
#endif
#if PROBE_TIMING
    timing_encode<<<1, 1, 0, stream>>>(a);
#endif
}
```
